# Optimizing an MI355X kernel written in HIP

```python
import math
import jax, jax.numpy as jnp
from jax import lax
import numpy as np

D_MODEL = 2048
BATCH = 4
SEQ = 2048
DEPTH = 4

D_MIX = D_MODEL
RET_HEADS = 4
RET_DIM = D_MIX // 4
RET_HEAD_DIM = RET_DIM // RET_HEADS
RET_CHUNK = 128
ROPE_BASE = 10000.0
HG_HEADS = 4
HG_DIM = D_MIX // 4
HG_HEAD_DIM = HG_DIM // HG_HEADS
HG_CHUNK = 64
M_DIM = D_MIX - RET_DIM - HG_DIM
M_HEAD_DIM = 64
M_HEADS = M_DIM // M_HEAD_DIM
M_GROUPS = 2
M_STATE = 128
M_CONV = 4
M_CHUNK = 128
M_CONV_DIM = M_DIM + 2 * M_GROUPS * M_STATE
D_FF = 4 * D_MODEL
DEEPNORM_ALPHA = (2 * DEPTH) ** 0.25
DEEPNORM_BETA = (8 * DEPTH) ** -0.25
LN_EPS = 1e-5
RMS_EPS = 1e-6
N_ADA = 6
IN_SPLITS = (RET_DIM, RET_DIM, RET_DIM, RET_DIM,
             HG_DIM, HG_DIM, HG_DIM, HG_DIM,
             M_DIM, M_CONV_DIM, M_HEADS)
IN_COLS = 4 * RET_DIM + 4 * HG_DIM + M_DIM + M_CONV_DIM + M_HEADS

kernel_name = "hymba_style_ret_hgrn2_ssd_deepnorm_adaln"


def layer_norm(x, g, b):
    xf = x.astype(jnp.float32)
    mu = jnp.mean(xf, axis=-1, keepdims=True)
    var = jnp.mean(jnp.square(xf - mu), axis=-1, keepdims=True)
    return ((xf - mu) * lax.rsqrt(var + LN_EPS) * g + b).astype(x.dtype)


def rms_norm(x):
    xf = x.astype(jnp.float32)
    return xf * lax.rsqrt(jnp.mean(jnp.square(xf), axis=-1, keepdims=True) + RMS_EPS)


def rotary(positions):
    inv_freq = 1.0 / (ROPE_BASE ** jnp.linspace(0.0, 1.0, RET_HEAD_DIM // 2, dtype=jnp.float32))
    ang = positions[..., None].astype(jnp.float32) * inv_freq
    return jnp.cos(ang)[:, :, None, :], jnp.sin(ang)[:, :, None, :]


def apply_rotary(t, cos, sin):
    half = t.shape[-1] // 2
    t1, t2 = t[..., :half], t[..., half:]
    return jnp.concatenate([t1 * cos - t2 * sin, t1 * sin + t2 * cos], axis=-1)


def chunked_scalar_decay(q, k, v, log_a, chunk):
    b, l, h, n = q.shape
    p = v.shape[-1]
    nc = l // chunk
    q = q.reshape(b, nc, chunk, h, n)
    k = k.reshape(b, nc, chunk, h, n)
    v = v.reshape(b, nc, chunk, h, p)
    cum = jnp.cumsum(log_a.astype(jnp.float32).reshape(b, nc, chunk, h), axis=2)
    mask = jnp.tril(jnp.ones((chunk, chunk), bool))[None, None, :, :, None]
    seg = cum[:, :, :, None, :] - cum[:, :, None, :, :]
    decay = jnp.exp(jnp.where(mask, seg, -jnp.inf))
    scores = jnp.einsum('bcihn,bcjhn->bcijh', q, k) * decay
    y_intra = jnp.einsum('bcijh,bcjhp->bcihp', scores, v)
    k_end = k * jnp.exp(cum[:, :, -1:, :] - cum)[..., None]
    states = jnp.einsum('bcjhn,bcjhp->bchnp', k_end, v)
    chunk_decay = jnp.exp(cum[:, :, -1, :])

    def step(s, inp):
        st, dc = inp
        return dc[..., None, None] * s + st, s

    s0 = jnp.zeros((b, h, n, p), jnp.float32)
    _, s_prev = lax.scan(step, s0, (jnp.moveaxis(states, 1, 0), jnp.moveaxis(chunk_decay, 1, 0)))
    s_prev = jnp.moveaxis(s_prev, 0, 1)
    y_inter = jnp.einsum('bcihn,bchnp->bcihp', q * jnp.exp(cum)[..., None], s_prev)
    return (y_intra + y_inter).reshape(b, l, h, p)


def chunked_vector_decay(q, k, v, log_f, chunk):
    b, l, h, dk = q.shape
    dv = v.shape[-1]
    nc = l // chunk

    def to_chunks(t):
        return jnp.moveaxis(t.reshape(b, nc, chunk, *t.shape[2:]), 1, 0)

    mask = jnp.tril(jnp.ones((chunk, chunk), bool))[None, :, :, None, None]

    def step(state, inp):
        qc, kc, vc, gc = inp
        cum = jnp.cumsum(gc, axis=1)
        rel = jnp.exp(jnp.where(mask, cum[:, :, None] - cum[:, None], -jnp.inf))
        scores = jnp.einsum('bihd,bjhd,bijhd->bijh', qc, kc, rel)
        y = (jnp.einsum('bijh,bjhv->bihv', scores, vc)
             + jnp.einsum('bihd,bhdv->bihv', qc * jnp.exp(cum), state))
        total = cum[:, -1]
        state = (jnp.exp(total)[..., None] * state
                 + jnp.einsum('bjhd,bjhv->bhdv', kc * jnp.exp(total[:, None] - cum), vc))
        return state, y

    s0 = jnp.zeros((b, h, dk, dv), jnp.float32)
    _, y = lax.scan(step, s0, (to_chunks(q), to_chunks(k), to_chunks(v),
                               to_chunks(log_f.astype(jnp.float32))))
    return jnp.moveaxis(y, 0, 1).reshape(b, l, h, dv)


def retention(q, k, v, g, positions):
    b, l, _ = q.shape
    q = q.reshape(b, l, RET_HEADS, RET_HEAD_DIM)
    k = k.reshape(b, l, RET_HEADS, RET_HEAD_DIM)
    v = v.reshape(b, l, RET_HEADS, RET_HEAD_DIM)
    cos, sin = rotary(positions)
    q = apply_rotary(q, cos, sin)
    k = apply_rotary(k, cos, sin) * (RET_HEAD_DIM ** -0.5)
    log_gamma = jnp.log(1.0 - jnp.exp2(-5.0 - jnp.arange(RET_HEADS, dtype=jnp.float32)))
    log_a = jnp.broadcast_to(log_gamma, (b, l, RET_HEADS))
    o = rms_norm(chunked_scalar_decay(q, k, v, log_a, RET_CHUNK))
    return jax.nn.silu(g.astype(jnp.float32)) * o.reshape(b, l, RET_DIM)


def hgrn2(q, f_raw, i, g, lb, norm_w):
    b, l, _ = q.shape
    f = lb + (1.0 - lb) * jax.nn.sigmoid(f_raw.astype(jnp.float32))
    log_f = jnp.log(f)
    k = 1.0 - f
    shp = (b, l, HG_HEADS, HG_HEAD_DIM)
    o = chunked_vector_decay(q.reshape(shp), k.reshape(shp), i.reshape(shp), log_f.reshape(shp), HG_CHUNK)
    o = rms_norm(o).reshape(b, l, HG_DIM) * norm_w
    return o * jax.nn.silu(g.astype(jnp.float32))


def causal_conv(u, w, bias):
    out = lax.conv_general_dilated(u, w.astype(u.dtype)[:, None, :], window_strides=(1,),
                                   padding=[(M_CONV - 1, 0)],
                                   dimension_numbers=('NWC', 'WIO', 'NWC'),
                                   feature_group_count=u.shape[-1])
    return out + bias


def mamba2(z, xbc, dt_raw, conv_w, conv_b, dt_bias, a_log, d_skip, norm_w):
    b, l, _ = z.shape
    xbc = jax.nn.silu(causal_conv(xbc, conv_w, conv_b))
    xs, bm, cm = jnp.split(xbc, [M_DIM, M_DIM + M_GROUPS * M_STATE], axis=-1)
    xs = xs.reshape(b, l, M_HEADS, M_HEAD_DIM)
    rep = M_HEADS // M_GROUPS
    bm = jnp.repeat(bm.reshape(b, l, M_GROUPS, M_STATE), rep, axis=2)
    cm = jnp.repeat(cm.reshape(b, l, M_GROUPS, M_STATE), rep, axis=2)
    dt = jax.nn.softplus(dt_raw.astype(jnp.float32) + dt_bias)
    a = -jnp.exp(a_log.astype(jnp.float32))
    y = chunked_scalar_decay(cm, bm, xs * dt[..., None], dt * a, M_CHUNK)
    y = y + xs * d_skip[:, None]
    y = y.reshape(b, l, M_DIM) * jax.nn.silu(z.astype(jnp.float32))
    y = rms_norm(y.reshape(b, l, M_GROUPS, M_DIM // M_GROUPS)).reshape(b, l, M_DIM)
    return y * norm_w


def hybrid_mixer(h, positions, lb, w_in, w_out, hg_norm_w, conv_w, conv_b, dt_bias, a_log, d_skip, m_norm_w):
    proj = h @ w_in
    idx = [int(s) for s in np.cumsum(IN_SPLITS)[:-1]]
    rq, rk, rv, rg, hq, hf, hi, hg, mz, mxbc, mdt = jnp.split(proj, idx, axis=-1)
    o_ret = retention(rq, rk, rv, rg, positions)
    o_hg = hgrn2(hq, hf, hi, hg, lb, hg_norm_w)
    o_m = mamba2(mz, mxbc, mdt, conv_w, conv_b, dt_bias, a_log, d_skip, m_norm_w)
    o = jnp.concatenate([o_ret, o_hg, o_m], axis=-1).astype(h.dtype)
    return o @ w_out


def setup_inputs(seed: int = 0) -> dict:
    key = jax.random.key(seed)
    ks = jax.random.split(key, 20)
    f32 = jnp.float32
    nrm = lambda k, shp, s: jax.random.normal(k, shp, f32) * s
    dt0 = jnp.exp(jax.random.uniform(ks[12], (DEPTH, M_HEADS), f32, math.log(1e-3), math.log(1e-1)))
    return {
        "x": nrm(ks[0], (BATCH, SEQ, D_MODEL), 1.0),
        "c": nrm(ks[1], (BATCH, D_MODEL), 1.0),
        "positions": jnp.tile(jnp.arange(SEQ, dtype=jnp.int32)[None], (BATCH, 1)),
        "lb_logits": nrm(ks[2], (DEPTH, HG_DIM), 0.1),
        "w_in": nrm(ks[3], (DEPTH, D_MODEL, IN_COLS), D_MODEL ** -0.5),
        "w_out": nrm(ks[4], (DEPTH, D_MIX, D_MODEL), D_MIX ** -0.5 * DEEPNORM_BETA),
        "w_ada": nrm(ks[5], (DEPTH, D_MODEL, N_ADA * D_MODEL), 0.3 * D_MODEL ** -0.5),
        "b_ada": nrm(ks[6], (DEPTH, N_ADA * D_MODEL), 0.02),
        "ln_g": 1.0 + nrm(ks[7], (DEPTH, 2, D_MODEL), 0.02),
        "ln_b": nrm(ks[8], (DEPTH, 2, D_MODEL), 0.02),
        "hg_norm_w": 1.0 + nrm(ks[9], (DEPTH, HG_DIM), 0.02),
        "m_conv_w": nrm(ks[10], (DEPTH, M_CONV, M_CONV_DIM), M_CONV ** -0.5),
        "m_conv_b": nrm(ks[11], (DEPTH, M_CONV_DIM), 0.02),
        "m_dt_bias": dt0 + jnp.log(-jnp.expm1(-dt0)),
        "m_a_log": jnp.log(jax.random.uniform(ks[13], (DEPTH, M_HEADS), f32, 1.0, 16.0)),
        "m_d": 1.0 + nrm(ks[14], (DEPTH, M_HEADS), 0.02),
        "m_norm_w": 1.0 + nrm(ks[15], (DEPTH, M_DIM), 0.02),
        "w1": nrm(ks[16], (DEPTH, D_MODEL, D_FF), D_MODEL ** -0.5),
        "w2": nrm(ks[17], (DEPTH, D_FF, D_MODEL), D_FF ** -0.5 * DEEPNORM_BETA),
    }


def reference(x, c, positions, lb_logits, w_in, w_out, w_ada, b_ada, ln_g, ln_b, hg_norm_w,
              m_conv_w, m_conv_b, m_dt_bias, m_a_log, m_d, m_norm_w, w1, w2):
    p = jax.nn.softmax(lb_logits.astype(jnp.float32), axis=0)
    lbs = jnp.cumsum(p, axis=0) - p[0]
    cond = jax.nn.silu(c)
    for l in range(DEPTH):
        ada = (cond @ w_ada[l] + b_ada[l])[:, None, :]
        sh_m, sc_m, g_m, sh_f, sc_f, g_f = jnp.split(ada, N_ADA, axis=-1)
        h = x * (1.0 + sc_m) + sh_m
        y = hybrid_mixer(h, positions, lbs[l], w_in[l], w_out[l], hg_norm_w[l], m_conv_w[l],
                         m_conv_b[l], m_dt_bias[l], m_a_log[l], m_d[l], m_norm_w[l])
        x = layer_norm(DEEPNORM_ALPHA * x + (1.0 + g_m) * y, ln_g[l, 0], ln_b[l, 0])
        h = x * (1.0 + sc_f) + sh_f
        y = jnp.square(jax.nn.relu(h @ w1[l])) @ w2[l]
        x = layer_norm(DEEPNORM_ALPHA * x + (1.0 + g_f) * y, ln_g[l, 1], ln_b[l, 1])
    return x
```

```cpp
#include <hip/hip_runtime.h>
#include <cstdio>
#include <cstdint>
namespace pg8 {
#define PG8_LAS __attribute__((address_space(3)))
typedef unsigned short bf16_t;
typedef short bf16x8 __attribute__((ext_vector_type(8)));
typedef float f32x4 __attribute__((ext_vector_type(4)));
typedef unsigned u32x4 __attribute__((ext_vector_type(4)));
constexpr int BM = 256, BK = 64, HALF = 128, HTB = HALF * BK * 2  , STAGE_BYTES = 8 * HTB, NXCD = 8, WGM = 8;

__host__ __device__ __forceinline__ int lds_byte(int r, int c) { const int st = (r >> 4) * 2 + (c >> 5), rr = r & 15, cc = c & 31, ob = rr * 64 + cc * 2; return st * 1024 + (ob ^ (((ob >> 9) & 1) << 5)); }
__host__ __device__ __forceinline__ void stage_rc(int b, int& R, int& C) { const int st = b / 1024, sb = b % 1024, swz = sb ^ (((sb >> 9) & 1) << 5); R = (st >> 1) * 16 + swz / 64; C = (st & 1) * 32 + (swz % 64) / 2; }
__host__ __device__ __forceinline__ int perm32(int rho) { const int n = rho >> 4, i = rho & 15; return 8 * (i >> 2) + 4 * n + (i & 3); }

struct Unit { int pm, pn; };
struct Gemm { const bf16_t* A; const bf16_t* Bt; int M, N, K; };

struct StaticOrder {
    int nM, nN, nwg, G, c;
    __host__ __device__ void init(int M, int N, int G_, int c_) { nM = M / BM; nN = N / BM; nwg = nM * nN; G = G_; c = c_; }
    __host__ __device__ bool next(int i, Unit& u) const {
        const long L = (long)i * G + c; if (L >= nwg) return false;
        int wgid = (int)L; { const int q = nwg / NXCD, r = nwg % NXCD, xcd = wgid % NXCD, off = wgid / NXCD; wgid = (xcd < r ? xcd * (q + 1) : r * (q + 1) + (xcd - r) * q) + off; }
        const int nig = WGM * nN, gid = wgid / nig, fm = gid * WGM, gsz = (nM - fm) < WGM ? (nM - fm) : WGM;
        u.pm = fm + ((wgid % nig) % gsz); u.pn = (wgid % nig) / gsz; return true;
    }
    __device__ __forceinline__ void a_ready(const Unit&) const {}
    __device__ __forceinline__ void done(const Unit&) const {}
};

typedef float f32x2 __attribute__((ext_vector_type(2)));
#define PG8_GAS __attribute__((address_space(1)))
__device__ __forceinline__ unsigned long long tab_get(PG8_LAS const unsigned char* tab, int i) {
    const unsigned long long v = ((const volatile PG8_LAS unsigned long long*)tab)[i];
    const unsigned lo = __builtin_amdgcn_readfirstlane((unsigned)v), hi = __builtin_amdgcn_readfirstlane((unsigned)(v >> 32));
    return ((unsigned long long)hi << 32) | lo;
}
__device__ __forceinline__ unsigned cvt_pk_bf16(float lo, float hi) { unsigned r; asm volatile("v_cvt_pk_bf16_f32 %0, %1, %2" : "=v"(r) : "v"(lo), "v"(hi)); return r; }

struct EpiProj {
    static constexpr bool PERM = true, AFTER_DRAIN = false;
    PG8_LAS const unsigned char* tab; size_t o_off, dt_off; int ldc; int dt_pn;
    __device__ __forceinline__ void operator()(const f32x4 (&acc)[2][2][4][2], const Unit& u, int wr, int wc, int fr, int fq) const {
        PG8_GAS unsigned char* wsb = (PG8_GAS unsigned char*)tab_get(tab, 20); PG8_GAS bf16_t* O = (PG8_GAS bf16_t*)(wsb + o_off); PG8_GAS float* dtraw = (PG8_GAS float*)(wsb + dt_off);
        const int row0 = u.pm * BM + wr * 64 + fr; const int col0 = u.pn * BM + wc * 32 + 8 * fq;
        const bool isdt = (u.pn == dt_pn) && (wc == 0) && (fq < 2);
#pragma unroll
        for (int ai = 0; ai < 2; ++ai)
#pragma unroll
            for (int m = 0; m < 4; ++m) { const int row = row0 + ai * HALF + m * 16; PG8_GAS bf16_t* rowp = O + (size_t)row * ldc + col0;
#pragma unroll
                for (int bj = 0; bj < 2; ++bj) { const f32x4 v0 = acc[ai][bj][m][0], v1 = acc[ai][bj][m][1];
                    u32x4 w; w.x = cvt_pk_bf16(v0[0], v0[1]); w.y = cvt_pk_bf16(v0[2], v0[3]); w.z = cvt_pk_bf16(v1[0], v1[1]); w.w = cvt_pk_bf16(v1[2], v1[3]);
                    *(PG8_GAS u32x4*)(rowp + bj * HALF) = w;
                    if (bj == 0 && isdt) { PG8_GAS float* dp = dtraw + (size_t)row * 16 + 8 * fq; *(PG8_GAS f32x4*)dp = v0; *(PG8_GAS f32x4*)(dp + 4) = v1; } } }
    }
};
struct EpiRelu2 {
    static constexpr bool PERM = true, AFTER_DRAIN = false;
    PG8_LAS const unsigned char* tab; size_t o_off; int ldc;
    __device__ __forceinline__ void operator()(const f32x4 (&acc)[2][2][4][2], const Unit& u, int wr, int wc, int fr, int fq) const {
        PG8_GAS bf16_t* O = (PG8_GAS bf16_t*)((PG8_GAS unsigned char*)tab_get(tab, 20) + o_off);
        const int row0 = u.pm * BM + wr * 64 + fr; const int col0 = u.pn * BM + wc * 32 + 8 * fq;
#pragma unroll
        for (int ai = 0; ai < 2; ++ai)
#pragma unroll
            for (int m = 0; m < 4; ++m) { PG8_GAS bf16_t* rowp = O + (size_t)(row0 + ai * HALF + m * 16) * ldc + col0;
#pragma unroll
                for (int bj = 0; bj < 2; ++bj) { f32x4 v0 = acc[ai][bj][m][0], v1 = acc[ai][bj][m][1];
#pragma unroll
                    for (int j = 0; j < 4; ++j) { const float a = fmaxf(v0[j], 0.f), b = fmaxf(v1[j], 0.f); v0[j] = a * a; v1[j] = b * b; }
                    u32x4 w; w.x = cvt_pk_bf16(v0[0], v0[1]); w.y = cvt_pk_bf16(v0[2], v0[3]); w.z = cvt_pk_bf16(v1[0], v1[1]); w.w = cvt_pk_bf16(v1[2], v1[3]);
                    *(PG8_GAS u32x4*)(rowp + bj * HALF) = w; } }
    }
};
struct EpiRes {
    static constexpr bool PERM = true, AFTER_DRAIN = false;
    PG8_LAS const unsigned char* tab; size_t t_off, gate_off, stat_off; int ldc, gstride, ln_idx  ; float alpha; size_t tf_off  ;
    __device__ __forceinline__ void operator()(const f32x4 (&acc)[2][2][4][2], const Unit& u, int wr, int wc, int fr, int fq) const {
        PG8_GAS unsigned char* wsb = (PG8_GAS unsigned char*)tab_get(tab, 20);
        PG8_GAS bf16_t* T = (PG8_GAS bf16_t*)(wsb + t_off); const PG8_GAS float* gate = (const PG8_GAS float*)(wsb + gate_off); const PG8_GAS float* stats = (const PG8_GAS float*)(wsb + stat_off);
        const PG8_GAS float* lng = ln_idx >= 0 ? (const PG8_GAS float*)tab_get(tab, 8) + (size_t)ln_idx * ldc : nullptr; const PG8_GAS float* lnb = ln_idx >= 0 ? (const PG8_GAS float*)tab_get(tab, 9) + (size_t)ln_idx * ldc : nullptr;
        const PG8_GAS float* xraw = (const PG8_GAS float*)tab_get(tab, 0);
        const int row0 = u.pm * BM + wr * 64 + fr, col0 = u.pn * BM + wc * 32 + 8 * fq;
        const PG8_GAS float* gp = gate + (size_t)(u.pm >> 3) * gstride + col0;
#pragma unroll
        for (int bj = 0; bj < 2; ++bj) { const int co = bj * HALF;
            const f32x4 gv0 = *(const PG8_GAS f32x4*)(gp + co) + 1.0f, gv1 = *(const PG8_GAS f32x4*)(gp + co + 4) + 1.0f;
            f32x4 lg0 = (f32x4){alpha, alpha, alpha, alpha}, lg1 = lg0, lb0 = (f32x4){0.f, 0.f, 0.f, 0.f}, lb1 = lb0;
            if (lng) { lg0 = *(const PG8_GAS f32x4*)(lng + col0 + co) * alpha; lg1 = *(const PG8_GAS f32x4*)(lng + col0 + co + 4) * alpha; lb0 = *(const PG8_GAS f32x4*)(lnb + col0 + co) * alpha; lb1 = *(const PG8_GAS f32x4*)(lnb + col0 + co + 4) * alpha; }
#pragma unroll
            for (int ai = 0; ai < 2; ++ai)
#pragma unroll
                for (int m = 0; m < 4; ++m) { const int row = row0 + ai * HALF + m * 16; const size_t off = (size_t)row * ldc + col0 + co;
                    float mu_ = 0.f, rs_ = 1.f; if (lng) { const f32x2 st = *(const PG8_GAS f32x2*)(stats + 2 * (size_t)row); mu_ = st.x; rs_ = st.y; }
                    f32x4 x0, x1;
                    if (lng) { const u32x4 tw = *(const PG8_GAS u32x4*)(T + off);
                        x0 = (f32x4){__builtin_bit_cast(float, tw.x << 16), __builtin_bit_cast(float, tw.x & 0xffff0000u), __builtin_bit_cast(float, tw.y << 16), __builtin_bit_cast(float, tw.y & 0xffff0000u)};
                        x1 = (f32x4){__builtin_bit_cast(float, tw.z << 16), __builtin_bit_cast(float, tw.z & 0xffff0000u), __builtin_bit_cast(float, tw.w << 16), __builtin_bit_cast(float, tw.w & 0xffff0000u)}; }
                    else { x0 = *(const PG8_GAS f32x4*)(xraw + off); x1 = *(const PG8_GAS f32x4*)(xraw + off + 4); }
                    const f32x4 t0 = ((x0 - mu_) * rs_) * lg0 + lb0 + gv0 * acc[ai][bj][m][0], t1 = ((x1 - mu_) * rs_) * lg1 + lb1 + gv1 * acc[ai][bj][m][1];
                    if (tf_off) { PG8_GAS float* tf = (PG8_GAS float*)(wsb + tf_off) + off; *(PG8_GAS f32x4*)tf = t0; *(PG8_GAS f32x4*)(tf + 4) = t1; }
                    else { u32x4 w; w.x = cvt_pk_bf16(t0[0], t0[1]); w.y = cvt_pk_bf16(t0[2], t0[3]); w.z = cvt_pk_bf16(t1[0], t1[1]); w.w = cvt_pk_bf16(t1[2], t1[3]);
                        *(PG8_GAS u32x4*)(T + off) = w; } }
            asm volatile("" ::: "memory"); }
    }
};

template <class Epi, class Sched, bool ALIGN_EPI = false, bool SP2 = false>
__device__ __forceinline__ void gemm_phase(PG8_LAS unsigned char* lds, const Gemm g, const Sched& S, const Epi& E) {
    int tid_l; asm volatile("v_mov_b32 %0, %1" : "=v"(tid_l) : "v"((int)threadIdx.x));
    const int tid = tid_l, wid = __builtin_amdgcn_readfirstlane(tid >> 6), lane = tid & 63, wr = wid >> 2, wc = wid & 3, fr = lane & 15, fq = lane >> 4;
    const int K = g.K, nt = K / BK;
    unsigned voffA[2], voffB[2];
#pragma unroll
    for (int i = 0; i < 2; ++i) { int R, C; stage_rc(tid * 16 + i * 8192, R, C); const int Rb = Epi::PERM ? ((R & ~31) + perm32(R & 31)) : R;
        voffA[i] = (unsigned)(R * K + C) * 2u; voffB[i] = (unsigned)(Rb * K + C) * 2u; }
    const size_t kstep = (size_t)(BK * 2);
    const size_t hstep = (size_t)HALF * K * 2;
    const size_t tstep = 2 * hstep;
    const unsigned ldsw = (unsigned)wid * 1024u;
    const int aoff = lds_byte(wr * 64 + fr, fq * 8), boff = lds_byte(wc * 32 + fr, fq * 8);
#define PG8_SA(b, h) (((b) * 2 + (h)) * HTB)
#define PG8_SB(b, h) ((4 + (b) * 2 + (h)) * HTB)
#define PG8_STAGE(bufoff, gbase, voff) do { _Pragma("unroll") for (int _i = 0; _i < 2; ++_i) \
        __builtin_amdgcn_global_load_lds((const unsigned*)((const char*)(gbase) + (voff)[_i]), (PG8_LAS unsigned*)(lds + (bufoff) + ldsw + _i * 8192), 16, 0, 0); } while (0)
#define PG8_LDA(dst, b, h) do { _Pragma("unroll") for (int m = 0; m < 4; ++m) _Pragma("unroll") for (int k = 0; k < 2; ++k) dst[m][k] = *(const PG8_LAS bf16x8*)(lds + PG8_SA(b, h) + aoff + m * 2048 + k * 1024); } while (0)
#define PG8_LDB(dst, b, h) do { _Pragma("unroll") for (int n = 0; n < 2; ++n) _Pragma("unroll") for (int k = 0; k < 2; ++k) dst[n][k] = *(const PG8_LAS bf16x8*)(lds + PG8_SB(b, h) + boff + n * 2048 + k * 1024); } while (0)
#define PG8_MMA(ai, bj, At, Bt) do { __builtin_amdgcn_s_setprio(1); _Pragma("unroll") for (int m = 0; m < 4; ++m) _Pragma("unroll") for (int n = 0; n < 2; ++n) _Pragma("unroll") for (int k = 0; k < 2; ++k) \
        acc[ai][bj][m][n] = __builtin_amdgcn_mfma_f32_16x16x32_bf16(Bt[n][k], At[m][k], acc[ai][bj][m][n], 0, 0, 0); __builtin_amdgcn_s_setprio(0); } while (0)
#define PG8_WAIT_V(n) asm volatile("s_waitcnt vmcnt(" #n ")" ::: "memory")
#define PG8_WAIT_L(n) asm volatile("s_waitcnt lgkmcnt(" #n ")" ::: "memory")
#define PG8_BAR __builtin_amdgcn_s_barrier()
#define PG8_SCHED __builtin_amdgcn_sched_barrier(0)
    Unit cur, nxt; int ui = 0;
    if (!S.next(0, cur)) return;
    f32x4 acc[2][2][4][2];
#pragma unroll
    for (int a = 0; a < 2; ++a)
#pragma unroll
        for (int b = 0; b < 2; ++b)
#pragma unroll
            for (int m = 0; m < 4; ++m)
#pragma unroll
                for (int n = 0; n < 2; ++n) acc[a][b][m][n] = (f32x4){0.f, 0.f, 0.f, 0.f};
    bf16x8 At[4][2], B0[2][2], B1[2][2];
    const char* cA = (const char*)g.A + (size_t)cur.pm * tstep; const char* cB = (const char*)g.Bt + (size_t)cur.pn * tstep;
    S.a_ready(cur);
    if constexpr (SP2) {
        PG8_STAGE(PG8_SB(0, 0), cB, voffB); PG8_STAGE(PG8_SB(0, 1), cB + hstep, voffB); PG8_STAGE(PG8_SA(0, 0), cA, voffA); PG8_STAGE(PG8_SA(0, 1), cA + hstep, voffA);
        if (wr == 1) PG8_BAR;
        PG8_WAIT_V(2); PG8_BAR;
        PG8_STAGE(PG8_SB(1, 0), cB + kstep, voffB); PG8_STAGE(PG8_SA(1, 0), cA + kstep, voffA); PG8_STAGE(PG8_SB(1, 1), cB + hstep + kstep, voffB);
        PG8_WAIT_V(6); PG8_BAR;
    } else {
        PG8_STAGE(PG8_SB(0, 0), cB, voffB); PG8_STAGE(PG8_SA(0, 0), cA, voffA); PG8_STAGE(PG8_SB(0, 1), cB + hstep, voffB); PG8_STAGE(PG8_SA(0, 1), cA + hstep, voffA);
        if (wr == 1) PG8_BAR;
        PG8_WAIT_V(4); PG8_BAR;
        PG8_STAGE(PG8_SB(1, 0), cB + kstep, voffB); PG8_STAGE(PG8_SA(1, 0), cA + kstep, voffA); PG8_STAGE(PG8_SB(1, 1), cB + hstep + kstep, voffB);
        PG8_WAIT_V(6); PG8_BAR;
    }
    for (;;) {
        const bool has_next = S.next(ui + 1, nxt);
        const char* nA = has_next ? (const char*)g.A + (size_t)nxt.pm * tstep : cA; const char* nB = has_next ? (const char*)g.Bt + (size_t)nxt.pn * tstep : cB;
        for (int t = 0; t < nt; t += 2) {
            const bool last = (t == nt - 2);
            const char* a1 = cA + (size_t)(t + 1) * kstep;
            const char* a2 = last ? nA : cA + (size_t)(t + 2) * kstep; const char* b2 = last ? nB : cB + (size_t)(t + 2) * kstep;
            const char* a3 = a2 + kstep; const char* b3 = b2 + kstep;
            if (last && has_next) S.a_ready(nxt);
            if constexpr (SP2) {
            PG8_LDB(B0, 0, 0); PG8_LDB(B1, 0, 1); PG8_SCHED; PG8_LDA(At, 0, 0); PG8_STAGE(PG8_SA(1, 1), a1 + hstep, voffA);
            PG8_WAIT_V(8); PG8_WAIT_L(0); PG8_BAR; PG8_MMA(0, 0, At, B0); PG8_MMA(0, 1, At, B1); PG8_BAR; PG8_SCHED;
            PG8_LDA(At, 0, 1); PG8_STAGE(PG8_SB(0, 0), b2, voffB); PG8_STAGE(PG8_SB(0, 1), b2 + hstep, voffB); PG8_STAGE(PG8_SA(0, 0), a2, voffA);
            PG8_WAIT_V(8); PG8_WAIT_L(0); PG8_BAR; PG8_MMA(1, 0, At, B0); PG8_MMA(1, 1, At, B1); PG8_BAR; PG8_SCHED;
            PG8_LDB(B0, 1, 0); PG8_LDB(B1, 1, 1); PG8_SCHED; PG8_LDA(At, 1, 0); PG8_STAGE(PG8_SA(0, 1), a2 + hstep, voffA);
            PG8_WAIT_V(8); PG8_WAIT_L(0); PG8_BAR; PG8_MMA(0, 0, At, B0); PG8_MMA(0, 1, At, B1); PG8_BAR; PG8_SCHED;
            PG8_LDA(At, 1, 1); PG8_STAGE(PG8_SB(1, 0), b3, voffB); PG8_STAGE(PG8_SB(1, 1), b3 + hstep, voffB); PG8_STAGE(PG8_SA(1, 0), a3, voffA);
            PG8_WAIT_V(8); PG8_WAIT_L(0); PG8_BAR; PG8_MMA(1, 0, At, B0); PG8_MMA(1, 1, At, B1); PG8_BAR; PG8_SCHED;
            } else {
            PG8_LDB(B0, 0, 0); PG8_SCHED; PG8_LDA(At, 0, 0); PG8_STAGE(PG8_SA(1, 1), a1 + hstep, voffA);
            PG8_WAIT_L(8); PG8_BAR; PG8_WAIT_L(0); PG8_MMA(0, 0, At, B0); PG8_BAR; PG8_SCHED;
            PG8_LDB(B1, 0, 1); PG8_STAGE(PG8_SB(0, 0), b2, voffB);
            PG8_BAR; PG8_WAIT_L(0); PG8_MMA(0, 1, At, B1); PG8_BAR;
            PG8_LDA(At, 0, 1); PG8_STAGE(PG8_SA(0, 0), a2, voffA);
            PG8_BAR; PG8_WAIT_L(0); PG8_MMA(1, 0, At, B0); PG8_BAR; PG8_SCHED;
            PG8_STAGE(PG8_SB(0, 1), b2 + hstep, voffB);
            PG8_WAIT_V(6); PG8_BAR; PG8_MMA(1, 1, At, B1); PG8_BAR;
            PG8_LDB(B0, 1, 0); PG8_SCHED; PG8_LDA(At, 1, 0); PG8_STAGE(PG8_SA(0, 1), a2 + hstep, voffA);
            PG8_WAIT_L(8); PG8_BAR; PG8_WAIT_L(0); PG8_MMA(0, 0, At, B0); PG8_BAR; PG8_SCHED;
            PG8_LDB(B1, 1, 1); PG8_STAGE(PG8_SB(1, 0), b3, voffB);
            PG8_BAR; PG8_WAIT_L(0); PG8_MMA(0, 1, At, B1); PG8_BAR;
            PG8_LDA(At, 1, 1); PG8_STAGE(PG8_SA(1, 0), a3, voffA);
            PG8_BAR; PG8_WAIT_L(0); PG8_MMA(1, 0, At, B0); PG8_BAR; PG8_SCHED;
            PG8_STAGE(PG8_SB(1, 1), b3 + hstep, voffB);
            PG8_WAIT_V(6); PG8_BAR; PG8_MMA(1, 1, At, B1); PG8_BAR;
            }
        }
        if constexpr (ALIGN_EPI) { if (wr == 0) PG8_BAR; }
        if constexpr (!Epi::AFTER_DRAIN) { E(acc, cur, wr, wc, fr, fq); S.done(cur); }
        if (!has_next) break;
#pragma unroll
        for (int a = 0; a < 2; ++a)
#pragma unroll
            for (int b = 0; b < 2; ++b)
#pragma unroll
                for (int m = 0; m < 4; ++m)
#pragma unroll
                    for (int n = 0; n < 2; ++n) acc[a][b][m][n] = (f32x4){0.f, 0.f, 0.f, 0.f};
        cur = nxt; cA = nA; cB = nB; ++ui;
        if constexpr (ALIGN_EPI) { if (wr == 1) PG8_BAR; }
    }
    PG8_WAIT_V(0);
    if constexpr (!ALIGN_EPI) { if (wr == 0) PG8_BAR; }
    PG8_BAR;
    if constexpr (Epi::AFTER_DRAIN) { E.fused(acc, cur, wr, wc, fr, fq, lds, wid, lane); S.done(cur); }
#undef PG8_SA
#undef PG8_SB
#undef PG8_STAGE
#undef PG8_LDA
#undef PG8_LDB
#undef PG8_MMA
#undef PG8_WAIT_V
#undef PG8_WAIT_L
#undef PG8_BAR
#undef PG8_SCHED
}
}
#ifndef PG8_SP2
#define PG8_SP2 true
#endif
#ifndef PG8_ALIGN
#define PG8_ALIGN true
#endif
#ifndef MIXER_V2
#define MIXER_V2 1
#endif
#ifndef MIXER_NAIVE
#define MIXER_NAIVE 0
#endif
#ifndef MK_PER_PHASE
#define MK_PER_PHASE 0
#endif

constexpr int NWAVES = 8;
constexpr int BATCH = 4, SEQ = 2048, D = 2048, DEPTH = 4, M = BATCH * SEQ;
constexpr int IN_COLS = 6672, NPROJ = 6912, DFF = 8192, NADA = 6 * D;
constexpr int C_RQ = 0, C_RK = 512, C_RV = 1024, C_RG = 1536, C_HQ = 2048, C_HF = 2560, C_HI = 3072, C_HG = 3584, C_MZ = 4096, C_MX = 5120, C_MB = 6144, C_MC = 6400, C_DT = 6656;
constexpr int MCONV = 1536;
constexpr float LN_EPS = 1e-5f, RMS_EPS = 1e-6f;
constexpr float ALPHA = 1.681792830507429f;
constexpr int PH_PER_LAYER = 9, N_PHASES = 2 + DEPTH * PH_PER_LAYER;

constexpr size_t MiB = 1u << 20;
constexpr size_t WS_CTL = 0, CTL_ZERO_BYTES = 1 * MiB;
constexpr size_t WS_ADA = 1 * MiB, WS_LBS = 2 * MiB, WS_DTRAW = 3 * MiB, WS_COS = 4 * MiB, WS_SIN = 6 * MiB;
constexpr size_t WS_WIN = 8 * MiB, WS_WOUT = 116 * MiB, WS_W1 = 148 * MiB, WS_W2 = 276 * MiB;
constexpr size_t WS_H = 404 * MiB, WS_Y = 436 * MiB, WS_O = 468 * MiB, WS_T = 500 * MiB, WS_X = 564 * MiB, WS_PROJ = 628 * MiB, WS_U = 736 * MiB;
constexpr size_t WS_NQ = 864 * MiB, WS_NK = 904 * MiB, WS_NV = 944 * MiB, WS_NF = 1008 * MiB, WS_NDT = 1024 * MiB, WS_NDA = 1025 * MiB, WS_END = 1026 * MiB;
static_assert(WS_WIN + (size_t)DEPTH * NPROJ * D * 2 <= WS_WOUT && WS_PROJ + (size_t)M * NPROJ * 2 <= WS_U && WS_U + (size_t)M * DFF * 2 <= WS_NQ, "d_ws map");
constexpr size_t WS_STAT = 2 * MiB + 512 * 1024;
constexpr int CW_BAR = 4096;

constexpr int LDSCTL_OFF = 0, MISC_OFF = LDSCTL_OFF + 320, LDSCTL_BYTES = 1024;
constexpr int RING_OFF = LDSCTL_BYTES, RING_BYTES = 146432;
constexpr int LDS_BYTES = 147456;

#define GAS __attribute__((address_space(1)))
#define LAS __attribute__((address_space(3)))
typedef unsigned short bf16;
typedef unsigned v4u __attribute__((ext_vector_type(4)));
typedef unsigned v2u __attribute__((ext_vector_type(2)));
typedef float f32x4 __attribute__((ext_vector_type(4)));
typedef float f32x2 __attribute__((ext_vector_type(2)));
typedef GAS unsigned gu32;
#define RLX_AGENT __ATOMIC_RELAXED, __HIP_MEMORY_SCOPE_AGENT
#define LDS_WAIT() asm volatile("s_waitcnt lgkmcnt(0)" ::: "memory")
#define VM_WAIT() asm volatile("s_waitcnt vmcnt(0)" ::: "memory")
__device__ __forceinline__ unsigned f2bf(float f) { unsigned u = __builtin_bit_cast(unsigned, f); return (u + 0x7fffu + ((u >> 16) & 1u)) >> 16; }
__device__ __forceinline__ unsigned pk2(float lo, float hi) { return f2bf(lo) | (f2bf(hi) << 16); }
__device__ __forceinline__ float bf2f(unsigned short h) { return __builtin_bit_cast(float, (unsigned)h << 16); }
__device__ __forceinline__ float bflo(unsigned w) { return __builtin_bit_cast(float, w << 16); }
__device__ __forceinline__ float bfhi(unsigned w) { return __builtin_bit_cast(float, w & 0xffff0000u); }
__device__ __forceinline__ float sigmoidf_(float x) { return __builtin_amdgcn_rcpf(1.0f + __expf(-x)); }
__device__ __forceinline__ float siluf_(float x) { return x * __builtin_amdgcn_rcpf(1.0f + __expf(-x)); }

#define XB_TMO      128
#define XB_XCNT(j)  (256  + 64 * (j))
#define XB_XSUB(j)  (1280 + 64 * (j))
#define XB_XGEN(j)  (2304 + 64 * (j))
#define XB_TOP      3328
#define XB_TOPGEN   3392
#define XCD_BAR_WORDS 3456
#define XB_SPIN_CAP (1u << 18)
__device__ __forceinline__ unsigned xb_ld(unsigned* p)              { return __hip_atomic_load(p, __ATOMIC_RELAXED, __HIP_MEMORY_SCOPE_AGENT); }
__device__ __forceinline__ unsigned xb_add(unsigned* p, unsigned v) { return __hip_atomic_fetch_add(p, v, __ATOMIC_RELAXED, __HIP_MEMORY_SCOPE_AGENT); }
__device__ __forceinline__ unsigned xb_xcc_id() { return (unsigned)__builtin_amdgcn_s_getreg((3 << 11) | 20) & 0xFu; }
#define XB_SPIN(cond, bar) do { unsigned _sp = 0; while (cond) { __builtin_amdgcn_s_sleep(1); \
    if ((++_sp & 255u) == 0u) { if (xb_ld(&(bar)[XB_TMO])) break; if (_sp > XB_SPIN_CAP) { atomicAdd(&(bar)[XB_TMO], 1u); break; } } } } while (0)
struct XcdBarrier { unsigned* bar; unsigned x; volatile LAS unsigned* st; };
__device__ __forceinline__ XcdBarrier xcd_barrier_post(unsigned* bar, volatile LAS unsigned* st) {
    XcdBarrier b; b.bar = bar; b.x = xb_xcc_id(); b.st = st;
    if (threadIdx.x == 0) (void)xb_add(&bar[XB_XCNT(b.x)], 1u);
    return b;
}
__device__ __forceinline__ void xcd_barrier_complete(unsigned* bar, unsigned x, unsigned& nloc, unsigned& nx) {
    const unsigned G = gridDim.x * gridDim.y * gridDim.z;
    unsigned sum, cnt, mine, sp = 0u;
    for (;;) {
        sum = 0u; cnt = 0u; mine = 0u;
#pragma unroll
        for (unsigned j = 0; j < 16; ++j) { const unsigned c = xb_ld(&bar[XB_XCNT(j)]); sum += c; cnt += (c > 0u) ? 1u : 0u; mine = (j == x) ? c : mine; }
        if (sum == G) break;
        __builtin_amdgcn_s_sleep(1);
        if ((++sp & 255u) == 0u) { if (xb_ld(&bar[XB_TMO])) break; if (sp > XB_SPIN_CAP) { atomicAdd(&bar[XB_TMO], 1u); break; } }
    }
    nloc = mine > 0u ? mine : 1u; nx = cnt > 0u ? cnt : 1u;
}
__device__ __forceinline__ void xcd_barrier(const XcdBarrier& b) {
    asm volatile("s_waitcnt vmcnt(0)" ::: "memory");
    __syncthreads();
    if (threadIdx.x == 0) {
        unsigned* bar = b.bar;
        __builtin_amdgcn_s_waitcnt(0);
        unsigned nloc = b.st[0], nx = b.st[1];
        if (nloc == 0u) { xcd_barrier_complete(bar, b.x, nloc, nx); b.st[0] = nloc; b.st[1] = nx; }
        const unsigned old = xb_add(&bar[XB_XSUB(b.x)], 1u);
        const unsigned gen = old / nloc;
        if (old + 1u == (gen + 1u) * nloc) {
            __builtin_amdgcn_fence(__ATOMIC_RELEASE, "agent");
            asm volatile("s_waitcnt vmcnt(0)" ::: "memory");
            const unsigned og = xb_add(&bar[XB_TOP], 1u);
            const unsigned tg = og / nx;
            if (og + 1u == (tg + 1u) * nx) xb_add(&bar[XB_TOPGEN], 1u);
            else XB_SPIN(xb_ld(&bar[XB_TOPGEN]) == tg, bar);
            __builtin_amdgcn_fence(__ATOMIC_ACQUIRE, "agent");
            xb_add(&bar[XB_XGEN(b.x)], 1u);
            asm volatile("s_waitcnt vmcnt(0)" ::: "memory");
        } else {
            XB_SPIN(xb_ld(&bar[XB_XGEN(b.x)]) == gen, bar);
            __builtin_amdgcn_fence(__ATOMIC_ACQUIRE, "agent");
            asm volatile("s_waitcnt vmcnt(0)" ::: "memory");
        }
    }
    __syncthreads();
}

struct Frame {
    LAS unsigned char* lds;
    volatile LAS unsigned* MISC;
    gu32* ctl;
    GAS unsigned char* ws;
    int tid, lane, wave, vcu, G;
};
constexpr int PTAB_OFF = MISC_OFF + 128;
enum { I_X = 0, I_C, I_POS, I_LB, I_WIN, I_WOUT, I_WADA, I_BADA, I_LNG, I_LNB, I_HGNW, I_CONVW, I_CONVB, I_DTB, I_ALOG, I_MD, I_MNW, I_W1, I_W2, I_OUT };
__device__ __forceinline__ unsigned long long ptab_get(const Frame& F, int i) {
    const unsigned long long v = ((const volatile LAS unsigned long long*)(F.lds + PTAB_OFF))[i];
    const unsigned lo = __builtin_amdgcn_readfirstlane((unsigned)v), hi = __builtin_amdgcn_readfirstlane((unsigned)(v >> 32));
    return ((unsigned long long)hi << 32) | lo;
}
#define INF(i) ((const GAS float*)ptab_get(F, (i)))
#define WSF(off) ((GAS float*)((GAS unsigned char*)F.ws + (off)))
#define WSB(off) ((GAS bf16*)((GAS unsigned char*)F.ws + (off)))

__device__ __forceinline__ float wave_sum(float v) {
#pragma unroll
    for (int o = 1; o < 64; o <<= 1) v += __shfl_xor(v, o);
    return v;
}
__device__ __forceinline__ float grp16_sum(float v) {
#pragma unroll
    for (int o = 1; o < 16; o <<= 1) v += __shfl_xor(v, o);
    return v;
}

struct TItem { const GAS float* src; GAS bf16* dst; int K, N, k0, n0; };
__device__ __forceinline__ void t_load(const TItem& d, int lane, f32x4 (&v)[16]) {
    const int r4 = lane >> 4, c4 = lane & 15;
    const bool ok = (d.n0 + 4 * c4) < d.N;
    const GAS float* src = d.src + (size_t)(d.k0 + r4) * d.N + d.n0 + 4 * c4;
#pragma unroll
    for (int i = 0; i < 16; ++i) v[i] = ok ? *(const GAS f32x4*)(src + (size_t)(4 * i) * d.N) : (f32x4){0.f, 0.f, 0.f, 0.f};
}
__device__ __forceinline__ void t_emit(const TItem& d, int lane, LAS float* scr, const f32x4 (&v)[16]) {
    const int r4 = lane >> 4, c4 = lane & 15;
#pragma unroll
    for (int i = 0; i < 16; ++i) { LAS float* q = scr + (4 * i + r4) * 65 + 4 * c4; q[0] = v[i].x; q[1] = v[i].y; q[2] = v[i].z; q[3] = v[i].w; }
    LDS_WAIT(); asm volatile("" ::: "memory");
    const int c = lane & 7;
#pragma unroll
    for (int j = 0; j < 8; ++j) { const int n = (lane >> 3) + 8 * j; const LAS float* sp = scr + (8 * c) * 65 + n;
        v4u o; o.x = pk2(sp[0 * 65], sp[1 * 65]); o.y = pk2(sp[2 * 65], sp[3 * 65]); o.z = pk2(sp[4 * 65], sp[5 * 65]); o.w = pk2(sp[6 * 65], sp[7 * 65]);
        *(GAS v4u*)(d.dst + (size_t)(d.n0 + n) * d.K + d.k0 + 8 * c) = o; }
    LDS_WAIT(); asm volatile("" ::: "memory");
}
constexpr int NB_IN = NPROJ / 64, I_IN = (D / 64) * NB_IN, NB_O = D / 64, I_O = (D / 64) * NB_O, NB_1 = DFF / 64, I_1 = (D / 64) * NB_1, NB_2 = D / 64, I_2 = (DFF / 64) * NB_2;
constexpr int L0_ITEMS = I_IN + I_O, PER_L12 = I_1 + I_2;
constexpr int TAIL_KB = 32, TAIL_N = TAIL_KB * NB_IN;
constexpr bool TAIL_WOUT = true;
constexpr int REST_L = (I_IN - TAIL_N) + (TAIL_WOUT ? 0 : I_O);
__device__ __forceinline__ TItem get_item(Frame& F, int mode, int ln, int it) {
    TItem d; int l = ln, r = it, which;
    if (mode == 0) {
        if (it < L0_ITEMS) { l = 0; if (r < I_IN) which = 0; else { which = 1; r -= I_IN; } }
        else if (it < L0_ITEMS + DEPTH * PER_L12) { l = (it - L0_ITEMS) / PER_L12; r = (it - L0_ITEMS) % PER_L12; if (r < I_1) which = 2; else { which = 3; r -= I_1; } }
        else { const int q = it - (L0_ITEMS + DEPTH * PER_L12); constexpr int RL = REST_L > 0 ? REST_L : 1; l = 1 + q / RL; r = q % RL; if (r < I_IN - TAIL_N) { which = 0; r += TAIL_N; } else { which = 1; r -= I_IN - TAIL_N; } }
    } else { if (r < TAIL_N) which = 0; else { which = 1; r -= TAIL_N; } }
    int nblk;
    if (which == 0) { d.src = INF(I_WIN) + (size_t)l * D * IN_COLS; d.dst = WSB(WS_WIN) + (size_t)l * NPROJ * D; d.K = D; d.N = IN_COLS; nblk = NB_IN; }
    else if (which == 1) { d.src = INF(I_WOUT) + (size_t)l * D * D; d.dst = WSB(WS_WOUT) + (size_t)l * D * D; d.K = D; d.N = D; nblk = NB_O; }
    else if (which == 2) { d.src = INF(I_W1) + (size_t)l * D * DFF; d.dst = WSB(WS_W1) + (size_t)l * DFF * D; d.K = D; d.N = DFF; nblk = NB_1; }
    else { d.src = INF(I_W2) + (size_t)l * DFF * D; d.dst = WSB(WS_W2) + (size_t)l * D * DFF; d.K = DFF; d.N = D; nblk = NB_2; }
    d.k0 = 64 * (r / nblk); d.n0 = 64 * (r % nblk);
    return d;
}
__device__ __forceinline__ void run_items(Frame& F, int mode, int ln, int first, int stride, int total) {
    LAS float* scr = (LAS float*)(F.lds + RING_OFF + F.wave * 16640);
    for (int it = first; it < total; it += stride) { f32x4 va[16]; const TItem da = get_item(F, mode, ln, it); t_load(da, F.lane, va); t_emit(da, F.lane, scr, va); }
}

__device__ __forceinline__ void p0_prologue(Frame& F) {
    LAS float* condS = (LAS float*)(F.lds + RING_OFF);
    LAS float* red = (LAS float*)(F.lds + RING_OFF + 32768);
    for (int i = F.tid; i < BATCH * D; i += NWAVES * 64) condS[i] = siluf_(INF(I_C)[i]);
    __syncthreads();
    for (int it = blockIdx.x; it < DEPTH * 64; it += F.G) {
        const int l = it >> 6, col0 = (it & 63) * 192;
        f32x4 acc[4];
#pragma unroll
        for (int b = 0; b < 4; ++b) acc[b] = (f32x4){0.f, 0.f, 0.f, 0.f};
        if (F.lane < 48) {
            const GAS float* wp = INF(I_WADA) + ((size_t)l * D + F.wave * 256) * NADA + col0 + 4 * F.lane;
#pragma unroll 16
            for (int k = 0; k < 256; ++k) { const f32x4 wv = *(const GAS f32x4*)(wp + (size_t)k * NADA); const int kk = F.wave * 256 + k;
#pragma unroll
                for (int b = 0; b < 4; ++b) acc[b] += wv * condS[b * D + kk]; }
#pragma unroll
            for (int b = 0; b < 4; ++b) *(LAS f32x4*)(red + (F.wave * 4 + b) * 192 + 4 * F.lane) = acc[b];
        }
        __syncthreads();
        for (int o = F.tid; o < 4 * 192; o += NWAVES * 64) { const int b = o / 192, j = o % 192; float s = INF(I_BADA)[(size_t)l * NADA + col0 + j];
#pragma unroll
            for (int w = 0; w < 8; ++w) s += red[(w * 4 + b) * 192 + j];
            WSF(WS_ADA)[((size_t)l * BATCH + b) * NADA + col0 + j] = s; }
        __syncthreads();
    }
    if (blockIdx.x == 0) {
        for (int j = F.tid; j < 512; j += NWAVES * 64) { float v[DEPTH], mx = -1e30f;
#pragma unroll
            for (int l = 0; l < DEPTH; ++l) { v[l] = INF(I_LB)[l * 512 + j]; mx = fmaxf(mx, v[l]); }
            float s = 0.f;
#pragma unroll
            for (int l = 0; l < DEPTH; ++l) { v[l] = __expf(v[l] - mx); s += v[l]; }
            float cum = 0.f; const float inv = 1.0f / s;
#pragma unroll
            for (int l = 0; l < DEPTH; ++l) { if (l > 0) cum += v[l] * inv; WSF(WS_LBS)[l * 512 + j] = cum; } }
    }
    {
        const int gt = blockIdx.x * (NWAVES * 64) + F.tid, NT = F.G * NWAVES * 64;
        for (int i = gt; i < M * 64; i += NT) { const int d = i & 63, row = i >> 6;
            const float invf = 1.0f / exp2f(((float)d * (1.0f / 63.0f)) * 13.287712379549449f);
            const float ang = (float)((const GAS int*)ptab_get(F, I_POS))[row] * invf;
            const float kq = rintf(ang * 0.15915494309189535f);
            float r = fmaf(-kq, 6.2831854820251465f, ang); r = fmaf(-kq, -1.7484555e-7f, r);
            WSF(WS_COS)[i] = __cosf(r); WSF(WS_SIN)[i] = __sinf(r); }
    }
    __syncthreads();
    run_items(F, 0, 0, F.vcu * NWAVES + F.wave, F.G * NWAVES, L0_ITEMS + DEPTH * PER_L12 + (DEPTH - 1) * REST_L);
}
__device__ __forceinline__ void convert_next_in_out(Frame& F, int ln, int rank, int nidle) {
    run_items(F, 1, ln, rank * NWAVES + F.wave, nidle * NWAVES, TAIL_N + (TAIL_WOUT ? I_O : 0));
}

__device__ __forceinline__ void mod_rows(Frame& F, const GAS float* xin, const GAS float* ada_l, int sc_chunk, int sh_chunk) {
    const int gw = F.vcu * NWAVES + F.wave, NGW = F.G * NWAVES;
    for (int row = gw; row < M; row += NGW) {
        const int b = row >> 11; const GAS float* ab = ada_l + (size_t)b * NADA;
        const GAS f32x4* xr = (const GAS f32x4*)(xin + (size_t)row * D) + F.lane;
        GAS v2u* ho = (GAS v2u*)(WSB(WS_H) + (size_t)row * D) + F.lane;
#pragma unroll
        for (int j = 0; j < 8; ++j) { const int col = 4 * (F.lane + 64 * j); const f32x4 v = xr[64 * j];
            const f32x4 sc = *(const GAS f32x4*)(ab + sc_chunk * D + col), sh = *(const GAS f32x4*)(ab + sh_chunk * D + col);
            const f32x4 h = v * (sc + 1.0f) + sh; v2u w; w.x = pk2(h.x, h.y); w.y = pk2(h.z, h.w); ho[64 * j] = w; }
    }
}
__device__ __forceinline__ void ln_rows(Frame& F, const GAS bf16* tin, const GAS float* tin32  , const GAS float* g, const GAS float* bt, GAS float* xout, GAS float* stats, const GAS float* ada_l, int sc_chunk, int sh_chunk, bool write_h) {
    const int gw = F.vcu * NWAVES + F.wave, NGW = F.G * NWAVES;
    const int per = (M + NGW - 1) / NGW, r0 = gw * per, r1 = (r0 + per < M) ? r0 + per : M;
    if (r0 >= M) return;
    const GAS float* ab = ada_l + (size_t)(r0 >> 11) * NADA;
    f32x4 G[8], B[8];
#pragma unroll
    for (int k = 0; k < 8; ++k) { const int col = 8 * (F.lane + 64 * (k >> 1)) + 4 * (k & 1); G[k] = *(const GAS f32x4*)(g + col); B[k] = *(const GAS f32x4*)(bt + col);
        if (write_h) { const f32x4 sc = *(const GAS f32x4*)(ab + sc_chunk * D + col) + 1.0f, sh = *(const GAS f32x4*)(ab + sh_chunk * D + col); G[k] = G[k] * sc; B[k] = B[k] * sc + sh; } }
    for (int rowa = r0; rowa < r1; rowa += 2) {
        const int rowb = rowa + 1; const bool hasb = rowb < r1; const int rowb_ = hasb ? rowb : rowa;
        const GAS v4u* ta = (const GAS v4u*)(tin + (size_t)rowa * D) + F.lane; const GAS v4u* tb = (const GAS v4u*)(tin + (size_t)rowb_ * D) + F.lane;
        f32x4 va[8], vb[8]; float sa = 0.f, sb = 0.f;
        if (tin32) {
            const GAS f32x4* fa = (const GAS f32x4*)(tin32 + (size_t)rowa * D) + 2 * F.lane; const GAS f32x4* fb = (const GAS f32x4*)(tin32 + (size_t)rowb_ * D) + 2 * F.lane;
#pragma unroll
            for (int j = 0; j < 4; ++j) { va[2 * j] = fa[128 * j]; va[2 * j + 1] = fa[128 * j + 1]; vb[2 * j] = fb[128 * j]; vb[2 * j + 1] = fb[128 * j + 1]; }
        } else {
        v4u wa[4], wb[4];
#pragma unroll
        for (int j = 0; j < 4; ++j) { wa[j] = ta[64 * j]; wb[j] = tb[64 * j]; }
#pragma unroll
        for (int j = 0; j < 4; ++j) {
            va[2 * j] = (f32x4){bflo(wa[j].x), bfhi(wa[j].x), bflo(wa[j].y), bfhi(wa[j].y)}; va[2 * j + 1] = (f32x4){bflo(wa[j].z), bfhi(wa[j].z), bflo(wa[j].w), bfhi(wa[j].w)};
            vb[2 * j] = (f32x4){bflo(wb[j].x), bfhi(wb[j].x), bflo(wb[j].y), bfhi(wb[j].y)}; vb[2 * j + 1] = (f32x4){bflo(wb[j].z), bfhi(wb[j].z), bflo(wb[j].w), bfhi(wb[j].w)}; }
        }
#pragma unroll
        for (int j = 0; j < 8; ++j) { sa += (va[j].x + va[j].y) + (va[j].z + va[j].w); sb += (vb[j].x + vb[j].y) + (vb[j].z + vb[j].w); }
        const float ma = wave_sum(sa) * (1.f / D), mb = wave_sum(sb) * (1.f / D); float qa = 0.f, qb = 0.f;
#pragma unroll
        for (int j = 0; j < 8; ++j) { va[j] = va[j] - ma; vb[j] = vb[j] - mb; qa += (va[j].x * va[j].x + va[j].y * va[j].y) + (va[j].z * va[j].z + va[j].w * va[j].w); qb += (vb[j].x * vb[j].x + vb[j].y * vb[j].y) + (vb[j].z * vb[j].z + vb[j].w * vb[j].w); }
        const float ra = 1.f / sqrtf(wave_sum(qa) * (1.f / D) + LN_EPS), rb = 1.f / sqrtf(wave_sum(qb) * (1.f / D) + LN_EPS);
        if (F.lane == 0) { *(GAS f32x2*)(stats + 2 * (size_t)rowa) = (f32x2){ma, ra}; if (hasb) *(GAS f32x2*)(stats + 2 * (size_t)rowb) = (f32x2){mb, rb}; }
#pragma unroll
        for (int half = 0; half < 2; ++half) {
            if (half == 1 && !hasb) break;
            const int row = half ? rowb : rowa; const float rstd = half ? rb : ra;
            GAS f32x4* xo = (GAS f32x4*)(xout + (size_t)row * D) + 2 * F.lane;
            GAS v4u* ho = (GAS v4u*)(WSB(WS_H) + (size_t)row * D) + F.lane;
#pragma unroll
            for (int j = 0; j < 4; ++j) { const f32x4 x0 = (half ? vb[2 * j] : va[2 * j]) * rstd * G[2 * j] + B[2 * j], x1 = (half ? vb[2 * j + 1] : va[2 * j + 1]) * rstd * G[2 * j + 1] + B[2 * j + 1];
                if (write_h) { v4u w; w.x = pk2(x0.x, x0.y); w.y = pk2(x0.z, x0.w); w.z = pk2(x1.x, x1.y); w.w = pk2(x1.z, x1.w); ho[64 * j] = w; }
                else { xo[128 * j] = x0; xo[128 * j + 1] = x1; } }
        }
    }
}

typedef short bf16x8 __attribute__((ext_vector_type(8)));
typedef short s16x4 __attribute__((ext_vector_type(4)));
typedef float f32x16 __attribute__((ext_vector_type(16)));
typedef __bf16 bf16x2_t __attribute__((ext_vector_type(2)));
constexpr int TS = 272;
constexpr int XS = 528;
constexpr size_t WS_QI = 864 * MiB, WS_SLR = 884 * MiB, WS_SLH = 892 * MiB, WS_SLM = 908 * MiB, WS_DECH = 924 * MiB, WS_RS = 925 * MiB, WS_CD = 926 * MiB;
constexpr int QIW = 1280;
#define MFMA32(a, b, c) __builtin_amdgcn_mfma_f32_32x32x16_bf16((a), (b), (c), 0, 0, 0)
__device__ __forceinline__ unsigned pkf(float lo, float hi) { f32x2 v = {lo, hi}; bf16x2_t b = __builtin_convertvector(v, bf16x2_t); return __builtin_bit_cast(unsigned, b); }
__device__ __forceinline__ unsigned short bf1(float x) { return (unsigned short)(pkf(x, 0.f) & 0xffffu); }
__device__ __forceinline__ void unpack8(const v4u w, float* f) { f[0] = bflo(w.x); f[1] = bfhi(w.x); f[2] = bflo(w.y); f[3] = bfhi(w.y); f[4] = bflo(w.z); f[5] = bfhi(w.z); f[6] = bflo(w.w); f[7] = bfhi(w.w); }
__device__ __forceinline__ v4u pack8(const float* f) { v4u w; w.x = pkf(f[0], f[1]); w.y = pkf(f[2], f[3]); w.z = pkf(f[4], f[5]); w.w = pkf(f[6], f[7]); return w; }
__device__ __forceinline__ int crow(int r, int hi) { return (r & 3) + 8 * (r >> 2) + 4 * hi; }
__device__ __forceinline__ bf16x8 frag_row(LAS const unsigned char* T, int stride, int r0, int k0, int lane) {
    return *(const LAS bf16x8*)(T + (r0 + (lane & 31)) * stride + (k0 + 8 * (lane >> 5)) * 2);
}
__device__ __forceinline__ bf16x8 frag_tr(LAS const unsigned char* T, int stride, int k0, int c0, int lane) {
    const int h = lane >> 5, blk = (lane >> 4) & 1, q = (lane & 15) >> 2, p = lane & 3;
    LAS unsigned char* a = (LAS unsigned char*)T + (k0 + 8 * h + q) * stride + (c0 + 16 * blk + 4 * p) * 2;
    const s16x4 lo = __builtin_amdgcn_ds_read_tr16_b64_v4i16((LAS s16x4*)a), hi = __builtin_amdgcn_ds_read_tr16_b64_v4i16((LAS s16x4*)(a + 4 * stride));
    return (bf16x8){lo[0], lo[1], lo[2], lo[3], hi[0], hi[1], hi[2], hi[3]};
}
__device__ __forceinline__ f32x16 zero16() { f32x16 z; for (int i = 0; i < 16; ++i) z[i] = 0.f; return z; }

__device__ __forceinline__ void st_acc4(GAS bf16* base, const f32x16& a) {
#pragma unroll
    for (int g = 0; g < 4; ++g) { v2u w; w.x = pkf(a[4 * g], a[4 * g + 1]); w.y = pkf(a[4 * g + 2], a[4 * g + 3]); *(GAS v2u*)(base + 8 * g) = w; }
}

__device__ __forceinline__ void pre_ret_unit(Frame& F, int u) {
    const int c = u & 15, h = (u >> 4) & 3, b = u >> 6;
    const int tid = F.tid, lane = F.lane, w = F.wave;
    LAS unsigned char* Qs = F.lds + RING_OFF; LAS unsigned char* Ks = Qs + 34816; LAS unsigned char* Vs = Ks + 34816;
    const size_t row0 = (size_t)b * SEQ + c * 128;
    const float gam = 1.0f - exp2f(-5.0f - (float)h), l2g = log2f(gam);
    {
        const int i = tid >> 2, s = tid & 3; const size_t row = row0 + i;
        const GAS bf16* pr = WSB(WS_PROJ) + row * NPROJ;
        const GAS float* cs = WSF(WS_COS) + row * 64 + 16 * s; const GAS float* sn = WSF(WS_SIN) + row * 64 + 16 * s;
        float cv[16], sv[16];
#pragma unroll
        for (int e = 0; e < 4; ++e) { const f32x4 a = *(const GAS f32x4*)(cs + 4 * e), d = *(const GAS f32x4*)(sn + 4 * e);
            cv[4 * e] = a.x; cv[4 * e + 1] = a.y; cv[4 * e + 2] = a.z; cv[4 * e + 3] = a.w; sv[4 * e] = d.x; sv[4 * e + 1] = d.y; sv[4 * e + 2] = d.z; sv[4 * e + 3] = d.w; }
#pragma unroll
        for (int t = 0; t < 2; ++t) {
            const GAS bf16* src = pr + (t ? C_RK : C_RQ) + h * 128 + 16 * s;
            float x1[16], x2[16], o1[16], o2[16];
            unpack8(*(const GAS v4u*)(src), x1); unpack8(*(const GAS v4u*)(src + 8), x1 + 8); unpack8(*(const GAS v4u*)(src + 64), x2); unpack8(*(const GAS v4u*)(src + 72), x2 + 8);
            const float sc = t ? 0.08838834764831845f : 1.0f;
#pragma unroll
            for (int e = 0; e < 16; ++e) { o1[e] = (x1[e] * cv[e] - x2[e] * sv[e]) * sc; o2[e] = (x1[e] * sv[e] + x2[e] * cv[e]) * sc; }
            LAS unsigned char* dst = (t ? Ks : Qs) + i * TS + 32 * s;
            const v4u a0 = pack8(o1), a1 = pack8(o1 + 8), b0 = pack8(o2), b1 = pack8(o2 + 8);
            *(LAS v4u*)(dst) = a0; *(LAS v4u*)(dst + 16) = a1; *(LAS v4u*)(dst + 128) = b0; *(LAS v4u*)(dst + 144) = b1;
            if (t == 0) { GAS bf16* qd = WSB(WS_QI) + row * QIW + h * 128 + 16 * s; *(GAS v4u*)(qd) = a0; *(GAS v4u*)(qd + 8) = a1; *(GAS v4u*)(qd + 64) = b0; *(GAS v4u*)(qd + 72) = b1; }
        }
        const GAS bf16* vsrc = pr + C_RV + h * 128 + 32 * s; LAS unsigned char* vd = Vs + i * TS + 64 * s;
#pragma unroll
        for (int e = 0; e < 4; ++e) *(LAS v4u*)(vd + 16 * e) = *(const GAS v4u*)(vsrc + 8 * e);
    }
    __syncthreads();
    const int rb = w >> 1, cb0 = (w & 1) * 2;
    f32x16 acc0 = zero16(), acc1 = zero16();
    if (cb0 <= rb) {
#pragma unroll
        for (int kk = 0; kk < 8; ++kk) { const bf16x8 a = frag_row(Qs, TS, rb * 32, 16 * kk, lane);
            acc0 = MFMA32(a, frag_row(Ks, TS, cb0 * 32, 16 * kk, lane), acc0);
            if (cb0 + 1 <= rb) acc1 = MFMA32(a, frag_row(Ks, TS, cb0 * 32 + 32, 16 * kk, lane), acc1); }
    }
    __syncthreads();
#pragma unroll
    for (int t = 0; t < 2; ++t) { const int cb = cb0 + t, j = cb * 32 + (lane & 31);
#pragma unroll
        for (int r = 0; r < 16; ++r) { const int i = rb * 32 + crow(r, lane >> 5); const float a = t ? acc1[r] : acc0[r];
            const float v = (cb <= rb && i >= j) ? a * exp2f((float)(i - j) * l2g) : 0.f;
            *(LAS unsigned short*)(Qs + i * TS + 2 * j) = bf1(v); } }
    {
        const int i = tid >> 2, s = tid & 3; const float f = exp2f((float)(127 - i) * l2g); LAS unsigned char* kp = Ks + i * TS + 64 * s;
#pragma unroll
        for (int e = 0; e < 4; ++e) { float x[8]; unpack8(*(LAS v4u*)(kp + 16 * e), x);
#pragma unroll
            for (int q = 0; q < 8; ++q) x[q] *= f;
            *(LAS v4u*)(kp + 16 * e) = pack8(x); }
    }
    __syncthreads();
    {
        const int pb0 = (w & 1) * 2; acc0 = zero16(); acc1 = zero16();
        for (int kk = 0; kk < 2 * (rb + 1); ++kk) { const bf16x8 a = frag_row(Qs, TS, rb * 32, 16 * kk, lane);
            acc0 = MFMA32(frag_tr(Vs, TS, 16 * kk, pb0 * 32, lane), a, acc0); acc1 = MFMA32(frag_tr(Vs, TS, 16 * kk, pb0 * 32 + 32, lane), a, acc1); }
        GAS bf16* yb = WSB(WS_Y) + (row0 + rb * 32 + (lane & 31)) * 2048 + h * 128 + pb0 * 32 + 4 * (lane >> 5);
        st_acc4(yb, acc0); st_acc4(yb + 32, acc1);
    }
    {
        const int pb = w >> 1, nb0 = (w & 1) * 2; acc0 = zero16(); acc1 = zero16();
#pragma unroll
        for (int kk = 0; kk < 8; ++kk) { const bf16x8 a = frag_tr(Vs, TS, 16 * kk, pb * 32, lane);
            acc0 = MFMA32(frag_tr(Ks, TS, 16 * kk, nb0 * 32, lane), a, acc0); acc1 = MFMA32(frag_tr(Ks, TS, 16 * kk, nb0 * 32 + 32, lane), a, acc1); }
        GAS bf16* sb = WSB(WS_SLR) + (size_t)u * 16384 + (pb * 32 + (lane & 31)) * 128 + nb0 * 32 + 4 * (lane >> 5);
        st_acc4(sb, acc0); st_acc4(sb + 32, acc1);
    }
    __syncthreads();
}

__device__ __forceinline__ void pre_hg_unit(Frame& F, int l, int u) {
    const int c = u & 31, h = (u >> 5) & 3, b = u >> 7;
    const int tid = F.tid, lane = F.lane, w = F.wave;
    LAS float* CUM = (LAS float*)(F.lds + RING_OFF);
    LAS unsigned char* Qm = F.lds + RING_OFF + 33792; LAS unsigned char* Km = Qm + 17408; LAS unsigned char* Kes = Km + 17408; LAS unsigned char* Vs = Kes + 17408;
    LAS unsigned char* Ps = Vs + 17408;
    LAS float* PT = (LAS float*)(Ps + 9216);
    const size_t row0 = (size_t)b * SEQ + c * 64;
    const int j = tid >> 3, s = tid & 7, d0 = 16 * s; const size_t row = row0 + j;
    const GAS bf16* pr = WSB(WS_PROJ) + row * NPROJ;
    float q[16], k[16];
    {
        float fr[16], lb[16];
        unpack8(*(const GAS v4u*)(pr + C_HQ + h * 128 + d0), q); unpack8(*(const GAS v4u*)(pr + C_HQ + h * 128 + d0 + 8), q + 8);
        unpack8(*(const GAS v4u*)(pr + C_HF + h * 128 + d0), fr); unpack8(*(const GAS v4u*)(pr + C_HF + h * 128 + d0 + 8), fr + 8);
        const GAS float* lbp = WSF(WS_LBS) + l * 512 + h * 128 + d0;
#pragma unroll
        for (int e = 0; e < 4; ++e) { const f32x4 a = *(const GAS f32x4*)(lbp + 4 * e); lb[4 * e] = a.x; lb[4 * e + 1] = a.y; lb[4 * e + 2] = a.z; lb[4 * e + 3] = a.w; }
        float lf[16];
#pragma unroll
        for (int e = 0; e < 16; ++e) { const float sg = sigmoidf_(fr[e]); const float f = lb[e] + (1.f - lb[e]) * sg; k[e] = (1.f - lb[e]) * (1.f - sg); lf[e] = __logf(f); }
#pragma unroll
        for (int e = 0; e < 4; ++e) *(LAS f32x4*)(CUM + j * 132 + d0 + 4 * e) = (f32x4){lf[4 * e], lf[4 * e + 1], lf[4 * e + 2], lf[4 * e + 3]};
        const GAS bf16* vsrc = pr + C_HI + h * 128 + d0; *(LAS v4u*)(Vs + j * TS + 2 * d0) = *(const GAS v4u*)(vsrc); *(LAS v4u*)(Vs + j * TS + 2 * d0 + 16) = *(const GAS v4u*)(vsrc + 8);
    }
    __syncthreads();
    {
        const int d = tid & 127, qd = tid >> 7; float loc[16], run = 0.f;
#pragma unroll
        for (int jj = 0; jj < 16; ++jj) { run += CUM[(16 * qd + jj) * 132 + d]; loc[jj] = run; }
        PT[qd * 128 + d] = run;
        __syncthreads();
        float off = 0.f;
#pragma unroll
        for (int qq = 0; qq < 3; ++qq) off += (qq < qd) ? PT[qq * 128 + d] : 0.f;
#pragma unroll
        for (int jj = 0; jj < 16; ++jj) CUM[(16 * qd + jj) * 132 + d] = loc[jj] + off;
    }
    __syncthreads();
    {
        float cum[16], mid[16], tot[16];
#pragma unroll
        for (int e = 0; e < 4; ++e) { const f32x4 a = *(const LAS f32x4*)(CUM + j * 132 + d0 + 4 * e), m4 = *(const LAS f32x4*)(CUM + 31 * 132 + d0 + 4 * e), t4 = *(const LAS f32x4*)(CUM + 63 * 132 + d0 + 4 * e);
            cum[4 * e] = a.x; cum[4 * e + 1] = a.y; cum[4 * e + 2] = a.z; cum[4 * e + 3] = a.w; mid[4 * e] = m4.x; mid[4 * e + 1] = m4.y; mid[4 * e + 2] = m4.z; mid[4 * e + 3] = m4.w;
            tot[4 * e] = t4.x; tot[4 * e + 1] = t4.y; tot[4 * e + 2] = t4.z; tot[4 * e + 3] = t4.w; }
        float qm[16], km[16], q2[16], ke[16];
#pragma unroll
        for (int e = 0; e < 16; ++e) { qm[e] = q[e] * __expf(fminf(cum[e] - mid[e], 80.f)); km[e] = k[e] * __expf(fminf(mid[e] - cum[e], 80.f)); q2[e] = q[e] * __expf(cum[e]); ke[e] = k[e] * __expf(tot[e] - cum[e]); }
        *(LAS v4u*)(Qm + j * TS + 2 * d0) = pack8(qm); *(LAS v4u*)(Qm + j * TS + 2 * d0 + 16) = pack8(qm + 8);
        *(LAS v4u*)(Km + j * TS + 2 * d0) = pack8(km); *(LAS v4u*)(Km + j * TS + 2 * d0 + 16) = pack8(km + 8);
        *(LAS v4u*)(Kes + j * TS + 2 * d0) = pack8(ke); *(LAS v4u*)(Kes + j * TS + 2 * d0 + 16) = pack8(ke + 8);
        GAS bf16* qd = WSB(WS_QI) + row * QIW + 512 + h * 128 + d0; *(GAS v4u*)(qd) = pack8(q2); *(GAS v4u*)(qd + 8) = pack8(q2 + 8);
        if (j == 0) { GAS float* dp = WSF(WS_DECH) + (size_t)u * 128 + d0;
#pragma unroll
            for (int e = 0; e < 4; ++e) *(GAS f32x4*)(dp + 4 * e) = (f32x4){__expf(tot[4 * e]), __expf(tot[4 * e + 1]), __expf(tot[4 * e + 2]), __expf(tot[4 * e + 3])}; }
    }
    __syncthreads();
    if (w < 4) {
        const int rb = w >> 1, cb = w & 1; f32x16 acc = zero16();
        if (cb <= rb) {
#pragma unroll
            for (int kk = 0; kk < 8; ++kk) acc = MFMA32(frag_row(Qm, TS, rb * 32, 16 * kk, lane), frag_row(Km, TS, cb * 32, 16 * kk, lane), acc);
        }
        const int jj = cb * 32 + (lane & 31);
#pragma unroll
        for (int r = 0; r < 16; ++r) { const int i = rb * 32 + crow(r, lane >> 5); *(LAS unsigned short*)(Ps + i * 144 + 2 * jj) = bf1((cb <= rb && i >= jj) ? acc[r] : 0.f); }
    }
    {
        const int vb = w >> 1, db0 = (w & 1) * 2; f32x16 acc0 = zero16(), acc1 = zero16();
#pragma unroll
        for (int kk = 0; kk < 4; ++kk) { const bf16x8 a = frag_tr(Vs, TS, 16 * kk, vb * 32, lane);
            acc0 = MFMA32(frag_tr(Kes, TS, 16 * kk, db0 * 32, lane), a, acc0); acc1 = MFMA32(frag_tr(Kes, TS, 16 * kk, db0 * 32 + 32, lane), a, acc1); }
        GAS bf16* sb = WSB(WS_SLH) + (size_t)u * 16384 + (vb * 32 + (lane & 31)) * 128 + db0 * 32 + 4 * (lane >> 5);
        st_acc4(sb, acc0); st_acc4(sb + 32, acc1);
    }
    __syncthreads();
    {
        const int rb = w >> 2, vb = w & 3; f32x16 acc = zero16();
        for (int kk = 0; kk < 2 * (rb + 1); ++kk) acc = MFMA32(frag_tr(Vs, TS, 16 * kk, vb * 32, lane), frag_row(Ps, 144, rb * 32, 16 * kk, lane), acc);
        st_acc4(WSB(WS_Y) + (row0 + rb * 32 + (lane & 31)) * 2048 + 512 + h * 128 + vb * 32 + 4 * (lane >> 5), acc);
    }
    __syncthreads();
}

__device__ __forceinline__ float softplus2_(float x) { return fmaxf(x, 0.f) + log1pf(__expf(-fabsf(x))); }
__device__ __forceinline__ void pre_mamba_unit(Frame& F, int l, int u) {
    const int half = u & 1, c = (u >> 1) & 15, g = (u >> 5) & 1, b = u >> 6, head0 = g * 8 + half * 4;
    const int tid = F.tid, lane = F.lane, w = F.wave;
    LAS unsigned char* Cs = F.lds + RING_OFF; LAS unsigned char* Bs = Cs + 34816; LAS unsigned char* Xs = Bs + 34816;
    LAS float* dtS = (LAS float*)(Xs + 67584); LAS float* cumS = dtS + 512; LAS float* wS = cumS + 512; LAS float* tot0 = wS + 512;
    const size_t row0 = (size_t)b * SEQ + c * 128;
    const int v4 = tid & 127, tg = tid >> 7;
    const int cch = (v4 < 32) ? 1024 + g * 128 + 4 * v4 : (v4 < 64) ? 1280 + g * 128 + 4 * (v4 - 32) : head0 * 64 + 4 * (v4 - 64);
    const GAS float* cw = INF(I_CONVW) + (size_t)l * 4 * MCONV + cch;
    const f32x4 w0 = *(const GAS f32x4*)(cw), w1 = *(const GAS f32x4*)(cw + MCONV), w2 = *(const GAS f32x4*)(cw + 2 * MCONV), w3 = *(const GAS f32x4*)(cw + 3 * MCONV), bias = *(const GAS f32x4*)(INF(I_CONVB) + (size_t)l * MCONV + cch);
    const GAS bf16* srcu = WSB(WS_PROJ) + ((ptrdiff_t)row0 - 3) * NPROJ + C_MX;
    const unsigned off0 = (unsigned)(tg * 32) * NPROJ + (unsigned)cch;
    const int tq0 = c * 128 + tg * 32;
    v2u raw[19];
#pragma unroll
    for (int q = 0; q < 3; ++q) raw[q] = (tq0 >= 3) ? *(const GAS v2u*)(srcu + (off0 + (unsigned)q * NPROJ)) : (v2u){0u, 0u};
#pragma unroll
    for (int tt = 0; tt < 16; ++tt) raw[3 + tt] = *(const GAS v2u*)(srcu + (off0 + (unsigned)(3 + tt) * NPROJ));
    float dskv[4];
#pragma unroll
    for (int hl = 0; hl < 4; ++hl) dskv[hl] = INF(I_MD)[l * 16 + head0 + hl];
    {
        const int hl = tid >> 7, j = tid & 127, head = head0 + hl;
        const float dt = softplus2_(WSF(WS_DTRAW)[(row0 + j) * 16 + head] + INF(I_DTB)[l * 16 + head]);
        float v = -__expf(INF(I_ALOG)[l * 16 + head]) * dt;
#pragma unroll
        for (int o = 1; o < 64; o <<= 1) { const float t = __shfl_up(v, o); if (lane >= o) v += t; }
        dtS[hl * 128 + j] = dt;
        if ((w & 1) == 0 && lane == 63) tot0[hl] = v;
        __syncthreads();
        if (w & 1) v += tot0[hl];
        cumS[hl * 128 + j] = v;
        __syncthreads();
        const float last = cumS[hl * 128 + 127];
        wS[hl * 128 + j] = __expf(last - v) * dt;
        WSF(WS_RS)[((size_t)b * 16 + head) * SEQ + c * 128 + j] = __expf(v);
        if (j == 127) WSF(WS_CD)[((size_t)b * 16 + head) * 16 + c] = __expf(v);
    }
    {
        GAS bf16* qiu = WSB(WS_QI) + row0 * QIW + 1024 + g * 128; const unsigned qoff0 = (unsigned)(tg * 32) * QIW + (unsigned)(4 * ((v4 - 32) & 31));
        LAS unsigned char* dst = (v4 < 32) ? Bs + 8 * v4 : (v4 < 64) ? Cs + 8 * (v4 - 32) : Xs + 8 * (v4 - 64);
        const int dstride = (v4 < 64) ? TS : XS;
        f32x4 x3 = (f32x4){bflo(raw[0].x), bfhi(raw[0].x), bflo(raw[0].y), bfhi(raw[0].y)}, x2 = (f32x4){bflo(raw[1].x), bfhi(raw[1].x), bflo(raw[1].y), bfhi(raw[1].y)}, x1 = (f32x4){bflo(raw[2].x), bfhi(raw[2].x), bflo(raw[2].y), bfhi(raw[2].y)};
#pragma unroll 1
        for (int hf = 0; hf < 2; ++hf) {
            if (hf == 1) {
#pragma unroll
                for (int tt = 0; tt < 16; ++tt) raw[3 + tt] = *(const GAS v2u*)(srcu + (off0 + (unsigned)(19 + tt) * NPROJ)); }
#pragma unroll
            for (int tt = 0; tt < 16; ++tt) { const int jj = tg * 32 + hf * 16 + tt;
                const f32x4 x0 = (f32x4){bflo(raw[3 + tt].x), bfhi(raw[3 + tt].x), bflo(raw[3 + tt].y), bfhi(raw[3 + tt].y)};
                const f32x4 a = bias + w0 * x3 + w1 * x2 + w2 * x1 + w3 * x0;
                v2u pk; pk.x = pkf(siluf_(a.x), siluf_(a.y)); pk.y = pkf(siluf_(a.z), siluf_(a.w));
                x3 = x2; x2 = x1; x1 = x0;
                *(LAS v2u*)(dst + jj * dstride) = pk;
                if (half == 0 && v4 >= 32 && v4 < 64) *(GAS v2u*)(qiu + (qoff0 + (unsigned)(hf * 16 + tt) * QIW)) = pk; }
        }
    }
    __syncthreads();
    const int rb = w >> 1, cb0 = (w & 1) * 2;
    f32x16 cbA = zero16(), cbB = zero16();
    if (cb0 <= rb) {
#pragma unroll
        for (int kk = 0; kk < 8; ++kk) { const bf16x8 a = frag_row(Cs, TS, rb * 32, 16 * kk, lane);
            cbA = MFMA32(a, frag_row(Bs, TS, cb0 * 32, 16 * kk, lane), cbA);
            if (cb0 + 1 <= rb) cbB = MFMA32(a, frag_row(Bs, TS, cb0 * 32 + 32, 16 * kk, lane), cbB); }
    }
    __syncthreads();
    for (int hl = 0; hl < 4; ++hl) {
        const int head = head0 + hl; const float dsk = (hl == 0) ? dskv[0] : (hl == 1) ? dskv[1] : (hl == 2) ? dskv[2] : dskv[3];
#pragma unroll
        for (int t = 0; t < 2; ++t) { const int cb = cb0 + t, j = cb * 32 + (lane & 31); const float cj = cumS[hl * 128 + j], dj = dtS[hl * 128 + j];
#pragma unroll
            for (int r = 0; r < 16; ++r) { const int i = rb * 32 + crow(r, lane >> 5); const float a = t ? cbB[r] : cbA[r];
                float v = (cb <= rb && i >= j) ? a * __expf(cumS[hl * 128 + i] - cj) * dj : 0.f; if (i == j) v += dsk;
                *(LAS unsigned short*)(Cs + i * TS + 2 * j) = bf1(v); } }
        __syncthreads();
        {
            const int pb = w & 1; f32x16 acc = zero16();
            for (int kk = 0; kk < 2 * (rb + 1); ++kk) acc = MFMA32(frag_tr(Xs, XS, 16 * kk, hl * 64 + pb * 32, lane), frag_row(Cs, TS, rb * 32, 16 * kk, lane), acc);
            st_acc4(WSB(WS_Y) + (row0 + rb * 32 + (lane & 31)) * 2048 + 1024 + head * 64 + pb * 32 + 4 * (lane >> 5), acc);
        }
        {
            const int pb = w >> 2, nb = w & 3; f32x16 acc = zero16();
#pragma unroll
            for (int kk = 0; kk < 8; ++kk) { const bf16x8 a = frag_tr(Xs, XS, 16 * kk, hl * 64 + pb * 32, lane);
                const LAS float* wp = wS + hl * 128 + 16 * kk + 8 * (lane >> 5); const f32x4 w0 = *(const LAS f32x4*)wp, w1 = *(const LAS f32x4*)(wp + 4);
                float x[8]; const v4u aw = __builtin_bit_cast(v4u, a); unpack8(aw, x);
                x[0] *= w0.x; x[1] *= w0.y; x[2] *= w0.z; x[3] *= w0.w; x[4] *= w1.x; x[5] *= w1.y; x[6] *= w1.z; x[7] *= w1.w;
                const v4u sw = pack8(x);
                acc = MFMA32(frag_tr(Bs, TS, 16 * kk, nb * 32, lane), __builtin_bit_cast(bf16x8, sw), acc); }
            st_acc4(WSB(WS_SLM) + (((size_t)b * 16 + head) * 16 + c) * 8192 + (pb * 32 + (lane & 31)) * 128 + nb * 32 + 4 * (lane >> 5), acc);
        }
        __syncthreads();
    }
}
__device__ __forceinline__ void mixer_pre(Frame& F, int l, int flags) {
    if (flags == 0 || (flags & 1)) for (int u = blockIdx.x; u < 256; u += F.G) pre_mamba_unit(F, l, u);
    if (flags == 0 || (flags & 2)) for (int u = blockIdx.x; u < 256; u += F.G) pre_ret_unit(F, u);
    if (flags == 0 || (flags & 4)) for (int u = blockIdx.x; u < 512; u += F.G) pre_hg_unit(F, l, u);
}

template <int MODE> __device__ __forceinline__ void lp_load(const GAS bf16* qb, const GAS bf16* yb, const GAS float* rsb, size_t rowb, int lane, bf16x8 (&A)[8], v2u (&yv)[4], float& rs) {
    const GAS bf16* qp = qb + (rowb + (lane & 31)) * QIW;
#pragma unroll
    for (int kk = 0; kk < 8; ++kk) A[kk] = *(const GAS bf16x8*)(qp + 16 * kk);
    const GAS bf16* yp = yb + (rowb + (lane & 31)) * 2048;
#pragma unroll
    for (int g = 0; g < 4; ++g) yv[g] = *(const GAS v2u*)(yp + 8 * g);
    if (MODE == 2) rs = rsb[rowb + (lane & 31)];
}
template <int MODE> __device__ __forceinline__ void loop_unit(Frame& F, int uu) {
    constexpr int NC = (MODE == 1) ? 32 : 16, CL = (MODE == 1) ? 64 : 128, PW = (MODE == 2) ? 64 : 128, RB = CL / 32, NT = 2 * RB;
    const int tid = F.tid, lane = F.lane, w = F.wave;
    int ps, hd, b;
    if (MODE == 2) { ps = uu & 1; hd = (uu >> 1) & 15; b = uu >> 5; } else { ps = uu & 3; hd = (uu >> 2) & 3; b = uu >> 4; }
    const int bh = (MODE == 2) ? b * 16 + hd : b * 4 + hd, p0 = ps * 32;
    const GAS bf16* SL = (MODE == 0) ? WSB(WS_SLR) : (MODE == 1) ? WSB(WS_SLH) : WSB(WS_SLM);
    const int qcol = (MODE == 0) ? hd * 128 : (MODE == 1) ? 512 + hd * 128 : 1024 + (hd >> 3) * 128;
    const int ycol = (MODE == 0) ? hd * 128 + p0 : (MODE == 1) ? 512 + hd * 128 + p0 : 1024 + hd * 64 + p0;
    const float gam = 1.0f - exp2f(-5.0f - (float)hd), l2g = log2f(gam), g128 = exp2f(128.f * l2g);
    LAS unsigned char* SP = F.lds + RING_OFF;
    const int p = tid >> 4, n8 = tid & 15;
    const GAS bf16* qb = WSB(WS_QI) + qcol + 8 * (lane >> 5);
    const GAS bf16* yb = WSB(WS_Y) + ycol + 4 * (lane >> 5);
    const GAS float* rsb = WSF(WS_RS) + (size_t)bh * SEQ - (size_t)b * SEQ;
    float S[8];
#pragma unroll
    for (int e = 0; e < 8; ++e) S[e] = 0.f;
    for (int pass = 0; pass < NC / 16; ++pass) {
#pragma unroll
        for (int hf = 0; hf < 2; ++hf) {
            v4u lw[8]; f32x4 dv[8][2]; float dsc[8];
#pragma unroll
            for (int cl = 0; cl < 8; ++cl) { const int c = pass * 16 + hf * 8 + cl;
                lw[cl] = *(const GAS v4u*)(SL + ((size_t)(bh * NC + c) * PW + p0 + p) * 128 + 8 * n8);
                if (MODE == 1) { const GAS float* dp = WSF(WS_DECH) + (size_t)(bh * NC + c) * 128 + 8 * n8; dv[cl][0] = *(const GAS f32x4*)dp; dv[cl][1] = *(const GAS f32x4*)(dp + 4); }
                if (MODE == 2) dsc[cl] = WSF(WS_CD)[bh * 16 + c]; }
#pragma unroll
            for (int cl = 0; cl < 8; ++cl) {
                *(LAS v4u*)(SP + (hf * 8 + cl) * 8704 + p * TS + 16 * n8) = pack8(S);
                float loc[8]; unpack8(lw[cl], loc);
                if (MODE == 1) { S[0] = S[0] * dv[cl][0].x + loc[0]; S[1] = S[1] * dv[cl][0].y + loc[1]; S[2] = S[2] * dv[cl][0].z + loc[2]; S[3] = S[3] * dv[cl][0].w + loc[3];
                    S[4] = S[4] * dv[cl][1].x + loc[4]; S[5] = S[5] * dv[cl][1].y + loc[5]; S[6] = S[6] * dv[cl][1].z + loc[6]; S[7] = S[7] * dv[cl][1].w + loc[7]; }
                else { const float dec = (MODE == 0) ? g128 : dsc[cl];
#pragma unroll
                    for (int e = 0; e < 8; ++e) S[e] = S[e] * dec + loc[e]; } }
            asm volatile("" ::: "memory");
        }
        __syncthreads();
        {
            bf16x8 A0[8], A1[8], Bf[8]; v2u y0[4], y1[4]; float r0 = 1.f, r1 = 1.f;
            lp_load<MODE>(qb, yb, rsb, (size_t)b * SEQ + (size_t)(pass * 16 + w) * CL, lane, A0, y0, r0);
#pragma unroll
            for (int t = 0; t < NT; ++t) {
                const int cl = w + 8 * (t / RB), rb = t % RB, c = pass * 16 + cl;
                const size_t rowb = (size_t)b * SEQ + (size_t)c * CL + rb * 32;
                if (t + 1 < NT) { const int cl2 = w + 8 * ((t + 1) / RB), rb2 = (t + 1) % RB; const size_t rowb2 = (size_t)b * SEQ + (size_t)(pass * 16 + cl2) * CL + rb2 * 32;
                    if (t & 1) lp_load<MODE>(qb, yb, rsb, rowb2, lane, A0, y0, r0); else lp_load<MODE>(qb, yb, rsb, rowb2, lane, A1, y1, r1); }
                asm volatile("" ::: "memory");
                if (rb == 0) {
#pragma unroll
                    for (int kk = 0; kk < 8; ++kk) Bf[kk] = frag_row(SP + cl * 8704, TS, 0, 16 * kk, lane); }
                f32x16 acc = zero16();
#pragma unroll
                for (int kk = 0; kk < 8; ++kk) acc = MFMA32(Bf[kk], (t & 1) ? A1[kk] : A0[kk], acc);
                float sc = 1.f;
                if (MODE == 0) sc = exp2f((float)(rb * 32 + (lane & 31) + 1) * l2g);
                if (MODE == 2) sc = (t & 1) ? r1 : r0;
                GAS bf16* yp = WSB(WS_Y) + (rowb + (lane & 31)) * 2048 + ycol + 4 * (lane >> 5);
#pragma unroll
                for (int g = 0; g < 4; ++g) { const v2u yy = (t & 1) ? y1[g] : y0[g]; v2u o;
                    o.x = pkf(bflo(yy.x) + sc * acc[4 * g], bfhi(yy.x) + sc * acc[4 * g + 1]); o.y = pkf(bflo(yy.y) + sc * acc[4 * g + 2], bfhi(yy.y) + sc * acc[4 * g + 3]);
                    *(GAS v2u*)(yp + 8 * g) = o; }
                asm volatile("" ::: "memory");
            }
        }
        __syncthreads();
    }
}
__device__ __forceinline__ void mixer_loop(Frame& F) {
    for (int u = blockIdx.x; u < 256; u += F.G) {
        if (u < 64) loop_unit<0>(F, u);
        else if (u < 128) loop_unit<1>(F, u - 64);
        else loop_unit<2>(F, u - 128);
    }
}

constexpr size_t WS_SPR = 928 * MiB, WS_SPH = 936 * MiB, WS_SPM = 952 * MiB;
__device__ __forceinline__ void mixer_scan(Frame& F) {
    for (int t = blockIdx.x * (NWAVES * 64) + F.tid; t < 131072; t += F.G * NWAVES * 64) {
        int mode, e;
        if (t < 32768) { mode = 0; e = t; } else if (t < 65536) { mode = 1; e = t - 32768; } else { mode = 2; e = t - 65536; }
        const int n8 = e & 15, NC = (mode == 1) ? 32 : 16, PW = (mode == 2) ? 64 : 128;
        const int p = (mode == 2) ? (e >> 4) & 63 : (e >> 4) & 127, bh = (mode == 2) ? e >> 10 : e >> 11;
        const GAS bf16* SL = ((mode == 0) ? WSB(WS_SLR) : (mode == 1) ? WSB(WS_SLH) : WSB(WS_SLM)) + ((size_t)bh * NC * PW + p) * 128 + 8 * n8;
        GAS bf16* SP = ((mode == 0) ? WSB(WS_SPR) : (mode == 1) ? WSB(WS_SPH) : WSB(WS_SPM)) + ((size_t)bh * NC * PW + p) * 128 + 8 * n8;
        const float gam = 1.0f - exp2f(-5.0f - (float)(bh & 3)), g128 = exp2f(128.f * log2f(gam));
        float S[8];
#pragma unroll
        for (int q = 0; q < 8; ++q) S[q] = 0.f;
        for (int c0 = 0; c0 < NC; c0 += 8) {
            v4u lw[8]; f32x4 dv[8][2]; float dsc[8];
#pragma unroll
            for (int cl = 0; cl < 8; ++cl) { const int c = c0 + cl;
                lw[cl] = *(const GAS v4u*)(SL + (size_t)c * PW * 128);
                dv[cl][0] = (f32x4){g128, g128, g128, g128}; dv[cl][1] = dv[cl][0]; dsc[cl] = g128;
                if (mode == 1) { const GAS float* dp = WSF(WS_DECH) + (size_t)(bh * 32 + c) * 128 + 8 * n8; dv[cl][0] = *(const GAS f32x4*)dp; dv[cl][1] = *(const GAS f32x4*)(dp + 4); }
                if (mode == 2) { dsc[cl] = WSF(WS_CD)[bh * 16 + c]; dv[cl][0] = (f32x4){dsc[cl], dsc[cl], dsc[cl], dsc[cl]}; dv[cl][1] = dv[cl][0]; } }
#pragma unroll
            for (int cl = 0; cl < 8; ++cl) {
                *(GAS v4u*)(SP + (size_t)(c0 + cl) * PW * 128) = pack8(S);
                float loc[8]; unpack8(lw[cl], loc);
                S[0] = S[0] * dv[cl][0].x + loc[0]; S[1] = S[1] * dv[cl][0].y + loc[1]; S[2] = S[2] * dv[cl][0].z + loc[2]; S[3] = S[3] * dv[cl][0].w + loc[3];
                S[4] = S[4] * dv[cl][1].x + loc[4]; S[5] = S[5] * dv[cl][1].y + loc[5]; S[6] = S[6] * dv[cl][1].z + loc[6]; S[7] = S[7] * dv[cl][1].w + loc[7]; }
        }
    }
}
__device__ __forceinline__ void up4(const v2u w, float* f) { f[0] = bflo(w.x); f[1] = bfhi(w.x); f[2] = bflo(w.y); f[3] = bfhi(w.y); }
template <int ROWS> __device__ __forceinline__ void stage_issue(v4u (&v)[ROWS / 32], const GAS bf16* src, size_t gpitch, int tid) {
#pragma unroll
    for (int k = 0; k < ROWS / 32; ++k) { const int q = tid + 512 * k; v[k] = *(const GAS v4u*)(src + (size_t)(q >> 4) * gpitch + 8 * (q & 15)); }
}
template <int ROWS> __device__ __forceinline__ void stage_land(const v4u (&v)[ROWS / 32], LAS unsigned char* dst, int tid) {
#pragma unroll
    for (int k = 0; k < ROWS / 32; ++k) { const int q = tid + 512 * k; *(LAS v4u*)(dst + (q >> 4) * TS + 16 * (q & 15)) = v[k]; }
}
template <int ROWS> __device__ __forceinline__ void unstage_rows(GAS bf16* dst, const LAS unsigned char* src, size_t gpitch, int tid) {
    v4u v[ROWS / 32];
#pragma unroll
    for (int k = 0; k < ROWS / 32; ++k) { const int q = tid + 512 * k; v[k] = *(const LAS v4u*)(src + (q >> 4) * TS + 16 * (q & 15)); }
#pragma unroll
    for (int k = 0; k < ROWS / 32; ++k) { const int q = tid + 512 * k; *(GAS v4u*)(dst + (size_t)(q >> 4) * gpitch + 8 * (q & 15)) = v[k]; }
}
template <bool HG> __device__ __forceinline__ void ip_rh_unit(Frame& F, int l, int u) {
    constexpr int NT = HG ? 64 : 128;
    const int c = HG ? (u & 31) : (u & 15), h = HG ? (u >> 5) & 3 : (u >> 4) & 3, b = HG ? u >> 7 : u >> 6, tid = F.tid, lane = F.lane, w = F.wave;
    const int hi = lane >> 5, li = lane & 31;
    LAS unsigned char* Qs = F.lds + RING_OFF + 1024; LAS unsigned char* Ss = Qs + 34816; LAS unsigned char* Ys = Ss + 34816; LAS unsigned char* Gs = Ys + 34816;
    LAS float* part = (LAS float*)(F.lds + RING_OFF);
    const size_t row0 = (size_t)b * SEQ + (size_t)c * NT;
    const int ccol = (HG ? 512 : 0) + h * 128;
    {
        v4u vq[NT / 32], vs[4], vy[NT / 32], vg[NT / 32];
        stage_issue<NT>(vq, WSB(WS_QI) + row0 * QIW + ccol, QIW, tid);
        stage_issue<128>(vs, (HG ? WSB(WS_SPH) : WSB(WS_SPR)) + (size_t)u * 16384, 128, tid);
        stage_issue<NT>(vy, WSB(WS_Y) + row0 * 2048 + ccol, 2048, tid);
        stage_issue<NT>(vg, WSB(WS_PROJ) + row0 * NPROJ + (HG ? C_HG : C_RG) + h * 128, NPROJ, tid);
        stage_land<NT>(vq, Qs, tid); stage_land<128>(vs, Ss, tid); stage_land<NT>(vy, Ys, tid); stage_land<NT>(vg, Gs, tid);
    }
    __syncthreads();
    constexpr int TPW = HG ? 1 : 2;
    const int rb = HG ? w >> 2 : w >> 1, pb0 = HG ? (w & 3) : (w & 1) * 2;
    f32x16 acc[TPW];
#pragma unroll
    for (int t = 0; t < TPW; ++t) acc[t] = zero16();
#pragma unroll
    for (int kk = 0; kk < 8; ++kk) { const bf16x8 bq = frag_row(Qs, TS, rb * 32, 16 * kk, lane);
#pragma unroll
        for (int t = 0; t < TPW; ++t) acc[t] = MFMA32(frag_row(Ss, TS, (pb0 + t) * 32, 16 * kk, lane), bq, acc[t]); }
    const float gam = 1.0f - exp2f(-5.0f - (float)h), sc = HG ? 1.0f : exp2f((float)(rb * 32 + li + 1) * log2f(gam));
    float yv[TPW][16], ss = 0.f;
    LAS unsigned char* yl = Ys + (rb * 32 + li) * TS + (pb0 * 32 + 4 * hi) * 2;
    const LAS unsigned char* gl = Gs + (rb * 32 + li) * TS + (pb0 * 32 + 4 * hi) * 2;
#pragma unroll
    for (int t = 0; t < TPW; ++t)
#pragma unroll
        for (int g = 0; g < 4; ++g) { float a[4]; up4(*(const LAS v2u*)(yl + t * 64 + 16 * g), a);
#pragma unroll
            for (int e = 0; e < 4; ++e) { yv[t][4 * g + e] = a[e] + sc * acc[t][4 * g + e]; ss += yv[t][4 * g + e] * yv[t][4 * g + e]; } }
    ss += __shfl_xor(ss, 32);
    if (hi == 0) part[w * 32 + li] = ss;
    __syncthreads();
    float tot;
    if (HG) { const int wb = w & 4; tot = (part[wb * 32 + li] + part[(wb + 1) * 32 + li]) + (part[(wb + 2) * 32 + li] + part[(wb + 3) * 32 + li]); }
    else tot = part[w * 32 + li] + part[(w ^ 1) * 32 + li];
    const float r = 1.f / sqrtf(tot * (1.f / 128.f) + RMS_EPS);
    const GAS float* wp = INF(I_HGNW) + l * 512 + h * 128 + pb0 * 32 + 4 * hi;
#pragma unroll
    for (int t = 0; t < TPW; ++t)
#pragma unroll
        for (int g = 0; g < 4; ++g) { float a[4]; up4(*(const LAS v2u*)(gl + t * 64 + 16 * g), a);
            f32x4 nw = (f32x4){1.f, 1.f, 1.f, 1.f}; if (HG) nw = *(const GAS f32x4*)(wp + t * 32 + 8 * g);
            v2u o; o.x = pkf(yv[t][4 * g] * r * nw.x * siluf_(a[0]), yv[t][4 * g + 1] * r * nw.y * siluf_(a[1])); o.y = pkf(yv[t][4 * g + 2] * r * nw.z * siluf_(a[2]), yv[t][4 * g + 3] * r * nw.w * siluf_(a[3]));
            *(LAS v2u*)(yl + t * 64 + 16 * g) = o; }
    __syncthreads();
    unstage_rows<NT>(WSB(WS_O) + row0 * 2048 + ccol, Ys, 2048, tid);
    __syncthreads();
}
struct MTile { bf16x8 A[8]; v2u y[4], z[4]; float rs; };
__device__ __forceinline__ void ip_m_load(MTile& T, const GAS bf16* spb, const GAS bf16* ypb, const GAS bf16* zpb, const GAS float* rsp, int head, int pb, int c, int b, int li, int hi) {
    const GAS bf16* sp = spb + (((size_t)(b * 16 + head) * 16 + c) * 64 + pb * 32 + li) * 128 + 8 * hi;
#pragma unroll
    for (int kk = 0; kk < 8; ++kk) T.A[kk] = *(const GAS bf16x8*)(sp + 16 * kk);
    const GAS bf16* yp = ypb + head * 64 + pb * 32; const GAS bf16* zp = zpb + head * 64 + pb * 32;
#pragma unroll
    for (int g = 0; g < 4; ++g) { T.y[g] = *(const GAS v2u*)(yp + 8 * g); T.z[g] = *(const GAS v2u*)(zp + 8 * g); }
    T.rs = rsp[(size_t)(b * 16 + head) * SEQ];
}
__device__ __forceinline__ void ip_mamba_unit(Frame& F, int l, int u) {
    const int c = u & 15, g = (u >> 4) & 1, b = u >> 5, lane = F.lane, w = F.wave;
    const int rb = w >> 1, hh = w & 1, hi = lane >> 5, li = lane & 31;
    const int tok = c * 128 + rb * 32 + li; const size_t row = (size_t)b * SEQ + tok;
    LAS float* part = (LAS float*)(F.lds + RING_OFF);
    const GAS bf16* qp = WSB(WS_QI) + row * QIW + 1024 + g * 128 + 8 * hi;
    bf16x8 Bc[8];
#pragma unroll
    for (int kk = 0; kk < 8; ++kk) Bc[kk] = *(const GAS bf16x8*)(qp + 16 * kk);
    const GAS bf16* spb = WSB(WS_SPM); const GAS bf16* ypb = WSB(WS_Y) + row * 2048 + 1024 + 4 * hi; const GAS bf16* zpb = WSB(WS_PROJ) + row * NPROJ + C_MZ + 4 * hi; const GAS float* rsp = WSF(WS_RS) + tok;
    const int head0 = g * 8 + hh * 4;
    LAS unsigned char* keepS = F.lds + RING_OFF + 1024 + w * 16384 + lane * 32;
    float ss = 0.f;
    MTile T0, T1;
    ip_m_load(T0, spb, ypb, zpb, rsp, head0, 0, c, b, li, hi);
#pragma unroll
    for (int t = 0; t < 8; ++t) {
        if (t + 1 < 8) { if (t & 1) ip_m_load(T0, spb, ypb, zpb, rsp, head0 + ((t + 1) >> 1), (t + 1) & 1, c, b, li, hi); else ip_m_load(T1, spb, ypb, zpb, rsp, head0 + ((t + 1) >> 1), (t + 1) & 1, c, b, li, hi); }
        asm volatile("" ::: "memory");
        f32x16 acc = zero16();
#pragma unroll
        for (int kk = 0; kk < 8; ++kk) acc = MFMA32((t & 1) ? T1.A[kk] : T0.A[kk], Bc[kk], acc);
        const float sc = (t & 1) ? T1.rs : T0.rs;
        v2u kq[4];
#pragma unroll
        for (int q = 0; q < 4; ++q) { float a[4], z[4]; up4((t & 1) ? T1.y[q] : T0.y[q], a); up4((t & 1) ? T1.z[q] : T0.z[q], z); float v[4];
#pragma unroll
            for (int e = 0; e < 4; ++e) { v[e] = (a[e] + sc * acc[4 * q + e]) * siluf_(z[e]); ss += v[e] * v[e]; }
            kq[q].x = pkf(v[0], v[1]); kq[q].y = pkf(v[2], v[3]); }
        *(LAS v4u*)(keepS + t * 2048) = (v4u){kq[0].x, kq[0].y, kq[1].x, kq[1].y}; *(LAS v4u*)(keepS + t * 2048 + 16) = (v4u){kq[2].x, kq[2].y, kq[3].x, kq[3].y};
        asm volatile("" ::: "memory");
    }
    ss += __shfl_xor(ss, 32);
    if (hi == 0) part[w * 32 + li] = ss;
    __syncthreads();
    const float r = 1.f / sqrtf((part[w * 32 + li] + part[(w ^ 1) * 32 + li]) * (1.f / 512.f) + RMS_EPS);
    GAS bf16* opb = WSB(WS_O) + row * 2048 + 1024 + 4 * hi; const GAS float* nwb = INF(I_MNW) + l * 1024 + 4 * hi;
#pragma unroll
    for (int t = 0; t < 8; ++t) { const int ch = (head0 + (t >> 1)) * 64 + (t & 1) * 32;
        const v4u k0 = *(const LAS v4u*)(keepS + t * 2048), k1 = *(const LAS v4u*)(keepS + t * 2048 + 16);
        const v2u kk4[4] = {(v2u){k0.x, k0.y}, (v2u){k0.z, k0.w}, (v2u){k1.x, k1.y}, (v2u){k1.z, k1.w}};
#pragma unroll
        for (int q = 0; q < 4; ++q) { float v[4]; up4(kk4[q], v); const f32x4 nw = *(const GAS f32x4*)(nwb + ch + 8 * q); v2u o;
            o.x = pkf(v[0] * r * nw.x, v[1] * r * nw.y); o.y = pkf(v[2] * r * nw.z, v[3] * r * nw.w); *(GAS v2u*)(opb + ch + 8 * q) = o; } }
    __syncthreads();
}
__device__ __forceinline__ void mixer_interpost(Frame& F, int l) {
    const int G = F.G, bx = blockIdx.x, halfG = G / 2;
    if (bx < halfG) { for (int u = bx; u < 128; u += halfG) ip_mamba_unit(F, l, u); }
    else { const int r = bx - halfG, n2 = G - halfG;
        for (int u = r; u < 256; u += n2) ip_rh_unit<false>(F, l, u);
        for (int u = r; u < 512; u += n2) ip_rh_unit<true>(F, l, u); }
}
__device__ __forceinline__ float softplusf_(float x) { return fmaxf(x, 0.f) + log1pf(__expf(-fabsf(x))); }
__device__ __forceinline__ void npre_rows(Frame& F, int l) {
    const int gw = F.vcu * NWAVES + F.wave, NGW = F.G * NWAVES, lane = F.lane;
    for (int row = gw; row < M; row += NGW) {
        const int t = row & (SEQ - 1);
        const GAS bf16* pr = WSB(WS_PROJ) + (size_t)row * NPROJ;
        GAS float* nq = WSF(WS_NQ) + (size_t)row * 1280; GAS float* nk = WSF(WS_NK) + (size_t)row * 1280; GAS float* nv = WSF(WS_NV) + (size_t)row * 2048;
        const float cs = WSF(WS_COS)[(size_t)row * 64 + lane], sn = WSF(WS_SIN)[(size_t)row * 64 + lane];
#pragma unroll
        for (int h = 0; h < 4; ++h) {
            const float q1 = bf2f(pr[C_RQ + h * 128 + lane]), q2 = bf2f(pr[C_RQ + h * 128 + 64 + lane]);
            const float k1 = bf2f(pr[C_RK + h * 128 + lane]) * 0.08838834764831845f, k2 = bf2f(pr[C_RK + h * 128 + 64 + lane]) * 0.08838834764831845f;
            nq[h * 128 + lane] = q1 * cs - q2 * sn; nq[h * 128 + 64 + lane] = q1 * sn + q2 * cs;
            nk[h * 128 + lane] = k1 * cs - k2 * sn; nk[h * 128 + 64 + lane] = k1 * sn + k2 * cs;
        }
#pragma unroll
        for (int j = 0; j < 8; ++j) { const int c = lane + 64 * j; nv[c] = bf2f(pr[C_RV + c]);
            const float lb = WSF(WS_LBS)[l * 512 + c], sg = sigmoidf_(bf2f(pr[C_HF + c])), f = lb + (1.f - lb) * sg;
            WSF(WS_NF)[(size_t)row * 512 + c] = f; nk[512 + c] = (1.f - lb) * (1.f - sg); nq[512 + c] = bf2f(pr[C_HQ + c]); nv[512 + c] = bf2f(pr[C_HI + c]); }
        for (int j = 0; j < 24; ++j) { const int ch = lane + 64 * j; float acc = INF(I_CONVB)[l * MCONV + ch];
#pragma unroll
            for (int k = 0; k < 4; ++k) { const int tt = t - 3 + k; if (tt >= 0) acc += INF(I_CONVW)[(l * 4 + k) * MCONV + ch] * bf2f(WSB(WS_PROJ)[(size_t)(row - 3 + k) * NPROJ + C_MX + ch]); }
            const float a = siluf_(acc);
            if (ch < 1024) nv[1024 + ch] = a; else if (ch < 1280) nk[1024 + ch - 1024] = a; else nq[1024 + ch - 1280] = a; }
        if (lane < 16) { const float dt = softplusf_(WSF(WS_DTRAW)[(size_t)row * 16 + lane] + INF(I_DTB)[l * 16 + lane]);
            WSF(WS_NDT)[(size_t)row * 16 + lane] = dt; WSF(WS_NDA)[(size_t)row * 16 + lane] = __expf(-__expf(INF(I_ALOG)[l * 16 + lane]) * dt); }
    }
}
template <int MODE> __device__ __forceinline__ void nscan(Frame& F, int l, int b, int hd, int half) {
    const int lane = F.lane;
    LAS float* kS = (LAS float*)(F.lds + RING_OFF + F.wave * 12288); LAS float* qS = kS + 1024; LAS float* fS = kS + 2048;
    const int kb = (MODE == 0) ? hd * 128 : (MODE == 1) ? 512 + hd * 128 : 1024 + (hd >> 3) * 128;
    const int vc = (MODE == 0) ? hd * 128 + half * 64 + lane : (MODE == 1) ? 512 + hd * 128 + half * 64 + lane : 1024 + hd * 64 + lane;
    const float gamma = 1.0f - exp2f(-5.0f - (float)hd);
    const float dsk = (MODE == 2) ? INF(I_MD)[l * 16 + hd] : 0.f;
    float S[128];
#pragma unroll
    for (int n = 0; n < 128; ++n) S[n] = 0.f;
    for (int t0 = 0; t0 < SEQ; t0 += 8) {
        const size_t row0 = (size_t)b * SEQ + t0;
#pragma unroll
        for (int tt = 0; tt < 8; ++tt) {
            *(LAS f32x2*)(kS + tt * 128 + 2 * lane) = *(const GAS f32x2*)(WSF(WS_NK) + (row0 + tt) * 1280 + kb + 2 * lane);
            *(LAS f32x2*)(qS + tt * 128 + 2 * lane) = *(const GAS f32x2*)(WSF(WS_NQ) + (row0 + tt) * 1280 + kb + 2 * lane);
            if (MODE == 1) *(LAS f32x2*)(fS + tt * 128 + 2 * lane) = *(const GAS f32x2*)(WSF(WS_NF) + (row0 + tt) * 512 + hd * 128 + 2 * lane);
        }
        LDS_WAIT(); asm volatile("" ::: "memory");
        for (int tt = 0; tt < 8; ++tt) {
            const size_t row = row0 + tt;
            const float v = WSF(WS_NV)[row * 2048 + vc];
            float dec = gamma, vv = v;
            if (MODE == 2) { dec = WSF(WS_NDA)[row * 16 + hd]; vv = v * WSF(WS_NDT)[row * 16 + hd]; }
            float o = 0.f;
#pragma unroll
            for (int n4 = 0; n4 < 32; ++n4) {
                const f32x4 k4 = *(const LAS f32x4*)(kS + tt * 128 + 4 * n4), q4 = *(const LAS f32x4*)(qS + tt * 128 + 4 * n4);
                f32x4 f4 = (f32x4){dec, dec, dec, dec};
                if (MODE == 1) f4 = *(const LAS f32x4*)(fS + tt * 128 + 4 * n4);
#pragma unroll
                for (int i = 0; i < 4; ++i) { S[4 * n4 + i] = S[4 * n4 + i] * f4[i] + k4[i] * vv; o += S[4 * n4 + i] * q4[i]; }
            }
            if (MODE == 2) o += dsk * v;
            WSB(WS_Y)[row * 2048 + vc] = (bf16)f2bf(o);
        }
        LDS_WAIT(); asm volatile("" ::: "memory");
    }
}
__device__ __forceinline__ void nloop(Frame& F, int l) {
    const int gw = blockIdx.x * NWAVES + F.wave, NGW = F.G * NWAVES;
    const int stride = NGW >= 128 ? NGW / 128 : 1;
    for (int u = 0; u < 128; ++u) {
        if ((u * stride) % NGW != gw) continue;
        if (u < 32) nscan<0>(F, l, u >> 3, (u >> 1) & 3, u & 1);
        else if (u < 64) { const int v = u - 32; nscan<1>(F, l, v >> 3, (v >> 1) & 3, v & 1); }
        else { const int v = u - 64; nscan<2>(F, l, v >> 4, v & 15, 0); }
    }
}
__device__ __forceinline__ void post_rows(Frame& F, int l) {
    const int gw = F.vcu * NWAVES + F.wave, NGW = F.G * NWAVES, lane = F.lane;
    const GAS float* hgw = INF(I_HGNW) + l * 512 + 8 * lane; const GAS float* mnw = INF(I_MNW) + l * 1024 + 8 * lane;
    const GAS bf16* Yb = WSB(WS_Y); const GAS bf16* Pb = WSB(WS_PROJ); GAS bf16* Ob = WSB(WS_O);
    float wv[3][8];
    { const f32x4 a = *(const GAS f32x4*)hgw, b4 = *(const GAS f32x4*)(hgw + 4), c4 = *(const GAS f32x4*)mnw, d4 = *(const GAS f32x4*)(mnw + 4), e4 = *(const GAS f32x4*)(mnw + 512), f4 = *(const GAS f32x4*)(mnw + 516);
      wv[0][0] = a.x; wv[0][1] = a.y; wv[0][2] = a.z; wv[0][3] = a.w; wv[0][4] = b4.x; wv[0][5] = b4.y; wv[0][6] = b4.z; wv[0][7] = b4.w;
      wv[1][0] = c4.x; wv[1][1] = c4.y; wv[1][2] = c4.z; wv[1][3] = c4.w; wv[1][4] = d4.x; wv[1][5] = d4.y; wv[1][6] = d4.z; wv[1][7] = d4.w;
      wv[2][0] = e4.x; wv[2][1] = e4.y; wv[2][2] = e4.z; wv[2][3] = e4.w; wv[2][4] = f4.x; wv[2][5] = f4.y; wv[2][6] = f4.z; wv[2][7] = f4.w; }
    for (int row = gw; row < M; row += NGW) {
        const GAS bf16* yr = Yb + (size_t)row * 2048 + 8 * lane; const GAS bf16* pr = Pb + (size_t)row * NPROJ + 8 * lane; GAS bf16* orow = Ob + (size_t)row * 2048 + 8 * lane;
        v4u yw[4], gq[4];
#pragma unroll
        for (int j = 0; j < 4; ++j) yw[j] = *(const GAS v4u*)(yr + 512 * j);
        gq[0] = *(const GAS v4u*)(pr + C_RG); gq[1] = *(const GAS v4u*)(pr + C_HG); gq[2] = *(const GAS v4u*)(pr + C_MZ); gq[3] = *(const GAS v4u*)(pr + C_MZ + 512);
#pragma unroll
        for (int j = 0; j < 4; ++j) {
            float y[8], g[8], o[8]; unpack8(yw[j], y); unpack8(gq[j], g);
            if (j < 2) {
                float ss = 0.f;
#pragma unroll
                for (int e = 0; e < 8; ++e) ss += y[e] * y[e];
                ss = grp16_sum(ss);
                const float r = 1.f / sqrtf(ss * (1.f / 128.f) + RMS_EPS);
#pragma unroll
                for (int e = 0; e < 8; ++e) o[e] = y[e] * r * (j == 1 ? wv[0][e] : 1.f) * siluf_(g[e]);
            } else {
                float ss = 0.f;
#pragma unroll
                for (int e = 0; e < 8; ++e) { y[e] = y[e] * siluf_(g[e]); ss += y[e] * y[e]; }
                ss = wave_sum(ss);
                const float r = 1.f / sqrtf(ss * (1.f / 512.f) + RMS_EPS);
#pragma unroll
                for (int e = 0; e < 8; ++e) o[e] = y[e] * r * wv[j - 1][e];
            }
            *(GAS v4u*)(orow + 512 * j) = pack8(o);
        }
    }
}

struct Args { const void* in[19]; float* out; unsigned char* ws; int ph_lo, ph_hi, flags, pad; };
__global__ void __launch_bounds__(NWAVES * 64, 2) hymba_fwd(Args args) {
    extern __shared__ __attribute__((aligned(16))) unsigned char lds[];
    Frame F;
    F.lds = (LAS unsigned char*)lds;
    F.MISC = (volatile LAS unsigned*)(F.lds + MISC_OFF);
    F.tid = threadIdx.x; F.lane = F.tid & 63; F.wave = __builtin_amdgcn_readfirstlane(F.tid >> 6);
    F.G = gridDim.x; { const int bx = blockIdx.x; F.vcu = (F.G % 8 == 0) ? (bx % 8) * (F.G / 8) + bx / 8 : bx; }
    F.ws = (GAS unsigned char*)args.ws;
    F.ctl = (gu32*)(args.ws + WS_CTL);
    for (int u = F.tid; u < LDSCTL_BYTES / 4; u += NWAVES * 64) ((LAS unsigned*)(F.lds + LDSCTL_OFF))[u] = 0u;
    __syncthreads();
    if (F.tid == 0) {
#pragma unroll
        for (int i = 0; i < 19; ++i) ((LAS unsigned long long*)(F.lds + PTAB_OFF))[i] = (unsigned long long)args.in[i];
        ((LAS unsigned long long*)(F.lds + PTAB_OFF))[19] = (unsigned long long)args.out;
        ((LAS unsigned long long*)(F.lds + PTAB_OFF))[20] = (unsigned long long)args.ws;
    }
    __syncthreads();
    const int lo = args.ph_lo, hi = args.ph_hi;
    XcdBarrier bar; bar.bar = (unsigned*)(F.ctl + CW_BAR); bar.x = 0; bar.st = nullptr;
    if (hi - lo > 1) bar = xcd_barrier_post((unsigned*)(F.ctl + CW_BAR), F.MISC + 8);
    int ph = 0;
#define PHASE_BEGIN if (ph >= lo && ph < hi) { { int t_; asm volatile("v_mov_b32 %0, %1" : "=v"(t_) : "v"((int)threadIdx.x)); F.tid = t_; F.lane = t_ & 63; F.wave = __builtin_amdgcn_readfirstlane(t_ >> 6); }
#define PHASE_END   if (ph + 1 < hi) xcd_barrier(bar); } ++ph;

    PHASE_BEGIN
#ifndef X_NO_PRO
 p0_prologue(F);
#endif
 PHASE_END
    PHASE_BEGIN
#ifndef X_NO_LN
 mod_rows(F, INF(I_X), WSF(WS_ADA), 1, 0);
#endif
 PHASE_END
    for (int l = 0; l < DEPTH; ++l) {
        const GAS float* ada_l = WSF(WS_ADA) + (size_t)l * BATCH * NADA;
        PHASE_BEGIN
#ifndef X_NO_GIN
{
            pg8::Gemm g{(const pg8::bf16_t*)WSB(WS_H), (const pg8::bf16_t*)(WSB(WS_WIN) + (size_t)l * NPROJ * D), M, NPROJ, D}; pg8::StaticOrder S; S.init(M, NPROJ, F.G, (int)blockIdx.x);
            pg8::EpiProj E{F.lds + PTAB_OFF, WS_PROJ, WS_DTRAW, NPROJ, C_DT / 256};
            pg8::gemm_phase<pg8::EpiProj, pg8::StaticOrder, PG8_ALIGN, PG8_SP2>(F.lds + RING_OFF, g, S, E);
            constexpr int NU = (M / 256) * (NPROJ / 256); const int full = NU / F.G, rem = NU % F.G;
            if (l + 1 < DEPTH) { if (rem != 0 && (int)blockIdx.x >= rem) convert_next_in_out(F, l + 1, (int)blockIdx.x - rem, F.G - rem); else if (rem == 0) convert_next_in_out(F, l + 1, (int)blockIdx.x, F.G); }
            (void)full;
        }
#endif
 PHASE_END
        PHASE_BEGIN
#if MIXER_NAIVE
 npre_rows(F, l);
#else
 mixer_pre(F, l, args.flags);
#endif
 PHASE_END
        PHASE_BEGIN
#if MIXER_NAIVE
 nloop(F, l);
#elif MIXER_V2
 mixer_scan(F);
#else
 mixer_loop(F);
#endif
 PHASE_END
        PHASE_BEGIN
#if MIXER_V2 && !MIXER_NAIVE
 mixer_interpost(F, l);
#else
 post_rows(F, l);
#endif
 PHASE_END
        PHASE_BEGIN
#ifndef X_NO_GOUT
{
            pg8::Gemm g{(const pg8::bf16_t*)WSB(WS_O), (const pg8::bf16_t*)(WSB(WS_WOUT) + (size_t)l * D * D), M, D, D}; pg8::StaticOrder S; S.init(M, D, F.G, (int)blockIdx.x);
            pg8::EpiRes E{F.lds + PTAB_OFF, WS_T, WS_ADA + ((size_t)l * BATCH * NADA + 2 * D) * 4, WS_STAT, D, NADA, l == 0 ? -1 : l * 2 - 1, ALPHA, (size_t)0};
            pg8::gemm_phase<pg8::EpiRes, pg8::StaticOrder, PG8_ALIGN, PG8_SP2>(F.lds + RING_OFF, g, S, E);
        }
#endif
 PHASE_END
        PHASE_BEGIN
#ifndef X_NO_LN
 ln_rows(F, WSB(WS_T), (const GAS float*)nullptr, INF(I_LNG) + (size_t)(l * 2 + 0) * D, INF(I_LNB) + (size_t)(l * 2 + 0) * D, WSF(WS_X), WSF(WS_STAT), ada_l, 4, 3, true);
#endif
 PHASE_END
        PHASE_BEGIN
#ifndef X_NO_G1
{
            pg8::Gemm g{(const pg8::bf16_t*)WSB(WS_H), (const pg8::bf16_t*)(WSB(WS_W1) + (size_t)l * DFF * D), M, DFF, D}; pg8::StaticOrder S; S.init(M, DFF, F.G, (int)blockIdx.x);
            pg8::EpiRelu2 E{F.lds + PTAB_OFF, WS_U, DFF};
            pg8::gemm_phase<pg8::EpiRelu2, pg8::StaticOrder, PG8_ALIGN, PG8_SP2>(F.lds + RING_OFF, g, S, E);
        }
#endif
 PHASE_END
        PHASE_BEGIN
#ifndef X_NO_G2
{
            pg8::Gemm g{(const pg8::bf16_t*)WSB(WS_U), (const pg8::bf16_t*)(WSB(WS_W2) + (size_t)l * D * DFF), M, D, DFF}; pg8::StaticOrder S; S.init(M, D, F.G, (int)blockIdx.x);
            pg8::EpiRes E{F.lds + PTAB_OFF, WS_T, WS_ADA + ((size_t)l * BATCH * NADA + 5 * D) * 4, WS_STAT, D, NADA, l * 2, ALPHA, (l == DEPTH - 1) ? (size_t)WS_X : (size_t)0};
            pg8::gemm_phase<pg8::EpiRes, pg8::StaticOrder, PG8_ALIGN, PG8_SP2>(F.lds + RING_OFF, g, S, E);
        }
#endif
 PHASE_END
        PHASE_BEGIN
#ifndef X_NO_LN
 ln_rows(F, WSB(WS_T), (l == DEPTH - 1) ? (const GAS float*)WSF(WS_X) : (const GAS float*)nullptr, INF(I_LNG) + (size_t)(l * 2 + 1) * D, INF(I_LNB) + (size_t)(l * 2 + 1) * D, (GAS float*)ptab_get(F, I_OUT), WSF(WS_STAT), ada_l + (size_t)BATCH * NADA, 1, 0, l < DEPTH - 1);
#endif
 PHASE_END
    }
#undef PHASE_BEGIN
#undef PHASE_END
}

extern "C" void kernel_launch(void* const* d_in, const int* in_sizes, int n_in, void* d_out, int out_size, void* d_ws, size_t ws_size, hipStream_t stream) {
    static int grid = 0;
    if (grid == 0) {
        if (n_in != 19 || in_sizes[0] != M * D || out_size != M * D || ws_size < WS_END) { fprintf(stderr, "kernel_launch: unexpected shapes (n_in %d, in0 %d, out %d, ws %zu)\n", n_in, n_in > 0 ? in_sizes[0] : -1, out_size, ws_size); grid = -1; return; }
        int dev = 0, cus = 0, per_cu = 0;
        if (hipGetDevice(&dev) != hipSuccess || hipDeviceGetAttribute(&cus, hipDeviceAttributeMultiprocessorCount, dev) != hipSuccess) { grid = -1; return; }
        if (hipFuncSetAttribute((const void*)hymba_fwd, hipFuncAttributeMaxDynamicSharedMemorySize, LDS_BYTES) != hipSuccess) { fprintf(stderr, "kernel_launch: hipFuncSetAttribute failed\n"); grid = -1; return; }
        if (hipOccupancyMaxActiveBlocksPerMultiprocessor(&per_cu, (const void*)hymba_fwd, NWAVES * 64, LDS_BYTES) != hipSuccess || per_cu < 1)
            fprintf(stderr, "kernel_launch: note: occupancy query reports %d workgroups per CU\n", per_cu);
        (void)hipGetLastError();
        grid = cus;
    }
    if (grid < 0) return;
    if (hipMemsetAsync((char*)d_ws + WS_CTL, 0, CTL_ZERO_BYTES, stream) != hipSuccess) return;
    Args a{};
    for (int i = 0; i < 19; ++i) a.in[i] = d_in[i];
    a.out = (float*)d_out; a.ws = (unsigned char*)d_ws;
#if MK_PER_PHASE
    for (int p = 0; p < N_PHASES; ++p) { a.ph_lo = p; a.ph_hi = p + 1; hipLaunchKernelGGL(hymba_fwd, dim3(grid), dim3(NWAVES * 64), LDS_BYTES, stream, a); }
#else
    a.ph_lo = 0; a.ph_hi = N_PHASES;
    hipLaunchKernelGGL(hymba_fwd, dim3(grid), dim3(NWAVES * 64), LDS_BYTES, stream, a);
#if defined(PROBE_SET)
#ifndef PROBE_FLAGS
#define PROBE_FLAGS 0
#endif
    {
        const int L3 = 2 + 3 * PH_PER_LAYER;
        const int sets[10][4] = { {0, -1, -1, -1}, {L3 + 0, L3 + 4, L3 + 6, L3 + 7}, {L3 + 1, L3 + 2, L3 + 3, -1}, {L3 + 5, L3 - 1, -1, -1}, {L3 + 1, -1, -1, -1}, {L3 + 2, -1, -1, -1}, {L3 + 0, -1, -1, -1}, {L3 + 7, -1, -1, -1}, {L3 + 4, -1, -1, -1}, {L3 + 6, -1, -1, -1} };
        for (int rep = 0; rep < PROBE_REPS; ++rep) for (int k = 0; k < 4; ++k) { const int p = sets[PROBE_SET][k]; if (p < 0) continue;
            a.ph_lo = p; a.ph_hi = p + 1; a.flags = PROBE_FLAGS; hipLaunchKernelGGL(hymba_fwd, dim3(grid), dim3(NWAVES * 64), LDS_BYTES, stream, a); }
    }
#endif
#endif
    const hipError_t le = hipPeekAtLastError();
    if (le != hipSuccess) fprintf(stderr, "kernel_launch: launch failed: %s\n", hipGetErrorName(le));
}
```

```cpp
#include <hip/hip_runtime.h>
#include <cstdio>
#include <cstdint>
namespace pg8 {
#define PG8_LAS __attribute__((address_space(3)))
typedef unsigned short bf16_t;
typedef short bf16x8 __attribute__((ext_vector_type(8)));
typedef float f32x4 __attribute__((ext_vector_type(4)));
typedef unsigned u32x4 __attribute__((ext_vector_type(4)));
constexpr int BM = 256, BK = 64, HALF = 128, HTB = HALF * BK * 2  , STAGE_BYTES = 8 * HTB, NXCD = 8, WGM = 8;

__host__ __device__ __forceinline__ int lds_byte(int r, int c) { const int st = (r >> 4) * 2 + (c >> 5), rr = r & 15, cc = c & 31, ob = rr * 64 + cc * 2; return st * 1024 + (ob ^ (((ob >> 9) & 1) << 5)); }
__host__ __device__ __forceinline__ void stage_rc(int b, int& R, int& C) { const int st = b / 1024, sb = b % 1024, swz = sb ^ (((sb >> 9) & 1) << 5); R = (st >> 1) * 16 + swz / 64; C = (st & 1) * 32 + (swz % 64) / 2; }
__host__ __device__ __forceinline__ int perm32(int rho) { const int n = rho >> 4, i = rho & 15; return 8 * (i >> 2) + 4 * n + (i & 3); }

struct Unit { int pm, pn; };
struct Gemm { const bf16_t* A; const bf16_t* Bt; int M, N, K; };

struct StaticOrder {
    int nM, nN, nwg, G, c;
    __host__ __device__ void init(int M, int N, int G_, int c_) { nM = M / BM; nN = N / BM; nwg = nM * nN; G = G_; c = c_; }
    __host__ __device__ bool next(int i, Unit& u) const {
        const long L = (long)i * G + c; if (L >= nwg) return false;
        int wgid = (int)L; { const int q = nwg / NXCD, r = nwg % NXCD, xcd = wgid % NXCD, off = wgid / NXCD; wgid = (xcd < r ? xcd * (q + 1) : r * (q + 1) + (xcd - r) * q) + off; }
        const int nig = WGM * nN, gid = wgid / nig, fm = gid * WGM, gsz = (nM - fm) < WGM ? (nM - fm) : WGM;
        u.pm = fm + ((wgid % nig) % gsz); u.pn = (wgid % nig) / gsz; return true;
    }
    __device__ __forceinline__ void a_ready(const Unit&) const {}
    __device__ __forceinline__ void done(const Unit&) const {}
};

typedef float f32x2 __attribute__((ext_vector_type(2)));
#define PG8_GAS __attribute__((address_space(1)))
__device__ __forceinline__ unsigned long long tab_get(PG8_LAS const unsigned char* tab, int i) {
    const unsigned long long v = ((const volatile PG8_LAS unsigned long long*)tab)[i];
    const unsigned lo = __builtin_amdgcn_readfirstlane((unsigned)v), hi = __builtin_amdgcn_readfirstlane((unsigned)(v >> 32));
    return ((unsigned long long)hi << 32) | lo;
}
__device__ __forceinline__ unsigned cvt_pk_bf16(float lo, float hi) { unsigned r; asm volatile("v_cvt_pk_bf16_f32 %0, %1, %2" : "=v"(r) : "v"(lo), "v"(hi)); return r; }

struct EpiProj {
    static constexpr bool PERM = true, AFTER_DRAIN = false;
    PG8_LAS const unsigned char* tab; size_t o_off, dt_off; int ldc; int dt_pn;
    __device__ __forceinline__ void operator()(const f32x4 (&acc)[2][2][4][2], const Unit& u, int wr, int wc, int fr, int fq) const {
        PG8_GAS unsigned char* wsb = (PG8_GAS unsigned char*)tab_get(tab, 20); PG8_GAS bf16_t* O = (PG8_GAS bf16_t*)(wsb + o_off); PG8_GAS float* dtraw = (PG8_GAS float*)(wsb + dt_off);
        const int row0 = u.pm * BM + wr * 64 + fr; const int col0 = u.pn * BM + wc * 32 + 8 * fq;
        const bool isdt = (u.pn == dt_pn) && (wc == 0) && (fq < 2);
#pragma unroll
        for (int ai = 0; ai < 2; ++ai)
#pragma unroll
            for (int m = 0; m < 4; ++m) { const int row = row0 + ai * HALF + m * 16; PG8_GAS bf16_t* rowp = O + (size_t)row * ldc + col0;
#pragma unroll
                for (int bj = 0; bj < 2; ++bj) { const f32x4 v0 = acc[ai][bj][m][0], v1 = acc[ai][bj][m][1];
                    u32x4 w; w.x = cvt_pk_bf16(v0[0], v0[1]); w.y = cvt_pk_bf16(v0[2], v0[3]); w.z = cvt_pk_bf16(v1[0], v1[1]); w.w = cvt_pk_bf16(v1[2], v1[3]);
                    *(PG8_GAS u32x4*)(rowp + bj * HALF) = w;
                    if (bj == 0 && isdt) { PG8_GAS float* dp = dtraw + (size_t)row * 16 + 8 * fq; *(PG8_GAS f32x4*)dp = v0; *(PG8_GAS f32x4*)(dp + 4) = v1; } } }
    }
};
struct EpiRelu2 {
    static constexpr bool PERM = true, AFTER_DRAIN = false;
    PG8_LAS const unsigned char* tab; size_t o_off; int ldc;
    __device__ __forceinline__ void operator()(const f32x4 (&acc)[2][2][4][2], const Unit& u, int wr, int wc, int fr, int fq) const {
        PG8_GAS bf16_t* O = (PG8_GAS bf16_t*)((PG8_GAS unsigned char*)tab_get(tab, 20) + o_off);
        const int row0 = u.pm * BM + wr * 64 + fr; const int col0 = u.pn * BM + wc * 32 + 8 * fq;
#pragma unroll
        for (int ai = 0; ai < 2; ++ai)
#pragma unroll
            for (int m = 0; m < 4; ++m) { PG8_GAS bf16_t* rowp = O + (size_t)(row0 + ai * HALF + m * 16) * ldc + col0;
#pragma unroll
                for (int bj = 0; bj < 2; ++bj) { f32x4 v0 = acc[ai][bj][m][0], v1 = acc[ai][bj][m][1];
#pragma unroll
                    for (int j = 0; j < 4; ++j) { const float a = fmaxf(v0[j], 0.f), b = fmaxf(v1[j], 0.f); v0[j] = a * a; v1[j] = b * b; }
                    u32x4 w; w.x = cvt_pk_bf16(v0[0], v0[1]); w.y = cvt_pk_bf16(v0[2], v0[3]); w.z = cvt_pk_bf16(v1[0], v1[1]); w.w = cvt_pk_bf16(v1[2], v1[3]);
                    *(PG8_GAS u32x4*)(rowp + bj * HALF) = w; } }
    }
};
struct EpiRes {
    static constexpr bool PERM = true, AFTER_DRAIN = false;
    PG8_LAS const unsigned char* tab; size_t t_off, gate_off, stat_off; int ldc, gstride, ln_idx  ; float alpha; size_t tf_off  ;
    __device__ __forceinline__ void operator()(const f32x4 (&acc)[2][2][4][2], const Unit& u, int wr, int wc, int fr, int fq) const {
        PG8_GAS unsigned char* wsb = (PG8_GAS unsigned char*)tab_get(tab, 20);
        PG8_GAS bf16_t* T = (PG8_GAS bf16_t*)(wsb + t_off); const PG8_GAS float* gate = (const PG8_GAS float*)(wsb + gate_off); const PG8_GAS float* stats = (const PG8_GAS float*)(wsb + stat_off);
        const PG8_GAS float* lng = ln_idx >= 0 ? (const PG8_GAS float*)tab_get(tab, 8) + (size_t)ln_idx * ldc : nullptr; const PG8_GAS float* lnb = ln_idx >= 0 ? (const PG8_GAS float*)tab_get(tab, 9) + (size_t)ln_idx * ldc : nullptr;
        const PG8_GAS float* xraw = (const PG8_GAS float*)tab_get(tab, 0);
        const int row0 = u.pm * BM + wr * 64 + fr, col0 = u.pn * BM + wc * 32 + 8 * fq;
        const PG8_GAS float* gp = gate + (size_t)(u.pm >> 3) * gstride + col0;
#pragma unroll
        for (int bj = 0; bj < 2; ++bj) { const int co = bj * HALF;
            const f32x4 gv0 = *(const PG8_GAS f32x4*)(gp + co) + 1.0f, gv1 = *(const PG8_GAS f32x4*)(gp + co + 4) + 1.0f;
            f32x4 lg0 = (f32x4){alpha, alpha, alpha, alpha}, lg1 = lg0, lb0 = (f32x4){0.f, 0.f, 0.f, 0.f}, lb1 = lb0;
            if (lng) { lg0 = *(const PG8_GAS f32x4*)(lng + col0 + co) * alpha; lg1 = *(const PG8_GAS f32x4*)(lng + col0 + co + 4) * alpha; lb0 = *(const PG8_GAS f32x4*)(lnb + col0 + co) * alpha; lb1 = *(const PG8_GAS f32x4*)(lnb + col0 + co + 4) * alpha; }
#pragma unroll
            for (int ai = 0; ai < 2; ++ai)
#pragma unroll
                for (int m = 0; m < 4; ++m) { const int row = row0 + ai * HALF + m * 16; const size_t off = (size_t)row * ldc + col0 + co;
                    float mu_ = 0.f, rs_ = 1.f; if (lng) { const f32x2 st = *(const PG8_GAS f32x2*)(stats + 2 * (size_t)row); mu_ = st.x; rs_ = st.y; }
                    f32x4 x0, x1;
                    if (lng) { const u32x4 tw = *(const PG8_GAS u32x4*)(T + off);
                        x0 = (f32x4){__builtin_bit_cast(float, tw.x << 16), __builtin_bit_cast(float, tw.x & 0xffff0000u), __builtin_bit_cast(float, tw.y << 16), __builtin_bit_cast(float, tw.y & 0xffff0000u)};
                        x1 = (f32x4){__builtin_bit_cast(float, tw.z << 16), __builtin_bit_cast(float, tw.z & 0xffff0000u), __builtin_bit_cast(float, tw.w << 16), __builtin_bit_cast(float, tw.w & 0xffff0000u)}; }
                    else { x0 = *(const PG8_GAS f32x4*)(xraw + off); x1 = *(const PG8_GAS f32x4*)(xraw + off + 4); }
                    const f32x4 t0 = ((x0 - mu_) * rs_) * lg0 + lb0 + gv0 * acc[ai][bj][m][0], t1 = ((x1 - mu_) * rs_) * lg1 + lb1 + gv1 * acc[ai][bj][m][1];
                    if (tf_off) { PG8_GAS float* tf = (PG8_GAS float*)(wsb + tf_off) + off; *(PG8_GAS f32x4*)tf = t0; *(PG8_GAS f32x4*)(tf + 4) = t1; }
                    else { u32x4 w; w.x = cvt_pk_bf16(t0[0], t0[1]); w.y = cvt_pk_bf16(t0[2], t0[3]); w.z = cvt_pk_bf16(t1[0], t1[1]); w.w = cvt_pk_bf16(t1[2], t1[3]);
                        *(PG8_GAS u32x4*)(T + off) = w; } }
            asm volatile("" ::: "memory"); }
    }
};

template <class Epi, class Sched, bool ALIGN_EPI = false, bool SP2 = false>
__device__ __forceinline__ void gemm_phase(PG8_LAS unsigned char* lds, const Gemm g, const Sched& S, const Epi& E) {
    int tid_l; asm volatile("v_mov_b32 %0, %1" : "=v"(tid_l) : "v"((int)threadIdx.x));
    const int tid = tid_l, wid = __builtin_amdgcn_readfirstlane(tid >> 6), lane = tid & 63, wr = wid >> 2, wc = wid & 3, fr = lane & 15, fq = lane >> 4;
    const int K = g.K, nt = K / BK;
    unsigned voffA[2], voffB[2];
#pragma unroll
    for (int i = 0; i < 2; ++i) { int R, C; stage_rc(tid * 16 + i * 8192, R, C); const int Rb = Epi::PERM ? ((R & ~31) + perm32(R & 31)) : R;
        voffA[i] = (unsigned)(R * K + C) * 2u; voffB[i] = (unsigned)(Rb * K + C) * 2u; }
    const size_t kstep = (size_t)(BK * 2);
    const size_t hstep = (size_t)HALF * K * 2;
    const size_t tstep = 2 * hstep;
    const unsigned ldsw = (unsigned)wid * 1024u;
    const int aoff = lds_byte(wr * 64 + fr, fq * 8), boff = lds_byte(wc * 32 + fr, fq * 8);
#define PG8_SA(b, h) (((b) * 2 + (h)) * HTB)
#define PG8_SB(b, h) ((4 + (b) * 2 + (h)) * HTB)
#define PG8_STAGE(bufoff, gbase, voff) do { _Pragma("unroll") for (int _i = 0; _i < 2; ++_i) \
        __builtin_amdgcn_global_load_lds((const unsigned*)((const char*)(gbase) + (voff)[_i]), (PG8_LAS unsigned*)(lds + (bufoff) + ldsw + _i * 8192), 16, 0, 0); } while (0)
#define PG8_LDA(dst, b, h) do { _Pragma("unroll") for (int m = 0; m < 4; ++m) _Pragma("unroll") for (int k = 0; k < 2; ++k) dst[m][k] = *(const PG8_LAS bf16x8*)(lds + PG8_SA(b, h) + aoff + m * 2048 + k * 1024); } while (0)
#define PG8_LDB(dst, b, h) do { _Pragma("unroll") for (int n = 0; n < 2; ++n) _Pragma("unroll") for (int k = 0; k < 2; ++k) dst[n][k] = *(const PG8_LAS bf16x8*)(lds + PG8_SB(b, h) + boff + n * 2048 + k * 1024); } while (0)
#define PG8_MMA(ai, bj, At, Bt) do { __builtin_amdgcn_s_setprio(1); _Pragma("unroll") for (int m = 0; m < 4; ++m) _Pragma("unroll") for (int n = 0; n < 2; ++n) _Pragma("unroll") for (int k = 0; k < 2; ++k) \
        acc[ai][bj][m][n] = __builtin_amdgcn_mfma_f32_16x16x32_bf16(Bt[n][k], At[m][k], acc[ai][bj][m][n], 0, 0, 0); __builtin_amdgcn_s_setprio(0); } while (0)
#define PG8_WAIT_V(n) asm volatile("s_waitcnt vmcnt(" #n ")" ::: "memory")
#define PG8_WAIT_L(n) asm volatile("s_waitcnt lgkmcnt(" #n ")" ::: "memory")
#define PG8_BAR __builtin_amdgcn_s_barrier()
#define PG8_SCHED __builtin_amdgcn_sched_barrier(0)
    Unit cur, nxt; int ui = 0;
    if (!S.next(0, cur)) return;
    f32x4 acc[2][2][4][2];
#pragma unroll
    for (int a = 0; a < 2; ++a)
#pragma unroll
        for (int b = 0; b < 2; ++b)
#pragma unroll
            for (int m = 0; m < 4; ++m)
#pragma unroll
                for (int n = 0; n < 2; ++n) acc[a][b][m][n] = (f32x4){0.f, 0.f, 0.f, 0.f};
    bf16x8 At[4][2], B0[2][2], B1[2][2];
    const char* cA = (const char*)g.A + (size_t)cur.pm * tstep; const char* cB = (const char*)g.Bt + (size_t)cur.pn * tstep;
    S.a_ready(cur);
    if constexpr (SP2) {
        PG8_STAGE(PG8_SB(0, 0), cB, voffB); PG8_STAGE(PG8_SB(0, 1), cB + hstep, voffB); PG8_STAGE(PG8_SA(0, 0), cA, voffA); PG8_STAGE(PG8_SA(0, 1), cA + hstep, voffA);
        if (wr == 1) PG8_BAR;
        PG8_WAIT_V(2); PG8_BAR;
        PG8_STAGE(PG8_SB(1, 0), cB + kstep, voffB); PG8_STAGE(PG8_SA(1, 0), cA + kstep, voffA); PG8_STAGE(PG8_SB(1, 1), cB + hstep + kstep, voffB);
        PG8_WAIT_V(6); PG8_BAR;
    } else {
        PG8_STAGE(PG8_SB(0, 0), cB, voffB); PG8_STAGE(PG8_SA(0, 0), cA, voffA); PG8_STAGE(PG8_SB(0, 1), cB + hstep, voffB); PG8_STAGE(PG8_SA(0, 1), cA + hstep, voffA);
        if (wr == 1) PG8_BAR;
        PG8_WAIT_V(4); PG8_BAR;
        PG8_STAGE(PG8_SB(1, 0), cB + kstep, voffB); PG8_STAGE(PG8_SA(1, 0), cA + kstep, voffA); PG8_STAGE(PG8_SB(1, 1), cB + hstep + kstep, voffB);
        PG8_WAIT_V(6); PG8_BAR;
    }
    for (;;) {
        const bool has_next = S.next(ui + 1, nxt);
        const char* nA = has_next ? (const char*)g.A + (size_t)nxt.pm * tstep : cA; const char* nB = has_next ? (const char*)g.Bt + (size_t)nxt.pn * tstep : cB;
        for (int t = 0; t < nt; t += 2) {
            const bool last = (t == nt - 2);
            const char* a1 = cA + (size_t)(t + 1) * kstep;
            const char* a2 = last ? nA : cA + (size_t)(t + 2) * kstep; const char* b2 = last ? nB : cB + (size_t)(t + 2) * kstep;
            const char* a3 = a2 + kstep; const char* b3 = b2 + kstep;
            if (last && has_next) S.a_ready(nxt);
            if constexpr (SP2) {
            PG8_LDB(B0, 0, 0); PG8_LDB(B1, 0, 1); PG8_SCHED; PG8_LDA(At, 0, 0); PG8_STAGE(PG8_SA(1, 1), a1 + hstep, voffA);
            PG8_WAIT_V(8); PG8_WAIT_L(0); PG8_BAR; PG8_MMA(0, 0, At, B0); PG8_MMA(0, 1, At, B1); PG8_BAR; PG8_SCHED;
            PG8_LDA(At, 0, 1); PG8_STAGE(PG8_SB(0, 0), b2, voffB); PG8_STAGE(PG8_SB(0, 1), b2 + hstep, voffB); PG8_STAGE(PG8_SA(0, 0), a2, voffA);
            PG8_WAIT_V(8); PG8_WAIT_L(0); PG8_BAR; PG8_MMA(1, 0, At, B0); PG8_MMA(1, 1, At, B1); PG8_BAR; PG8_SCHED;
            PG8_LDB(B0, 1, 0); PG8_LDB(B1, 1, 1); PG8_SCHED; PG8_LDA(At, 1, 0); PG8_STAGE(PG8_SA(0, 1), a2 + hstep, voffA);
            PG8_WAIT_V(8); PG8_WAIT_L(0); PG8_BAR; PG8_MMA(0, 0, At, B0); PG8_MMA(0, 1, At, B1); PG8_BAR; PG8_SCHED;
            PG8_LDA(At, 1, 1); PG8_STAGE(PG8_SB(1, 0), b3, voffB); PG8_STAGE(PG8_SB(1, 1), b3 + hstep, voffB); PG8_STAGE(PG8_SA(1, 0), a3, voffA);
            PG8_WAIT_V(8); PG8_WAIT_L(0); PG8_BAR; PG8_MMA(1, 0, At, B0); PG8_MMA(1, 1, At, B1); PG8_BAR; PG8_SCHED;
            } else {
            PG8_LDB(B0, 0, 0); PG8_SCHED; PG8_LDA(At, 0, 0); PG8_STAGE(PG8_SA(1, 1), a1 + hstep, voffA);
            PG8_WAIT_L(8); PG8_BAR; PG8_WAIT_L(0); PG8_MMA(0, 0, At, B0); PG8_BAR; PG8_SCHED;
            PG8_LDB(B1, 0, 1); PG8_STAGE(PG8_SB(0, 0), b2, voffB);
            PG8_BAR; PG8_WAIT_L(0); PG8_MMA(0, 1, At, B1); PG8_BAR;
            PG8_LDA(At, 0, 1); PG8_STAGE(PG8_SA(0, 0), a2, voffA);
            PG8_BAR; PG8_WAIT_L(0); PG8_MMA(1, 0, At, B0); PG8_BAR; PG8_SCHED;
            PG8_STAGE(PG8_SB(0, 1), b2 + hstep, voffB);
            PG8_WAIT_V(6); PG8_BAR; PG8_MMA(1, 1, At, B1); PG8_BAR;
            PG8_LDB(B0, 1, 0); PG8_SCHED; PG8_LDA(At, 1, 0); PG8_STAGE(PG8_SA(0, 1), a2 + hstep, voffA);
            PG8_WAIT_L(8); PG8_BAR; PG8_WAIT_L(0); PG8_MMA(0, 0, At, B0); PG8_BAR; PG8_SCHED;
            PG8_LDB(B1, 1, 1); PG8_STAGE(PG8_SB(1, 0), b3, voffB);
            PG8_BAR; PG8_WAIT_L(0); PG8_MMA(0, 1, At, B1); PG8_BAR;
            PG8_LDA(At, 1, 1); PG8_STAGE(PG8_SA(1, 0), a3, voffA);
            PG8_BAR; PG8_WAIT_L(0); PG8_MMA(1, 0, At, B0); PG8_BAR; PG8_SCHED;
            PG8_STAGE(PG8_SB(1, 1), b3 + hstep, voffB);
            PG8_WAIT_V(6); PG8_BAR; PG8_MMA(1, 1, At, B1); PG8_BAR;
            }
        }
        if constexpr (ALIGN_EPI) { if (wr == 0) PG8_BAR; }
        if constexpr (!Epi::AFTER_DRAIN) { E(acc, cur, wr, wc, fr, fq); S.done(cur); }
        if (!has_next) break;
#pragma unroll
        for (int a = 0; a < 2; ++a)
#pragma unroll
            for (int b = 0; b < 2; ++b)
#pragma unroll
                for (int m = 0; m < 4; ++m)
#pragma unroll
                    for (int n = 0; n < 2; ++n) acc[a][b][m][n] = (f32x4){0.f, 0.f, 0.f, 0.f};
        cur = nxt; cA = nA; cB = nB; ++ui;
        if constexpr (ALIGN_EPI) { if (wr == 1) PG8_BAR; }
    }
    PG8_WAIT_V(0);
    if constexpr (!ALIGN_EPI) { if (wr == 0) PG8_BAR; }
    PG8_BAR;
    if constexpr (Epi::AFTER_DRAIN) { E.fused(acc, cur, wr, wc, fr, fq, lds, wid, lane); S.done(cur); }
#undef PG8_SA
#undef PG8_SB
#undef PG8_STAGE
#undef PG8_LDA
#undef PG8_LDB
#undef PG8_MMA
#undef PG8_WAIT_V
#undef PG8_WAIT_L
#undef PG8_BAR
#undef PG8_SCHED
}
}
#ifndef PG8_SP2
#define PG8_SP2 true
#endif
#ifndef PG8_ALIGN
#define PG8_ALIGN true
#endif
#ifndef MIXER_NAIVE
#define MIXER_NAIVE 0
#endif
#ifndef MK_PER_PHASE
#define MK_PER_PHASE 0
#endif

constexpr int NWAVES = 8;
constexpr int BATCH = 4, SEQ = 2048, D = 2048, DEPTH = 4, M = BATCH * SEQ;
constexpr int IN_COLS = 6672, NPROJ = 6912, DFF = 8192, NADA = 6 * D;
constexpr int C_RQ = 0, C_RK = 512, C_RV = 1024, C_RG = 1536, C_HQ = 2048, C_HF = 2560, C_HI = 3072, C_HG = 3584, C_MZ = 4096, C_MX = 5120, C_MB = 6144, C_MC = 6400, C_DT = 6656;
constexpr int MCONV = 1536;
constexpr float LN_EPS = 1e-5f, RMS_EPS = 1e-6f;
constexpr float ALPHA = 1.681792830507429f;
constexpr int PH_PER_LAYER = 9, N_PHASES = 2 + DEPTH * PH_PER_LAYER;

constexpr size_t MiB = 1u << 20;
constexpr size_t WS_CTL = 0, CTL_ZERO_BYTES = 1 * MiB;
constexpr size_t WS_ADA = 1 * MiB, WS_LBS = 2 * MiB, WS_DTRAW = 3 * MiB, WS_COS = 4 * MiB, WS_SIN = 6 * MiB;
constexpr size_t WS_WIN = 8 * MiB, WS_WOUT = 116 * MiB, WS_W1 = 148 * MiB, WS_W2 = 276 * MiB;
constexpr size_t WS_H = 404 * MiB, WS_Y = 436 * MiB, WS_O = 468 * MiB, WS_T = 500 * MiB, WS_X = 564 * MiB, WS_PROJ = 628 * MiB, WS_U = 736 * MiB;
constexpr size_t WS_NQ = 864 * MiB, WS_NK = 904 * MiB, WS_NV = 944 * MiB, WS_NF = 1008 * MiB, WS_NDT = 1024 * MiB, WS_NDA = 1025 * MiB, WS_END = 1026 * MiB;
static_assert(WS_WIN + (size_t)DEPTH * NPROJ * D * 2 <= WS_WOUT && WS_PROJ + (size_t)M * NPROJ * 2 <= WS_U && WS_U + (size_t)M * DFF * 2 <= WS_NQ, "d_ws map");
constexpr size_t WS_STAT = 2 * MiB + 512 * 1024;
constexpr int CW_BAR = 4096;

constexpr int LDSCTL_OFF = 0, MISC_OFF = LDSCTL_OFF + 320, LDSCTL_BYTES = 1024;
constexpr int RING_OFF = LDSCTL_BYTES, RING_BYTES = 146432;
constexpr int LDS_BYTES = 147456;

#define GAS __attribute__((address_space(1)))
#define LAS __attribute__((address_space(3)))
typedef unsigned short bf16;
typedef unsigned v4u __attribute__((ext_vector_type(4)));
typedef unsigned v2u __attribute__((ext_vector_type(2)));
typedef float f32x4 __attribute__((ext_vector_type(4)));
typedef float f32x2 __attribute__((ext_vector_type(2)));
typedef GAS unsigned gu32;
#define RLX_AGENT __ATOMIC_RELAXED, __HIP_MEMORY_SCOPE_AGENT
#define LDS_WAIT() asm volatile("s_waitcnt lgkmcnt(0)" ::: "memory")
#define VM_WAIT() asm volatile("s_waitcnt vmcnt(0)" ::: "memory")
__device__ __forceinline__ unsigned f2bf(float f) { unsigned u = __builtin_bit_cast(unsigned, f); return (u + 0x7fffu + ((u >> 16) & 1u)) >> 16; }
__device__ __forceinline__ unsigned pk2(float lo, float hi) { return f2bf(lo) | (f2bf(hi) << 16); }
__device__ __forceinline__ float bf2f(unsigned short h) { return __builtin_bit_cast(float, (unsigned)h << 16); }
__device__ __forceinline__ float bflo(unsigned w) { return __builtin_bit_cast(float, w << 16); }
__device__ __forceinline__ float bfhi(unsigned w) { return __builtin_bit_cast(float, w & 0xffff0000u); }
__device__ __forceinline__ float sigmoidf_(float x) { return __builtin_amdgcn_rcpf(1.0f + __expf(-x)); }
__device__ __forceinline__ float siluf_(float x) { return x * __builtin_amdgcn_rcpf(1.0f + __expf(-x)); }

#define XB_TMO      128
#define XB_XCNT(j)  (256  + 64 * (j))
#define XB_XSUB(j)  (1280 + 64 * (j))
#define XB_XGEN(j)  (2304 + 64 * (j))
#define XB_TOP      3328
#define XB_TOPGEN   3392
#define XCD_BAR_WORDS 3456
#define XB_SPIN_CAP (1u << 18)
__device__ __forceinline__ unsigned xb_ld(unsigned* p)              { return __hip_atomic_load(p, __ATOMIC_RELAXED, __HIP_MEMORY_SCOPE_AGENT); }
__device__ __forceinline__ unsigned xb_add(unsigned* p, unsigned v) { return __hip_atomic_fetch_add(p, v, __ATOMIC_RELAXED, __HIP_MEMORY_SCOPE_AGENT); }
__device__ __forceinline__ unsigned xb_xcc_id() { return (unsigned)__builtin_amdgcn_s_getreg((3 << 11) | 20) & 0xFu; }
#define XB_SPIN(cond, bar) do { unsigned _sp = 0; while (cond) { __builtin_amdgcn_s_sleep(1); \
    if ((++_sp & 255u) == 0u) { if (xb_ld(&(bar)[XB_TMO])) break; if (_sp > XB_SPIN_CAP) { atomicAdd(&(bar)[XB_TMO], 1u); break; } } } } while (0)
struct XcdBarrier { unsigned* bar; unsigned x; volatile LAS unsigned* st; };
__device__ __forceinline__ XcdBarrier xcd_barrier_post(unsigned* bar, volatile LAS unsigned* st) {
    XcdBarrier b; b.bar = bar; b.x = xb_xcc_id(); b.st = st;
    if (threadIdx.x == 0) (void)xb_add(&bar[XB_XCNT(b.x)], 1u);
    return b;
}
__device__ __forceinline__ void xcd_barrier_complete(unsigned* bar, unsigned x, unsigned& nloc, unsigned& nx) {
    const unsigned G = gridDim.x * gridDim.y * gridDim.z;
    unsigned sum, cnt, mine, sp = 0u;
    for (;;) {
        sum = 0u; cnt = 0u; mine = 0u;
#pragma unroll
        for (unsigned j = 0; j < 16; ++j) { const unsigned c = xb_ld(&bar[XB_XCNT(j)]); sum += c; cnt += (c > 0u) ? 1u : 0u; mine = (j == x) ? c : mine; }
        if (sum == G) break;
        __builtin_amdgcn_s_sleep(1);
        if ((++sp & 255u) == 0u) { if (xb_ld(&bar[XB_TMO])) break; if (sp > XB_SPIN_CAP) { atomicAdd(&bar[XB_TMO], 1u); break; } }
    }
    nloc = mine > 0u ? mine : 1u; nx = cnt > 0u ? cnt : 1u;
}
__device__ __forceinline__ void xcd_barrier(const XcdBarrier& b) {
    asm volatile("s_waitcnt vmcnt(0)" ::: "memory");
    __syncthreads();
    if (threadIdx.x == 0) {
        unsigned* bar = b.bar;
        __builtin_amdgcn_s_waitcnt(0);
        unsigned nloc = b.st[0], nx = b.st[1];
        if (nloc == 0u) { xcd_barrier_complete(bar, b.x, nloc, nx); b.st[0] = nloc; b.st[1] = nx; }
        const unsigned old = xb_add(&bar[XB_XSUB(b.x)], 1u);
        const unsigned gen = old / nloc;
        if (old + 1u == (gen + 1u) * nloc) {
            __builtin_amdgcn_fence(__ATOMIC_RELEASE, "agent");
            asm volatile("s_waitcnt vmcnt(0)" ::: "memory");
            const unsigned og = xb_add(&bar[XB_TOP], 1u);
            const unsigned tg = og / nx;
            if (og + 1u == (tg + 1u) * nx) xb_add(&bar[XB_TOPGEN], 1u);
            else XB_SPIN(xb_ld(&bar[XB_TOPGEN]) == tg, bar);
            __builtin_amdgcn_fence(__ATOMIC_ACQUIRE, "agent");
            xb_add(&bar[XB_XGEN(b.x)], 1u);
            asm volatile("s_waitcnt vmcnt(0)" ::: "memory");
        } else {
            XB_SPIN(xb_ld(&bar[XB_XGEN(b.x)]) == gen, bar);
            __builtin_amdgcn_fence(__ATOMIC_ACQUIRE, "agent");
            asm volatile("s_waitcnt vmcnt(0)" ::: "memory");
        }
    }
    __syncthreads();
}

struct Frame {
    LAS unsigned char* lds;
    volatile LAS unsigned* MISC;
    gu32* ctl;
    GAS unsigned char* ws;
    int tid, lane, wave, vcu, G;
};
constexpr int PTAB_OFF = MISC_OFF + 128;
enum { I_X = 0, I_C, I_POS, I_LB, I_WIN, I_WOUT, I_WADA, I_BADA, I_LNG, I_LNB, I_HGNW, I_CONVW, I_CONVB, I_DTB, I_ALOG, I_MD, I_MNW, I_W1, I_W2, I_OUT };
__device__ __forceinline__ unsigned long long ptab_get(const Frame& F, int i) {
    const unsigned long long v = ((const volatile LAS unsigned long long*)(F.lds + PTAB_OFF))[i];
    const unsigned lo = __builtin_amdgcn_readfirstlane((unsigned)v), hi = __builtin_amdgcn_readfirstlane((unsigned)(v >> 32));
    return ((unsigned long long)hi << 32) | lo;
}
#define INF(i) ((const GAS float*)ptab_get(F, (i)))
#define WSF(off) ((GAS float*)((GAS unsigned char*)F.ws + (off)))
#define WSB(off) ((GAS bf16*)((GAS unsigned char*)F.ws + (off)))

__device__ __forceinline__ float wave_sum(float v) {
#pragma unroll
    for (int o = 1; o < 64; o <<= 1) v += __shfl_xor(v, o);
    return v;
}
__device__ __forceinline__ float grp16_sum(float v) {
#pragma unroll
    for (int o = 1; o < 16; o <<= 1) v += __shfl_xor(v, o);
    return v;
}

struct TItem { const GAS float* src; GAS bf16* dst; int K, N, k0, n0; };
__device__ __forceinline__ void t_load(const TItem& d, int lane, f32x4 (&v)[16]) {
    const int r4 = lane >> 4, c4 = lane & 15;
    const bool ok = (d.n0 + 4 * c4) < d.N;
    const GAS float* src = d.src + (size_t)(d.k0 + r4) * d.N + d.n0 + 4 * c4;
#pragma unroll
    for (int i = 0; i < 16; ++i) v[i] = ok ? *(const GAS f32x4*)(src + (size_t)(4 * i) * d.N) : (f32x4){0.f, 0.f, 0.f, 0.f};
}
__device__ __forceinline__ void t_emit(const TItem& d, int lane, LAS float* scr, const f32x4 (&v)[16]) {
    const int r4 = lane >> 4, c4 = lane & 15;
#pragma unroll
    for (int i = 0; i < 16; ++i) { LAS float* q = scr + (4 * i + r4) * 65 + 4 * c4; q[0] = v[i].x; q[1] = v[i].y; q[2] = v[i].z; q[3] = v[i].w; }
    LDS_WAIT(); asm volatile("" ::: "memory");
    const int c = lane & 7;
#pragma unroll
    for (int j = 0; j < 8; ++j) { const int n = (lane >> 3) + 8 * j; const LAS float* sp = scr + (8 * c) * 65 + n;
        v4u o; o.x = pk2(sp[0 * 65], sp[1 * 65]); o.y = pk2(sp[2 * 65], sp[3 * 65]); o.z = pk2(sp[4 * 65], sp[5 * 65]); o.w = pk2(sp[6 * 65], sp[7 * 65]);
        *(GAS v4u*)(d.dst + (size_t)(d.n0 + n) * d.K + d.k0 + 8 * c) = o; }
    LDS_WAIT(); asm volatile("" ::: "memory");
}
constexpr int NB_IN = NPROJ / 64, I_IN = (D / 64) * NB_IN, NB_O = D / 64, I_O = (D / 64) * NB_O, NB_1 = DFF / 64, I_1 = (D / 64) * NB_1, NB_2 = D / 64, I_2 = (DFF / 64) * NB_2;
constexpr int L0_ITEMS = I_IN + I_O, PER_L12 = I_1 + I_2;
constexpr int TAIL_KB = 32, TAIL_N = TAIL_KB * NB_IN;
constexpr bool TAIL_WOUT = true;
constexpr int REST_L = (I_IN - TAIL_N) + (TAIL_WOUT ? 0 : I_O);
__device__ __forceinline__ TItem get_item(Frame& F, int mode, int ln, int it) {
    TItem d; int l = ln, r = it, which;
    if (mode == 0) {
        if (it < L0_ITEMS) { l = 0; if (r < I_IN) which = 0; else { which = 1; r -= I_IN; } }
        else if (it < L0_ITEMS + DEPTH * PER_L12) { l = (it - L0_ITEMS) / PER_L12; r = (it - L0_ITEMS) % PER_L12; if (r < I_1) which = 2; else { which = 3; r -= I_1; } }
        else { const int q = it - (L0_ITEMS + DEPTH * PER_L12); constexpr int RL = REST_L > 0 ? REST_L : 1; l = 1 + q / RL; r = q % RL; if (r < I_IN - TAIL_N) { which = 0; r += TAIL_N; } else { which = 1; r -= I_IN - TAIL_N; } }
    } else { if (r < TAIL_N) which = 0; else { which = 1; r -= TAIL_N; } }
    int nblk;
    if (which == 0) { d.src = INF(I_WIN) + (size_t)l * D * IN_COLS; d.dst = WSB(WS_WIN) + (size_t)l * NPROJ * D; d.K = D; d.N = IN_COLS; nblk = NB_IN; }
    else if (which == 1) { d.src = INF(I_WOUT) + (size_t)l * D * D; d.dst = WSB(WS_WOUT) + (size_t)l * D * D; d.K = D; d.N = D; nblk = NB_O; }
    else if (which == 2) { d.src = INF(I_W1) + (size_t)l * D * DFF; d.dst = WSB(WS_W1) + (size_t)l * DFF * D; d.K = D; d.N = DFF; nblk = NB_1; }
    else { d.src = INF(I_W2) + (size_t)l * DFF * D; d.dst = WSB(WS_W2) + (size_t)l * D * DFF; d.K = DFF; d.N = D; nblk = NB_2; }
    d.k0 = 64 * (r / nblk); d.n0 = 64 * (r % nblk);
    return d;
}
__device__ __forceinline__ void run_items(Frame& F, int mode, int ln, int first, int stride, int total) {
    LAS float* scr = (LAS float*)(F.lds + RING_OFF + F.wave * 16640);
    for (int it = first; it < total; it += stride) { f32x4 va[16]; const TItem da = get_item(F, mode, ln, it); t_load(da, F.lane, va); t_emit(da, F.lane, scr, va); }
}

__device__ __forceinline__ void p0_prologue(Frame& F) {
    LAS float* condS = (LAS float*)(F.lds + RING_OFF);
    LAS float* red = (LAS float*)(F.lds + RING_OFF + 32768);
    for (int i = F.tid; i < BATCH * D; i += NWAVES * 64) condS[i] = siluf_(INF(I_C)[i]);
    __syncthreads();
    for (int it = blockIdx.x; it < DEPTH * 64; it += F.G) {
        const int l = it >> 6, col0 = (it & 63) * 192;
        f32x4 acc[4];
#pragma unroll
        for (int b = 0; b < 4; ++b) acc[b] = (f32x4){0.f, 0.f, 0.f, 0.f};
        if (F.lane < 48) {
            const GAS float* wp = INF(I_WADA) + ((size_t)l * D + F.wave * 256) * NADA + col0 + 4 * F.lane;
#pragma unroll 16
            for (int k = 0; k < 256; ++k) { const f32x4 wv = *(const GAS f32x4*)(wp + (size_t)k * NADA); const int kk = F.wave * 256 + k;
#pragma unroll
                for (int b = 0; b < 4; ++b) acc[b] += wv * condS[b * D + kk]; }
#pragma unroll
            for (int b = 0; b < 4; ++b) *(LAS f32x4*)(red + (F.wave * 4 + b) * 192 + 4 * F.lane) = acc[b];
        }
        __syncthreads();
        for (int o = F.tid; o < 4 * 192; o += NWAVES * 64) { const int b = o / 192, j = o % 192; float s = INF(I_BADA)[(size_t)l * NADA + col0 + j];
#pragma unroll
            for (int w = 0; w < 8; ++w) s += red[(w * 4 + b) * 192 + j];
            WSF(WS_ADA)[((size_t)l * BATCH + b) * NADA + col0 + j] = s; }
        __syncthreads();
    }
    if (blockIdx.x == 0) {
        for (int j = F.tid; j < 512; j += NWAVES * 64) { float v[DEPTH], mx = -1e30f;
#pragma unroll
            for (int l = 0; l < DEPTH; ++l) { v[l] = INF(I_LB)[l * 512 + j]; mx = fmaxf(mx, v[l]); }
            float s = 0.f;
#pragma unroll
            for (int l = 0; l < DEPTH; ++l) { v[l] = __expf(v[l] - mx); s += v[l]; }
            float cum = 0.f; const float inv = 1.0f / s;
#pragma unroll
            for (int l = 0; l < DEPTH; ++l) { if (l > 0) cum += v[l] * inv; WSF(WS_LBS)[l * 512 + j] = cum; } }
    }
    {
        const int gt = blockIdx.x * (NWAVES * 64) + F.tid, NT = F.G * NWAVES * 64;
        for (int i = gt; i < M * 64; i += NT) { const int d = i & 63, row = i >> 6;
            const float invf = 1.0f / exp2f(((float)d * (1.0f / 63.0f)) * 13.287712379549449f);
            const float ang = (float)((const GAS int*)ptab_get(F, I_POS))[row] * invf;
            const float kq = rintf(ang * 0.15915494309189535f);
            float r = fmaf(-kq, 6.2831854820251465f, ang); r = fmaf(-kq, -1.7484555e-7f, r);
            WSF(WS_COS)[i] = __cosf(r); WSF(WS_SIN)[i] = __sinf(r); }
    }
    __syncthreads();
    run_items(F, 0, 0, F.vcu * NWAVES + F.wave, F.G * NWAVES, L0_ITEMS + DEPTH * PER_L12 + (DEPTH - 1) * REST_L);
}
__device__ __forceinline__ void convert_next_in_out(Frame& F, int ln, int rank, int nidle) {
    run_items(F, 1, ln, rank * NWAVES + F.wave, nidle * NWAVES, TAIL_N + (TAIL_WOUT ? I_O : 0));
}

__device__ __forceinline__ void mod_rows(Frame& F, const GAS float* xin, const GAS float* ada_l, int sc_chunk, int sh_chunk) {
    const int gw = F.vcu * NWAVES + F.wave, NGW = F.G * NWAVES;
    for (int row = gw; row < M; row += NGW) {
        const int b = row >> 11; const GAS float* ab = ada_l + (size_t)b * NADA;
        const GAS f32x4* xr = (const GAS f32x4*)(xin + (size_t)row * D) + F.lane;
        GAS v2u* ho = (GAS v2u*)(WSB(WS_H) + (size_t)row * D) + F.lane;
#pragma unroll
        for (int j = 0; j < 8; ++j) { const int col = 4 * (F.lane + 64 * j); const f32x4 v = xr[64 * j];
            const f32x4 sc = *(const GAS f32x4*)(ab + sc_chunk * D + col), sh = *(const GAS f32x4*)(ab + sh_chunk * D + col);
            const f32x4 h = v * (sc + 1.0f) + sh; v2u w; w.x = pk2(h.x, h.y); w.y = pk2(h.z, h.w); ho[64 * j] = w; }
    }
}
__device__ __forceinline__ void ln_rows(Frame& F, const GAS bf16* tin, const GAS float* tin32  , const GAS float* g, const GAS float* bt, GAS float* xout, GAS float* stats, const GAS float* ada_l, int sc_chunk, int sh_chunk, bool write_h) {
    const int gw = F.vcu * NWAVES + F.wave, NGW = F.G * NWAVES;
    const int per = (M + NGW - 1) / NGW, r0 = gw * per, r1 = (r0 + per < M) ? r0 + per : M;
    if (r0 >= M) return;
    const GAS float* ab = ada_l + (size_t)(r0 >> 11) * NADA;
    f32x4 G[8], B[8];
#pragma unroll
    for (int k = 0; k < 8; ++k) { const int col = 8 * (F.lane + 64 * (k >> 1)) + 4 * (k & 1); G[k] = *(const GAS f32x4*)(g + col); B[k] = *(const GAS f32x4*)(bt + col);
        if (write_h) { const f32x4 sc = *(const GAS f32x4*)(ab + sc_chunk * D + col) + 1.0f, sh = *(const GAS f32x4*)(ab + sh_chunk * D + col); G[k] = G[k] * sc; B[k] = B[k] * sc + sh; } }
    for (int rowa = r0; rowa < r1; rowa += 2) {
        const int rowb = rowa + 1; const bool hasb = rowb < r1; const int rowb_ = hasb ? rowb : rowa;
        const GAS v4u* ta = (const GAS v4u*)(tin + (size_t)rowa * D) + F.lane; const GAS v4u* tb = (const GAS v4u*)(tin + (size_t)rowb_ * D) + F.lane;
        f32x4 va[8], vb[8]; float sa = 0.f, sb = 0.f;
        if (tin32) {
            const GAS f32x4* fa = (const GAS f32x4*)(tin32 + (size_t)rowa * D) + 2 * F.lane; const GAS f32x4* fb = (const GAS f32x4*)(tin32 + (size_t)rowb_ * D) + 2 * F.lane;
#pragma unroll
            for (int j = 0; j < 4; ++j) { va[2 * j] = fa[128 * j]; va[2 * j + 1] = fa[128 * j + 1]; vb[2 * j] = fb[128 * j]; vb[2 * j + 1] = fb[128 * j + 1]; }
        } else {
        v4u wa[4], wb[4];
#pragma unroll
        for (int j = 0; j < 4; ++j) { wa[j] = ta[64 * j]; wb[j] = tb[64 * j]; }
#pragma unroll
        for (int j = 0; j < 4; ++j) {
            va[2 * j] = (f32x4){bflo(wa[j].x), bfhi(wa[j].x), bflo(wa[j].y), bfhi(wa[j].y)}; va[2 * j + 1] = (f32x4){bflo(wa[j].z), bfhi(wa[j].z), bflo(wa[j].w), bfhi(wa[j].w)};
            vb[2 * j] = (f32x4){bflo(wb[j].x), bfhi(wb[j].x), bflo(wb[j].y), bfhi(wb[j].y)}; vb[2 * j + 1] = (f32x4){bflo(wb[j].z), bfhi(wb[j].z), bflo(wb[j].w), bfhi(wb[j].w)}; }
        }
#pragma unroll
        for (int j = 0; j < 8; ++j) { sa += (va[j].x + va[j].y) + (va[j].z + va[j].w); sb += (vb[j].x + vb[j].y) + (vb[j].z + vb[j].w); }
        const float ma = wave_sum(sa) * (1.f / D), mb = wave_sum(sb) * (1.f / D); float qa = 0.f, qb = 0.f;
#pragma unroll
        for (int j = 0; j < 8; ++j) { va[j] = va[j] - ma; vb[j] = vb[j] - mb; qa += (va[j].x * va[j].x + va[j].y * va[j].y) + (va[j].z * va[j].z + va[j].w * va[j].w); qb += (vb[j].x * vb[j].x + vb[j].y * vb[j].y) + (vb[j].z * vb[j].z + vb[j].w * vb[j].w); }
        const float ra = 1.f / sqrtf(wave_sum(qa) * (1.f / D) + LN_EPS), rb = 1.f / sqrtf(wave_sum(qb) * (1.f / D) + LN_EPS);
        if (F.lane == 0) { *(GAS f32x2*)(stats + 2 * (size_t)rowa) = (f32x2){ma, ra}; if (hasb) *(GAS f32x2*)(stats + 2 * (size_t)rowb) = (f32x2){mb, rb}; }
#pragma unroll
        for (int half = 0; half < 2; ++half) {
            if (half == 1 && !hasb) break;
            const int row = half ? rowb : rowa; const float rstd = half ? rb : ra;
            GAS f32x4* xo = (GAS f32x4*)(xout + (size_t)row * D) + 2 * F.lane;
            GAS v4u* ho = (GAS v4u*)(WSB(WS_H) + (size_t)row * D) + F.lane;
#pragma unroll
            for (int j = 0; j < 4; ++j) { const f32x4 x0 = (half ? vb[2 * j] : va[2 * j]) * rstd * G[2 * j] + B[2 * j], x1 = (half ? vb[2 * j + 1] : va[2 * j + 1]) * rstd * G[2 * j + 1] + B[2 * j + 1];
                if (write_h) { v4u w; w.x = pk2(x0.x, x0.y); w.y = pk2(x0.z, x0.w); w.z = pk2(x1.x, x1.y); w.w = pk2(x1.z, x1.w); ho[64 * j] = w; }
                else { xo[128 * j] = x0; xo[128 * j + 1] = x1; } }
        }
    }
}

typedef short bf16x8 __attribute__((ext_vector_type(8)));
typedef short s16x4 __attribute__((ext_vector_type(4)));
typedef float f32x16 __attribute__((ext_vector_type(16)));
typedef __bf16 bf16x2_t __attribute__((ext_vector_type(2)));
constexpr int TS = 272;
constexpr int XS = 528;
constexpr size_t WS_QI = 864 * MiB, WS_SLR = 884 * MiB, WS_SLH = 892 * MiB, WS_SLM = 908 * MiB, WS_DECH = 924 * MiB, WS_RS = 925 * MiB, WS_CD = 926 * MiB;
constexpr int QIW = 1280;
#define MFMA32(a, b, c) __builtin_amdgcn_mfma_f32_32x32x16_bf16((a), (b), (c), 0, 0, 0)
__device__ __forceinline__ unsigned pkf(float lo, float hi) { f32x2 v = {lo, hi}; bf16x2_t b = __builtin_convertvector(v, bf16x2_t); return __builtin_bit_cast(unsigned, b); }
__device__ __forceinline__ unsigned short bf1(float x) { return (unsigned short)(pkf(x, 0.f) & 0xffffu); }
__device__ __forceinline__ void unpack8(const v4u w, float* f) { f[0] = bflo(w.x); f[1] = bfhi(w.x); f[2] = bflo(w.y); f[3] = bfhi(w.y); f[4] = bflo(w.z); f[5] = bfhi(w.z); f[6] = bflo(w.w); f[7] = bfhi(w.w); }
__device__ __forceinline__ v4u pack8(const float* f) { v4u w; w.x = pkf(f[0], f[1]); w.y = pkf(f[2], f[3]); w.z = pkf(f[4], f[5]); w.w = pkf(f[6], f[7]); return w; }
__device__ __forceinline__ int crow(int r, int hi) { return (r & 3) + 8 * (r >> 2) + 4 * hi; }
__device__ __forceinline__ bf16x8 frag_row(LAS const unsigned char* T, int stride, int r0, int k0, int lane) {
    return *(const LAS bf16x8*)(T + (r0 + (lane & 31)) * stride + (k0 + 8 * (lane >> 5)) * 2);
}
__device__ __forceinline__ bf16x8 frag_tr(LAS const unsigned char* T, int stride, int k0, int c0, int lane) {
    const int h = lane >> 5, blk = (lane >> 4) & 1, q = (lane & 15) >> 2, p = lane & 3;
    LAS unsigned char* a = (LAS unsigned char*)T + (k0 + 8 * h + q) * stride + (c0 + 16 * blk + 4 * p) * 2;
    const s16x4 lo = __builtin_amdgcn_ds_read_tr16_b64_v4i16((LAS s16x4*)a), hi = __builtin_amdgcn_ds_read_tr16_b64_v4i16((LAS s16x4*)(a + 4 * stride));
    return (bf16x8){lo[0], lo[1], lo[2], lo[3], hi[0], hi[1], hi[2], hi[3]};
}
__device__ __forceinline__ f32x16 zero16() { f32x16 z; for (int i = 0; i < 16; ++i) z[i] = 0.f; return z; }

__device__ __forceinline__ void st_acc4(GAS bf16* base, const f32x16& a) {
#pragma unroll
    for (int g = 0; g < 4; ++g) { v2u w; w.x = pkf(a[4 * g], a[4 * g + 1]); w.y = pkf(a[4 * g + 2], a[4 * g + 3]); *(GAS v2u*)(base + 8 * g) = w; }
}

__device__ __forceinline__ void pre_ret_unit(Frame& F, int u) {
    const int c = u & 15, h = (u >> 4) & 3, b = u >> 6;
    const int tid = F.tid, lane = F.lane, w = F.wave;
    LAS unsigned char* Qs = F.lds + RING_OFF; LAS unsigned char* Ks = Qs + 34816; LAS unsigned char* Vs = Ks + 34816;
    const size_t row0 = (size_t)b * SEQ + c * 128;
    const float gam = 1.0f - exp2f(-5.0f - (float)h), l2g = log2f(gam);
    {
        const int i = tid >> 2, s = tid & 3; const size_t row = row0 + i;
        const GAS bf16* pr = WSB(WS_PROJ) + row * NPROJ;
        const GAS float* cs = WSF(WS_COS) + row * 64 + 16 * s; const GAS float* sn = WSF(WS_SIN) + row * 64 + 16 * s;
        float cv[16], sv[16];
#pragma unroll
        for (int e = 0; e < 4; ++e) { const f32x4 a = *(const GAS f32x4*)(cs + 4 * e), d = *(const GAS f32x4*)(sn + 4 * e);
            cv[4 * e] = a.x; cv[4 * e + 1] = a.y; cv[4 * e + 2] = a.z; cv[4 * e + 3] = a.w; sv[4 * e] = d.x; sv[4 * e + 1] = d.y; sv[4 * e + 2] = d.z; sv[4 * e + 3] = d.w; }
#pragma unroll
        for (int t = 0; t < 2; ++t) {
            const GAS bf16* src = pr + (t ? C_RK : C_RQ) + h * 128 + 16 * s;
            float x1[16], x2[16], o1[16], o2[16];
            unpack8(*(const GAS v4u*)(src), x1); unpack8(*(const GAS v4u*)(src + 8), x1 + 8); unpack8(*(const GAS v4u*)(src + 64), x2); unpack8(*(const GAS v4u*)(src + 72), x2 + 8);
            const float sc = t ? 0.08838834764831845f : 1.0f;
#pragma unroll
            for (int e = 0; e < 16; ++e) { o1[e] = (x1[e] * cv[e] - x2[e] * sv[e]) * sc; o2[e] = (x1[e] * sv[e] + x2[e] * cv[e]) * sc; }
            LAS unsigned char* dst = (t ? Ks : Qs) + i * TS + 32 * s;
            const v4u a0 = pack8(o1), a1 = pack8(o1 + 8), b0 = pack8(o2), b1 = pack8(o2 + 8);
            *(LAS v4u*)(dst) = a0; *(LAS v4u*)(dst + 16) = a1; *(LAS v4u*)(dst + 128) = b0; *(LAS v4u*)(dst + 144) = b1;
            if (t == 0) { GAS bf16* qd = WSB(WS_QI) + row * QIW + h * 128 + 16 * s; *(GAS v4u*)(qd) = a0; *(GAS v4u*)(qd + 8) = a1; *(GAS v4u*)(qd + 64) = b0; *(GAS v4u*)(qd + 72) = b1; }
        }
        const GAS bf16* vsrc = pr + C_RV + h * 128 + 32 * s; LAS unsigned char* vd = Vs + i * TS + 64 * s;
#pragma unroll
        for (int e = 0; e < 4; ++e) *(LAS v4u*)(vd + 16 * e) = *(const GAS v4u*)(vsrc + 8 * e);
    }
    __syncthreads();
    const int rb = w >> 1, cb0 = (w & 1) * 2;
    f32x16 acc0 = zero16(), acc1 = zero16();
    if (cb0 <= rb) {
#pragma unroll
        for (int kk = 0; kk < 8; ++kk) { const bf16x8 a = frag_row(Qs, TS, rb * 32, 16 * kk, lane);
            acc0 = MFMA32(a, frag_row(Ks, TS, cb0 * 32, 16 * kk, lane), acc0);
            if (cb0 + 1 <= rb) acc1 = MFMA32(a, frag_row(Ks, TS, cb0 * 32 + 32, 16 * kk, lane), acc1); }
    }
    __syncthreads();
#pragma unroll
    for (int t = 0; t < 2; ++t) { const int cb = cb0 + t, j = cb * 32 + (lane & 31);
#pragma unroll
        for (int r = 0; r < 16; ++r) { const int i = rb * 32 + crow(r, lane >> 5); const float a = t ? acc1[r] : acc0[r];
            const float v = (cb <= rb && i >= j) ? a * exp2f((float)(i - j) * l2g) : 0.f;
            *(LAS unsigned short*)(Qs + i * TS + 2 * j) = bf1(v); } }
    {
        const int i = tid >> 2, s = tid & 3; const float f = exp2f((float)(127 - i) * l2g); LAS unsigned char* kp = Ks + i * TS + 64 * s;
#pragma unroll
        for (int e = 0; e < 4; ++e) { float x[8]; unpack8(*(LAS v4u*)(kp + 16 * e), x);
#pragma unroll
            for (int q = 0; q < 8; ++q) x[q] *= f;
            *(LAS v4u*)(kp + 16 * e) = pack8(x); }
    }
    __syncthreads();
    {
        const int pb0 = (w & 1) * 2; acc0 = zero16(); acc1 = zero16();
        for (int kk = 0; kk < 2 * (rb + 1); ++kk) { const bf16x8 a = frag_row(Qs, TS, rb * 32, 16 * kk, lane);
            acc0 = MFMA32(frag_tr(Vs, TS, 16 * kk, pb0 * 32, lane), a, acc0); acc1 = MFMA32(frag_tr(Vs, TS, 16 * kk, pb0 * 32 + 32, lane), a, acc1); }
        GAS bf16* yb = WSB(WS_Y) + (row0 + rb * 32 + (lane & 31)) * 2048 + h * 128 + pb0 * 32 + 4 * (lane >> 5);
        st_acc4(yb, acc0); st_acc4(yb + 32, acc1);
    }
    {
        const int pb = w >> 1, nb0 = (w & 1) * 2; acc0 = zero16(); acc1 = zero16();
#pragma unroll
        for (int kk = 0; kk < 8; ++kk) { const bf16x8 a = frag_tr(Vs, TS, 16 * kk, pb * 32, lane);
            acc0 = MFMA32(frag_tr(Ks, TS, 16 * kk, nb0 * 32, lane), a, acc0); acc1 = MFMA32(frag_tr(Ks, TS, 16 * kk, nb0 * 32 + 32, lane), a, acc1); }
        GAS bf16* sb = WSB(WS_SLR) + (size_t)u * 16384 + (pb * 32 + (lane & 31)) * 128 + nb0 * 32 + 4 * (lane >> 5);
        st_acc4(sb, acc0); st_acc4(sb + 32, acc1);
    }
    __syncthreads();
}

__device__ __forceinline__ void pre_hg_unit(Frame& F, int l, int u) {
    const int c = u & 31, h = (u >> 5) & 3, b = u >> 7;
    const int tid = F.tid, lane = F.lane, w = F.wave;
    LAS float* CUM = (LAS float*)(F.lds + RING_OFF);
    LAS unsigned char* Qm = F.lds + RING_OFF + 33792; LAS unsigned char* Km = Qm + 17408; LAS unsigned char* Kes = Km + 17408; LAS unsigned char* Vs = Kes + 17408;
    LAS unsigned char* Ps = Vs + 17408;
    LAS float* PT = (LAS float*)(Ps + 9216);
    const size_t row0 = (size_t)b * SEQ + c * 64;
    const int j = tid >> 3, s = tid & 7, d0 = 16 * s; const size_t row = row0 + j;
    const GAS bf16* pr = WSB(WS_PROJ) + row * NPROJ;
    float q[16], k[16];
    {
        float fr[16], lb[16];
        unpack8(*(const GAS v4u*)(pr + C_HQ + h * 128 + d0), q); unpack8(*(const GAS v4u*)(pr + C_HQ + h * 128 + d0 + 8), q + 8);
        unpack8(*(const GAS v4u*)(pr + C_HF + h * 128 + d0), fr); unpack8(*(const GAS v4u*)(pr + C_HF + h * 128 + d0 + 8), fr + 8);
        const GAS float* lbp = WSF(WS_LBS) + l * 512 + h * 128 + d0;
#pragma unroll
        for (int e = 0; e < 4; ++e) { const f32x4 a = *(const GAS f32x4*)(lbp + 4 * e); lb[4 * e] = a.x; lb[4 * e + 1] = a.y; lb[4 * e + 2] = a.z; lb[4 * e + 3] = a.w; }
        float lf[16];
#pragma unroll
        for (int e = 0; e < 16; ++e) { const float sg = sigmoidf_(fr[e]); const float f = lb[e] + (1.f - lb[e]) * sg; k[e] = (1.f - lb[e]) * (1.f - sg); lf[e] = __logf(f); }
#pragma unroll
        for (int e = 0; e < 4; ++e) *(LAS f32x4*)(CUM + j * 132 + d0 + 4 * e) = (f32x4){lf[4 * e], lf[4 * e + 1], lf[4 * e + 2], lf[4 * e + 3]};
        const GAS bf16* vsrc = pr + C_HI + h * 128 + d0; *(LAS v4u*)(Vs + j * TS + 2 * d0) = *(const GAS v4u*)(vsrc); *(LAS v4u*)(Vs + j * TS + 2 * d0 + 16) = *(const GAS v4u*)(vsrc + 8);
    }
    __syncthreads();
    {
        const int d = tid & 127, qd = tid >> 7; float loc[16], run = 0.f;
#pragma unroll
        for (int jj = 0; jj < 16; ++jj) { run += CUM[(16 * qd + jj) * 132 + d]; loc[jj] = run; }
        PT[qd * 128 + d] = run;
        __syncthreads();
        float off = 0.f;
#pragma unroll
        for (int qq = 0; qq < 3; ++qq) off += (qq < qd) ? PT[qq * 128 + d] : 0.f;
#pragma unroll
        for (int jj = 0; jj < 16; ++jj) CUM[(16 * qd + jj) * 132 + d] = loc[jj] + off;
    }
    __syncthreads();
    {
        float cum[16], mid[16], tot[16];
#pragma unroll
        for (int e = 0; e < 4; ++e) { const f32x4 a = *(const LAS f32x4*)(CUM + j * 132 + d0 + 4 * e), m4 = *(const LAS f32x4*)(CUM + 31 * 132 + d0 + 4 * e), t4 = *(const LAS f32x4*)(CUM + 63 * 132 + d0 + 4 * e);
            cum[4 * e] = a.x; cum[4 * e + 1] = a.y; cum[4 * e + 2] = a.z; cum[4 * e + 3] = a.w; mid[4 * e] = m4.x; mid[4 * e + 1] = m4.y; mid[4 * e + 2] = m4.z; mid[4 * e + 3] = m4.w;
            tot[4 * e] = t4.x; tot[4 * e + 1] = t4.y; tot[4 * e + 2] = t4.z; tot[4 * e + 3] = t4.w; }
        float qm[16], km[16], q2[16], ke[16];
#pragma unroll
        for (int e = 0; e < 16; ++e) { qm[e] = q[e] * __expf(fminf(cum[e] - mid[e], 80.f)); km[e] = k[e] * __expf(fminf(mid[e] - cum[e], 80.f)); q2[e] = q[e] * __expf(cum[e]); ke[e] = k[e] * __expf(tot[e] - cum[e]); }
        *(LAS v4u*)(Qm + j * TS + 2 * d0) = pack8(qm); *(LAS v4u*)(Qm + j * TS + 2 * d0 + 16) = pack8(qm + 8);
        *(LAS v4u*)(Km + j * TS + 2 * d0) = pack8(km); *(LAS v4u*)(Km + j * TS + 2 * d0 + 16) = pack8(km + 8);
        *(LAS v4u*)(Kes + j * TS + 2 * d0) = pack8(ke); *(LAS v4u*)(Kes + j * TS + 2 * d0 + 16) = pack8(ke + 8);
        GAS bf16* qd = WSB(WS_QI) + row * QIW + 512 + h * 128 + d0; *(GAS v4u*)(qd) = pack8(q2); *(GAS v4u*)(qd + 8) = pack8(q2 + 8);
        if (j == 0) { GAS float* dp = WSF(WS_DECH) + (size_t)u * 128 + d0;
#pragma unroll
            for (int e = 0; e < 4; ++e) *(GAS f32x4*)(dp + 4 * e) = (f32x4){__expf(tot[4 * e]), __expf(tot[4 * e + 1]), __expf(tot[4 * e + 2]), __expf(tot[4 * e + 3])}; }
    }
    __syncthreads();
    if (w < 4) {
        const int rb = w >> 1, cb = w & 1; f32x16 acc = zero16();
        if (cb <= rb) {
#pragma unroll
            for (int kk = 0; kk < 8; ++kk) acc = MFMA32(frag_row(Qm, TS, rb * 32, 16 * kk, lane), frag_row(Km, TS, cb * 32, 16 * kk, lane), acc);
        }
        const int jj = cb * 32 + (lane & 31);
#pragma unroll
        for (int r = 0; r < 16; ++r) { const int i = rb * 32 + crow(r, lane >> 5); *(LAS unsigned short*)(Ps + i * 144 + 2 * jj) = bf1((cb <= rb && i >= jj) ? acc[r] : 0.f); }
    }
    {
        const int vb = w >> 1, db0 = (w & 1) * 2; f32x16 acc0 = zero16(), acc1 = zero16();
#pragma unroll
        for (int kk = 0; kk < 4; ++kk) { const bf16x8 a = frag_tr(Vs, TS, 16 * kk, vb * 32, lane);
            acc0 = MFMA32(frag_tr(Kes, TS, 16 * kk, db0 * 32, lane), a, acc0); acc1 = MFMA32(frag_tr(Kes, TS, 16 * kk, db0 * 32 + 32, lane), a, acc1); }
        GAS bf16* sb = WSB(WS_SLH) + (size_t)u * 16384 + (vb * 32 + (lane & 31)) * 128 + db0 * 32 + 4 * (lane >> 5);
        st_acc4(sb, acc0); st_acc4(sb + 32, acc1);
    }
    __syncthreads();
    {
        const int rb = w >> 2, vb = w & 3; f32x16 acc = zero16();
        for (int kk = 0; kk < 2 * (rb + 1); ++kk) acc = MFMA32(frag_tr(Vs, TS, 16 * kk, vb * 32, lane), frag_row(Ps, 144, rb * 32, 16 * kk, lane), acc);
        st_acc4(WSB(WS_Y) + (row0 + rb * 32 + (lane & 31)) * 2048 + 512 + h * 128 + vb * 32 + 4 * (lane >> 5), acc);
    }
    __syncthreads();
}

__device__ __forceinline__ float softplus2_(float x) { return fmaxf(x, 0.f) + log1pf(__expf(-fabsf(x))); }
__device__ __forceinline__ void pre_mamba_unit(Frame& F, int l, int u) {
    const int half = u & 1, c = (u >> 1) & 15, g = (u >> 5) & 1, b = u >> 6, head0 = g * 8 + half * 4;
    const int tid = F.tid, lane = F.lane, w = F.wave;
    LAS unsigned char* Cs = F.lds + RING_OFF; LAS unsigned char* Bs = Cs + 34816; LAS unsigned char* Xs = Bs + 34816;
    LAS float* dtS = (LAS float*)(Xs + 67584); LAS float* cumS = dtS + 512; LAS float* wS = cumS + 512; LAS float* tot0 = wS + 512;
    const size_t row0 = (size_t)b * SEQ + c * 128;
    const int v4 = tid & 127, tg = tid >> 7;
    const int cch = (v4 < 32) ? 1024 + g * 128 + 4 * v4 : (v4 < 64) ? 1280 + g * 128 + 4 * (v4 - 32) : head0 * 64 + 4 * (v4 - 64);
    const GAS float* cw = INF(I_CONVW) + (size_t)l * 4 * MCONV + cch;
    const f32x4 w0 = *(const GAS f32x4*)(cw), w1 = *(const GAS f32x4*)(cw + MCONV), w2 = *(const GAS f32x4*)(cw + 2 * MCONV), w3 = *(const GAS f32x4*)(cw + 3 * MCONV), bias = *(const GAS f32x4*)(INF(I_CONVB) + (size_t)l * MCONV + cch);
    const GAS bf16* srcu = WSB(WS_PROJ) + ((ptrdiff_t)row0 - 3) * NPROJ + C_MX;
    const unsigned off0 = (unsigned)(tg * 32) * NPROJ + (unsigned)cch;
    const int tq0 = c * 128 + tg * 32;
    v2u raw[19];
#pragma unroll
    for (int q = 0; q < 3; ++q) raw[q] = (tq0 >= 3) ? *(const GAS v2u*)(srcu + (off0 + (unsigned)q * NPROJ)) : (v2u){0u, 0u};
#pragma unroll
    for (int tt = 0; tt < 16; ++tt) raw[3 + tt] = *(const GAS v2u*)(srcu + (off0 + (unsigned)(3 + tt) * NPROJ));
    float dskv[4];
#pragma unroll
    for (int hl = 0; hl < 4; ++hl) dskv[hl] = INF(I_MD)[l * 16 + head0 + hl];
    {
        const int hl = tid >> 7, j = tid & 127, head = head0 + hl;
        const float dt = softplus2_(WSF(WS_DTRAW)[(row0 + j) * 16 + head] + INF(I_DTB)[l * 16 + head]);
        float v = -__expf(INF(I_ALOG)[l * 16 + head]) * dt;
#pragma unroll
        for (int o = 1; o < 64; o <<= 1) { const float t = __shfl_up(v, o); if (lane >= o) v += t; }
        dtS[hl * 128 + j] = dt;
        if ((w & 1) == 0 && lane == 63) tot0[hl] = v;
        __syncthreads();
        if (w & 1) v += tot0[hl];
        cumS[hl * 128 + j] = v;
        __syncthreads();
        const float last = cumS[hl * 128 + 127];
        wS[hl * 128 + j] = __expf(last - v) * dt;
        WSF(WS_RS)[((size_t)b * 16 + head) * SEQ + c * 128 + j] = __expf(v);
        if (j == 127) WSF(WS_CD)[((size_t)b * 16 + head) * 16 + c] = __expf(v);
    }
    {
        GAS bf16* qiu = WSB(WS_QI) + row0 * QIW + 1024 + g * 128; const unsigned qoff0 = (unsigned)(tg * 32) * QIW + (unsigned)(4 * ((v4 - 32) & 31));
        LAS unsigned char* dst = (v4 < 32) ? Bs + 8 * v4 : (v4 < 64) ? Cs + 8 * (v4 - 32) : Xs + 8 * (v4 - 64);
        const int dstride = (v4 < 64) ? TS : XS;
        f32x4 x3 = (f32x4){bflo(raw[0].x), bfhi(raw[0].x), bflo(raw[0].y), bfhi(raw[0].y)}, x2 = (f32x4){bflo(raw[1].x), bfhi(raw[1].x), bflo(raw[1].y), bfhi(raw[1].y)}, x1 = (f32x4){bflo(raw[2].x), bfhi(raw[2].x), bflo(raw[2].y), bfhi(raw[2].y)};
#pragma unroll 1
        for (int hf = 0; hf < 2; ++hf) {
            if (hf == 1) {
#pragma unroll
                for (int tt = 0; tt < 16; ++tt) raw[3 + tt] = *(const GAS v2u*)(srcu + (off0 + (unsigned)(19 + tt) * NPROJ)); }
#pragma unroll
            for (int tt = 0; tt < 16; ++tt) { const int jj = tg * 32 + hf * 16 + tt;
                const f32x4 x0 = (f32x4){bflo(raw[3 + tt].x), bfhi(raw[3 + tt].x), bflo(raw[3 + tt].y), bfhi(raw[3 + tt].y)};
                const f32x4 a = bias + w0 * x3 + w1 * x2 + w2 * x1 + w3 * x0;
                v2u pk; pk.x = pkf(siluf_(a.x), siluf_(a.y)); pk.y = pkf(siluf_(a.z), siluf_(a.w));
                x3 = x2; x2 = x1; x1 = x0;
                *(LAS v2u*)(dst + jj * dstride) = pk;
                if (half == 0 && v4 >= 32 && v4 < 64) *(GAS v2u*)(qiu + (qoff0 + (unsigned)(hf * 16 + tt) * QIW)) = pk; }
        }
    }
    __syncthreads();
    const int rb = w >> 1, cb0 = (w & 1) * 2;
    f32x16 cbA = zero16(), cbB = zero16();
    if (cb0 <= rb) {
#pragma unroll
        for (int kk = 0; kk < 8; ++kk) { const bf16x8 a = frag_row(Cs, TS, rb * 32, 16 * kk, lane);
            cbA = MFMA32(a, frag_row(Bs, TS, cb0 * 32, 16 * kk, lane), cbA);
            if (cb0 + 1 <= rb) cbB = MFMA32(a, frag_row(Bs, TS, cb0 * 32 + 32, 16 * kk, lane), cbB); }
    }
    __syncthreads();
    for (int hl = 0; hl < 4; ++hl) {
        const int head = head0 + hl; const float dsk = (hl == 0) ? dskv[0] : (hl == 1) ? dskv[1] : (hl == 2) ? dskv[2] : dskv[3];
#pragma unroll
        for (int t = 0; t < 2; ++t) { const int cb = cb0 + t, j = cb * 32 + (lane & 31); const float cj = cumS[hl * 128 + j], dj = dtS[hl * 128 + j];
#pragma unroll
            for (int r = 0; r < 16; ++r) { const int i = rb * 32 + crow(r, lane >> 5); const float a = t ? cbB[r] : cbA[r];
                float v = (cb <= rb && i >= j) ? a * __expf(cumS[hl * 128 + i] - cj) * dj : 0.f; if (i == j) v += dsk;
                *(LAS unsigned short*)(Cs + i * TS + 2 * j) = bf1(v); } }
        __syncthreads();
        {
            const int pb = w & 1; f32x16 acc = zero16();
            for (int kk = 0; kk < 2 * (rb + 1); ++kk) acc = MFMA32(frag_tr(Xs, XS, 16 * kk, hl * 64 + pb * 32, lane), frag_row(Cs, TS, rb * 32, 16 * kk, lane), acc);
            st_acc4(WSB(WS_Y) + (row0 + rb * 32 + (lane & 31)) * 2048 + 1024 + head * 64 + pb * 32 + 4 * (lane >> 5), acc);
        }
        {
            const int pb = w >> 2, nb = w & 3; f32x16 acc = zero16();
#pragma unroll
            for (int kk = 0; kk < 8; ++kk) { const bf16x8 a = frag_tr(Xs, XS, 16 * kk, hl * 64 + pb * 32, lane);
                const LAS float* wp = wS + hl * 128 + 16 * kk + 8 * (lane >> 5); const f32x4 w0 = *(const LAS f32x4*)wp, w1 = *(const LAS f32x4*)(wp + 4);
                float x[8]; const v4u aw = __builtin_bit_cast(v4u, a); unpack8(aw, x);
                x[0] *= w0.x; x[1] *= w0.y; x[2] *= w0.z; x[3] *= w0.w; x[4] *= w1.x; x[5] *= w1.y; x[6] *= w1.z; x[7] *= w1.w;
                const v4u sw = pack8(x);
                acc = MFMA32(frag_tr(Bs, TS, 16 * kk, nb * 32, lane), __builtin_bit_cast(bf16x8, sw), acc); }
            st_acc4(WSB(WS_SLM) + (((size_t)b * 16 + head) * 16 + c) * 8192 + (pb * 32 + (lane & 31)) * 128 + nb * 32 + 4 * (lane >> 5), acc);
        }
        __syncthreads();
    }
}
__device__ __forceinline__ void mixer_pre(Frame& F, int l, int flags) {
    if (flags == 0 || (flags & 1)) for (int u = blockIdx.x; u < 256; u += F.G) pre_mamba_unit(F, l, u);
    if (flags == 0 || (flags & 2)) for (int u = blockIdx.x; u < 256; u += F.G) pre_ret_unit(F, u);
    if (flags == 0 || (flags & 4)) for (int u = blockIdx.x; u < 512; u += F.G) pre_hg_unit(F, l, u);
}

template <int MODE> __device__ __forceinline__ void lp_load(const GAS bf16* qb, const GAS bf16* yb, const GAS float* rsb, size_t rowb, int lane, bf16x8 (&A)[8], v2u (&yv)[4], float& rs) {
    const GAS bf16* qp = qb + (rowb + (lane & 31)) * QIW;
#pragma unroll
    for (int kk = 0; kk < 8; ++kk) A[kk] = *(const GAS bf16x8*)(qp + 16 * kk);
    const GAS bf16* yp = yb + (rowb + (lane & 31)) * 2048;
#pragma unroll
    for (int g = 0; g < 4; ++g) yv[g] = *(const GAS v2u*)(yp + 8 * g);
    if (MODE == 2) rs = rsb[rowb + (lane & 31)];
}
template <int MODE> __device__ __forceinline__ void loop_unit(Frame& F, int uu) {
    constexpr int NC = (MODE == 1) ? 32 : 16, CL = (MODE == 1) ? 64 : 128, PW = (MODE == 2) ? 64 : 128, RB = CL / 32, NT = 2 * RB;
    const int tid = F.tid, lane = F.lane, w = F.wave;
    int ps, hd, b;
    if (MODE == 2) { ps = uu & 1; hd = (uu >> 1) & 15; b = uu >> 5; } else { ps = uu & 3; hd = (uu >> 2) & 3; b = uu >> 4; }
    const int bh = (MODE == 2) ? b * 16 + hd : b * 4 + hd, p0 = ps * 32;
    const GAS bf16* SL = (MODE == 0) ? WSB(WS_SLR) : (MODE == 1) ? WSB(WS_SLH) : WSB(WS_SLM);
    const int qcol = (MODE == 0) ? hd * 128 : (MODE == 1) ? 512 + hd * 128 : 1024 + (hd >> 3) * 128;
    const int ycol = (MODE == 0) ? hd * 128 + p0 : (MODE == 1) ? 512 + hd * 128 + p0 : 1024 + hd * 64 + p0;
    const float gam = 1.0f - exp2f(-5.0f - (float)hd), l2g = log2f(gam), g128 = exp2f(128.f * l2g);
    LAS unsigned char* SP = F.lds + RING_OFF;
    const int p = tid >> 4, n8 = tid & 15;
    const GAS bf16* qb = WSB(WS_QI) + qcol + 8 * (lane >> 5);
    const GAS bf16* yb = WSB(WS_Y) + ycol + 4 * (lane >> 5);
    const GAS float* rsb = WSF(WS_RS) + (size_t)bh * SEQ - (size_t)b * SEQ;
    float S[8];
#pragma unroll
    for (int e = 0; e < 8; ++e) S[e] = 0.f;
    for (int pass = 0; pass < NC / 16; ++pass) {
#pragma unroll
        for (int hf = 0; hf < 2; ++hf) {
            v4u lw[8]; f32x4 dv[8][2]; float dsc[8];
#pragma unroll
            for (int cl = 0; cl < 8; ++cl) { const int c = pass * 16 + hf * 8 + cl;
                lw[cl] = *(const GAS v4u*)(SL + ((size_t)(bh * NC + c) * PW + p0 + p) * 128 + 8 * n8);
                if (MODE == 1) { const GAS float* dp = WSF(WS_DECH) + (size_t)(bh * NC + c) * 128 + 8 * n8; dv[cl][0] = *(const GAS f32x4*)dp; dv[cl][1] = *(const GAS f32x4*)(dp + 4); }
                if (MODE == 2) dsc[cl] = WSF(WS_CD)[bh * 16 + c]; }
#pragma unroll
            for (int cl = 0; cl < 8; ++cl) {
                *(LAS v4u*)(SP + (hf * 8 + cl) * 8704 + p * TS + 16 * n8) = pack8(S);
                float loc[8]; unpack8(lw[cl], loc);
                if (MODE == 1) { S[0] = S[0] * dv[cl][0].x + loc[0]; S[1] = S[1] * dv[cl][0].y + loc[1]; S[2] = S[2] * dv[cl][0].z + loc[2]; S[3] = S[3] * dv[cl][0].w + loc[3];
                    S[4] = S[4] * dv[cl][1].x + loc[4]; S[5] = S[5] * dv[cl][1].y + loc[5]; S[6] = S[6] * dv[cl][1].z + loc[6]; S[7] = S[7] * dv[cl][1].w + loc[7]; }
                else { const float dec = (MODE == 0) ? g128 : dsc[cl];
#pragma unroll
                    for (int e = 0; e < 8; ++e) S[e] = S[e] * dec + loc[e]; } }
            asm volatile("" ::: "memory");
        }
        __syncthreads();
        {
            bf16x8 A0[8], A1[8], Bf[8]; v2u y0[4], y1[4]; float r0 = 1.f, r1 = 1.f;
            lp_load<MODE>(qb, yb, rsb, (size_t)b * SEQ + (size_t)(pass * 16 + w) * CL, lane, A0, y0, r0);
#pragma unroll
            for (int t = 0; t < NT; ++t) {
                const int cl = w + 8 * (t / RB), rb = t % RB, c = pass * 16 + cl;
                const size_t rowb = (size_t)b * SEQ + (size_t)c * CL + rb * 32;
                if (t + 1 < NT) { const int cl2 = w + 8 * ((t + 1) / RB), rb2 = (t + 1) % RB; const size_t rowb2 = (size_t)b * SEQ + (size_t)(pass * 16 + cl2) * CL + rb2 * 32;
                    if (t & 1) lp_load<MODE>(qb, yb, rsb, rowb2, lane, A0, y0, r0); else lp_load<MODE>(qb, yb, rsb, rowb2, lane, A1, y1, r1); }
                asm volatile("" ::: "memory");
                if (rb == 0) {
#pragma unroll
                    for (int kk = 0; kk < 8; ++kk) Bf[kk] = frag_row(SP + cl * 8704, TS, 0, 16 * kk, lane); }
                f32x16 acc = zero16();
#pragma unroll
                for (int kk = 0; kk < 8; ++kk) acc = MFMA32(Bf[kk], (t & 1) ? A1[kk] : A0[kk], acc);
                float sc = 1.f;
                if (MODE == 0) sc = exp2f((float)(rb * 32 + (lane & 31) + 1) * l2g);
                if (MODE == 2) sc = (t & 1) ? r1 : r0;
                GAS bf16* yp = WSB(WS_Y) + (rowb + (lane & 31)) * 2048 + ycol + 4 * (lane >> 5);
#pragma unroll
                for (int g = 0; g < 4; ++g) { const v2u yy = (t & 1) ? y1[g] : y0[g]; v2u o;
                    o.x = pkf(bflo(yy.x) + sc * acc[4 * g], bfhi(yy.x) + sc * acc[4 * g + 1]); o.y = pkf(bflo(yy.y) + sc * acc[4 * g + 2], bfhi(yy.y) + sc * acc[4 * g + 3]);
                    *(GAS v2u*)(yp + 8 * g) = o; }
                asm volatile("" ::: "memory");
            }
        }
        __syncthreads();
    }
}
__device__ __forceinline__ void mixer_loop(Frame& F) {
    for (int u = blockIdx.x; u < 256; u += F.G) {
        if (u < 64) loop_unit<0>(F, u);
        else if (u < 128) loop_unit<1>(F, u - 64);
        else loop_unit<2>(F, u - 128);
    }
}
__device__ __forceinline__ float softplusf_(float x) { return fmaxf(x, 0.f) + log1pf(__expf(-fabsf(x))); }
__device__ __forceinline__ void npre_rows(Frame& F, int l) {
    const int gw = F.vcu * NWAVES + F.wave, NGW = F.G * NWAVES, lane = F.lane;
    for (int row = gw; row < M; row += NGW) {
        const int t = row & (SEQ - 1);
        const GAS bf16* pr = WSB(WS_PROJ) + (size_t)row * NPROJ;
        GAS float* nq = WSF(WS_NQ) + (size_t)row * 1280; GAS float* nk = WSF(WS_NK) + (size_t)row * 1280; GAS float* nv = WSF(WS_NV) + (size_t)row * 2048;
        const float cs = WSF(WS_COS)[(size_t)row * 64 + lane], sn = WSF(WS_SIN)[(size_t)row * 64 + lane];
#pragma unroll
        for (int h = 0; h < 4; ++h) {
            const float q1 = bf2f(pr[C_RQ + h * 128 + lane]), q2 = bf2f(pr[C_RQ + h * 128 + 64 + lane]);
            const float k1 = bf2f(pr[C_RK + h * 128 + lane]) * 0.08838834764831845f, k2 = bf2f(pr[C_RK + h * 128 + 64 + lane]) * 0.08838834764831845f;
            nq[h * 128 + lane] = q1 * cs - q2 * sn; nq[h * 128 + 64 + lane] = q1 * sn + q2 * cs;
            nk[h * 128 + lane] = k1 * cs - k2 * sn; nk[h * 128 + 64 + lane] = k1 * sn + k2 * cs;
        }
#pragma unroll
        for (int j = 0; j < 8; ++j) { const int c = lane + 64 * j; nv[c] = bf2f(pr[C_RV + c]);
            const float lb = WSF(WS_LBS)[l * 512 + c], sg = sigmoidf_(bf2f(pr[C_HF + c])), f = lb + (1.f - lb) * sg;
            WSF(WS_NF)[(size_t)row * 512 + c] = f; nk[512 + c] = (1.f - lb) * (1.f - sg); nq[512 + c] = bf2f(pr[C_HQ + c]); nv[512 + c] = bf2f(pr[C_HI + c]); }
        for (int j = 0; j < 24; ++j) { const int ch = lane + 64 * j; float acc = INF(I_CONVB)[l * MCONV + ch];
#pragma unroll
            for (int k = 0; k < 4; ++k) { const int tt = t - 3 + k; if (tt >= 0) acc += INF(I_CONVW)[(l * 4 + k) * MCONV + ch] * bf2f(WSB(WS_PROJ)[(size_t)(row - 3 + k) * NPROJ + C_MX + ch]); }
            const float a = siluf_(acc);
            if (ch < 1024) nv[1024 + ch] = a; else if (ch < 1280) nk[1024 + ch - 1024] = a; else nq[1024 + ch - 1280] = a; }
        if (lane < 16) { const float dt = softplusf_(WSF(WS_DTRAW)[(size_t)row * 16 + lane] + INF(I_DTB)[l * 16 + lane]);
            WSF(WS_NDT)[(size_t)row * 16 + lane] = dt; WSF(WS_NDA)[(size_t)row * 16 + lane] = __expf(-__expf(INF(I_ALOG)[l * 16 + lane]) * dt); }
    }
}
template <int MODE> __device__ __forceinline__ void nscan(Frame& F, int l, int b, int hd, int half) {
    const int lane = F.lane;
    LAS float* kS = (LAS float*)(F.lds + RING_OFF + F.wave * 12288); LAS float* qS = kS + 1024; LAS float* fS = kS + 2048;
    const int kb = (MODE == 0) ? hd * 128 : (MODE == 1) ? 512 + hd * 128 : 1024 + (hd >> 3) * 128;
    const int vc = (MODE == 0) ? hd * 128 + half * 64 + lane : (MODE == 1) ? 512 + hd * 128 + half * 64 + lane : 1024 + hd * 64 + lane;
    const float gamma = 1.0f - exp2f(-5.0f - (float)hd);
    const float dsk = (MODE == 2) ? INF(I_MD)[l * 16 + hd] : 0.f;
    float S[128];
#pragma unroll
    for (int n = 0; n < 128; ++n) S[n] = 0.f;
    for (int t0 = 0; t0 < SEQ; t0 += 8) {
        const size_t row0 = (size_t)b * SEQ + t0;
#pragma unroll
        for (int tt = 0; tt < 8; ++tt) {
            *(LAS f32x2*)(kS + tt * 128 + 2 * lane) = *(const GAS f32x2*)(WSF(WS_NK) + (row0 + tt) * 1280 + kb + 2 * lane);
            *(LAS f32x2*)(qS + tt * 128 + 2 * lane) = *(const GAS f32x2*)(WSF(WS_NQ) + (row0 + tt) * 1280 + kb + 2 * lane);
            if (MODE == 1) *(LAS f32x2*)(fS + tt * 128 + 2 * lane) = *(const GAS f32x2*)(WSF(WS_NF) + (row0 + tt) * 512 + hd * 128 + 2 * lane);
        }
        LDS_WAIT(); asm volatile("" ::: "memory");
        for (int tt = 0; tt < 8; ++tt) {
            const size_t row = row0 + tt;
            const float v = WSF(WS_NV)[row * 2048 + vc];
            float dec = gamma, vv = v;
            if (MODE == 2) { dec = WSF(WS_NDA)[row * 16 + hd]; vv = v * WSF(WS_NDT)[row * 16 + hd]; }
            float o = 0.f;
#pragma unroll
            for (int n4 = 0; n4 < 32; ++n4) {
                const f32x4 k4 = *(const LAS f32x4*)(kS + tt * 128 + 4 * n4), q4 = *(const LAS f32x4*)(qS + tt * 128 + 4 * n4);
                f32x4 f4 = (f32x4){dec, dec, dec, dec};
                if (MODE == 1) f4 = *(const LAS f32x4*)(fS + tt * 128 + 4 * n4);
#pragma unroll
                for (int i = 0; i < 4; ++i) { S[4 * n4 + i] = S[4 * n4 + i] * f4[i] + k4[i] * vv; o += S[4 * n4 + i] * q4[i]; }
            }
            if (MODE == 2) o += dsk * v;
            WSB(WS_Y)[row * 2048 + vc] = (bf16)f2bf(o);
        }
        LDS_WAIT(); asm volatile("" ::: "memory");
    }
}
__device__ __forceinline__ void nloop(Frame& F, int l) {
    const int gw = blockIdx.x * NWAVES + F.wave, NGW = F.G * NWAVES;
    const int stride = NGW >= 128 ? NGW / 128 : 1;
    for (int u = 0; u < 128; ++u) {
        if ((u * stride) % NGW != gw) continue;
        if (u < 32) nscan<0>(F, l, u >> 3, (u >> 1) & 3, u & 1);
        else if (u < 64) { const int v = u - 32; nscan<1>(F, l, v >> 3, (v >> 1) & 3, v & 1); }
        else { const int v = u - 64; nscan<2>(F, l, v >> 4, v & 15, 0); }
    }
}
__device__ __forceinline__ void post_rows(Frame& F, int l) {
    const int gw = F.vcu * NWAVES + F.wave, NGW = F.G * NWAVES, lane = F.lane;
    const GAS float* hgw = INF(I_HGNW) + l * 512 + 8 * lane; const GAS float* mnw = INF(I_MNW) + l * 1024 + 8 * lane;
    const GAS bf16* Yb = WSB(WS_Y); const GAS bf16* Pb = WSB(WS_PROJ); GAS bf16* Ob = WSB(WS_O);
    float wv[3][8];
    { const f32x4 a = *(const GAS f32x4*)hgw, b4 = *(const GAS f32x4*)(hgw + 4), c4 = *(const GAS f32x4*)mnw, d4 = *(const GAS f32x4*)(mnw + 4), e4 = *(const GAS f32x4*)(mnw + 512), f4 = *(const GAS f32x4*)(mnw + 516);
      wv[0][0] = a.x; wv[0][1] = a.y; wv[0][2] = a.z; wv[0][3] = a.w; wv[0][4] = b4.x; wv[0][5] = b4.y; wv[0][6] = b4.z; wv[0][7] = b4.w;
      wv[1][0] = c4.x; wv[1][1] = c4.y; wv[1][2] = c4.z; wv[1][3] = c4.w; wv[1][4] = d4.x; wv[1][5] = d4.y; wv[1][6] = d4.z; wv[1][7] = d4.w;
      wv[2][0] = e4.x; wv[2][1] = e4.y; wv[2][2] = e4.z; wv[2][3] = e4.w; wv[2][4] = f4.x; wv[2][5] = f4.y; wv[2][6] = f4.z; wv[2][7] = f4.w; }
    for (int row = gw; row < M; row += NGW) {
        const GAS bf16* yr = Yb + (size_t)row * 2048 + 8 * lane; const GAS bf16* pr = Pb + (size_t)row * NPROJ + 8 * lane; GAS bf16* orow = Ob + (size_t)row * 2048 + 8 * lane;
        v4u yw[4], gq[4];
#pragma unroll
        for (int j = 0; j < 4; ++j) yw[j] = *(const GAS v4u*)(yr + 512 * j);
        gq[0] = *(const GAS v4u*)(pr + C_RG); gq[1] = *(const GAS v4u*)(pr + C_HG); gq[2] = *(const GAS v4u*)(pr + C_MZ); gq[3] = *(const GAS v4u*)(pr + C_MZ + 512);
#pragma unroll
        for (int j = 0; j < 4; ++j) {
            float y[8], g[8], o[8]; unpack8(yw[j], y); unpack8(gq[j], g);
            if (j < 2) {
                float ss = 0.f;
#pragma unroll
                for (int e = 0; e < 8; ++e) ss += y[e] * y[e];
                ss = grp16_sum(ss);
                const float r = 1.f / sqrtf(ss * (1.f / 128.f) + RMS_EPS);
#pragma unroll
                for (int e = 0; e < 8; ++e) o[e] = y[e] * r * (j == 1 ? wv[0][e] : 1.f) * siluf_(g[e]);
            } else {
                float ss = 0.f;
#pragma unroll
                for (int e = 0; e < 8; ++e) { y[e] = y[e] * siluf_(g[e]); ss += y[e] * y[e]; }
                ss = wave_sum(ss);
                const float r = 1.f / sqrtf(ss * (1.f / 512.f) + RMS_EPS);
#pragma unroll
                for (int e = 0; e < 8; ++e) o[e] = y[e] * r * wv[j - 1][e];
            }
            *(GAS v4u*)(orow + 512 * j) = pack8(o);
        }
    }
}

struct Args { const void* in[19]; float* out; unsigned char* ws; int ph_lo, ph_hi, flags, pad; };
__global__ void __launch_bounds__(NWAVES * 64, 2) hymba_fwd(Args args) {
    extern __shared__ __attribute__((aligned(16))) unsigned char lds[];
    asm volatile("s_nop 0\ns_nop 0\ns_nop 0\ns_nop 0\ns_nop 0\ns_nop 0\ns_nop 0\ns_nop 0\n" ::: );
    Frame F;
    F.lds = (LAS unsigned char*)lds;
    F.MISC = (volatile LAS unsigned*)(F.lds + MISC_OFF);
    F.tid = threadIdx.x; F.lane = F.tid & 63; F.wave = __builtin_amdgcn_readfirstlane(F.tid >> 6);
    F.G = gridDim.x; { const int bx = blockIdx.x; F.vcu = (F.G % 8 == 0) ? (bx % 8) * (F.G / 8) + bx / 8 : bx; }
    F.ws = (GAS unsigned char*)args.ws;
    F.ctl = (gu32*)(args.ws + WS_CTL);
    for (int u = F.tid; u < LDSCTL_BYTES / 4; u += NWAVES * 64) ((LAS unsigned*)(F.lds + LDSCTL_OFF))[u] = 0u;
    __syncthreads();
    if (F.tid == 0) {
#pragma unroll
        for (int i = 0; i < 19; ++i) ((LAS unsigned long long*)(F.lds + PTAB_OFF))[i] = (unsigned long long)args.in[i];
        ((LAS unsigned long long*)(F.lds + PTAB_OFF))[19] = (unsigned long long)args.out;
        ((LAS unsigned long long*)(F.lds + PTAB_OFF))[20] = (unsigned long long)args.ws;
    }
    __syncthreads();
    const int lo = args.ph_lo, hi = args.ph_hi;
    XcdBarrier bar; bar.bar = (unsigned*)(F.ctl + CW_BAR); bar.x = 0; bar.st = nullptr;
    if (hi - lo > 1) bar = xcd_barrier_post((unsigned*)(F.ctl + CW_BAR), F.MISC + 8);
    int ph = 0;
#define PHASE_BEGIN if (ph >= lo && ph < hi) { { int t_; asm volatile("v_mov_b32 %0, %1" : "=v"(t_) : "v"((int)threadIdx.x)); F.tid = t_; F.lane = t_ & 63; F.wave = __builtin_amdgcn_readfirstlane(t_ >> 6); }
#define PHASE_END   if (ph + 1 < hi) xcd_barrier(bar); } ++ph;

    PHASE_BEGIN
#ifndef X_NO_PRO
 p0_prologue(F);
#endif
 PHASE_END
    PHASE_BEGIN
#ifndef X_NO_LN
 mod_rows(F, INF(I_X), WSF(WS_ADA), 1, 0);
#endif
 PHASE_END
    for (int l = 0; l < DEPTH; ++l) {
        const GAS float* ada_l = WSF(WS_ADA) + (size_t)l * BATCH * NADA;
        PHASE_BEGIN
#ifndef X_NO_GIN
{
            pg8::Gemm g{(const pg8::bf16_t*)WSB(WS_H), (const pg8::bf16_t*)(WSB(WS_WIN) + (size_t)l * NPROJ * D), M, NPROJ, D}; pg8::StaticOrder S; S.init(M, NPROJ, F.G, (int)blockIdx.x);
            pg8::EpiProj E{F.lds + PTAB_OFF, WS_PROJ, WS_DTRAW, NPROJ, C_DT / 256};
            pg8::gemm_phase<pg8::EpiProj, pg8::StaticOrder, PG8_ALIGN, PG8_SP2>(F.lds + RING_OFF, g, S, E);
            constexpr int NU = (M / 256) * (NPROJ / 256); const int full = NU / F.G, rem = NU % F.G;
            if (l + 1 < DEPTH) { if (rem != 0 && (int)blockIdx.x >= rem) convert_next_in_out(F, l + 1, (int)blockIdx.x - rem, F.G - rem); else if (rem == 0) convert_next_in_out(F, l + 1, (int)blockIdx.x, F.G); }
            (void)full;
        }
#endif
 PHASE_END
        PHASE_BEGIN
#if MIXER_NAIVE
 npre_rows(F, l);
#else
 mixer_pre(F, l, args.flags);
#endif
 PHASE_END
        PHASE_BEGIN
#if MIXER_NAIVE
 nloop(F, l);
#else
#ifndef X_NO_LOOP
 mixer_loop(F);
#endif
#endif
 PHASE_END
        PHASE_BEGIN
#ifndef X_NO_POST
 post_rows(F, l);
#endif
 PHASE_END
        PHASE_BEGIN
#ifndef X_NO_GOUT
{
            pg8::Gemm g{(const pg8::bf16_t*)WSB(WS_O), (const pg8::bf16_t*)(WSB(WS_WOUT) + (size_t)l * D * D), M, D, D}; pg8::StaticOrder S; S.init(M, D, F.G, (int)blockIdx.x);
            pg8::EpiRes E{F.lds + PTAB_OFF, WS_T, WS_ADA + ((size_t)l * BATCH * NADA + 2 * D) * 4, WS_STAT, D, NADA, l == 0 ? -1 : l * 2 - 1, ALPHA, (size_t)0};
            pg8::gemm_phase<pg8::EpiRes, pg8::StaticOrder, PG8_ALIGN, PG8_SP2>(F.lds + RING_OFF, g, S, E);
        }
#endif
 PHASE_END
        PHASE_BEGIN
#ifndef X_NO_LN
 ln_rows(F, WSB(WS_T), (const GAS float*)nullptr, INF(I_LNG) + (size_t)(l * 2 + 0) * D, INF(I_LNB) + (size_t)(l * 2 + 0) * D, WSF(WS_X), WSF(WS_STAT), ada_l, 4, 3, true);
#endif
 PHASE_END
        PHASE_BEGIN
#ifndef X_NO_G1
{
            pg8::Gemm g{(const pg8::bf16_t*)WSB(WS_H), (const pg8::bf16_t*)(WSB(WS_W1) + (size_t)l * DFF * D), M, DFF, D}; pg8::StaticOrder S; S.init(M, DFF, F.G, (int)blockIdx.x);
            pg8::EpiRelu2 E{F.lds + PTAB_OFF, WS_U, DFF};
            pg8::gemm_phase<pg8::EpiRelu2, pg8::StaticOrder, PG8_ALIGN, PG8_SP2>(F.lds + RING_OFF, g, S, E);
        }
#endif
 PHASE_END
        PHASE_BEGIN
#ifndef X_NO_G2
{
            pg8::Gemm g{(const pg8::bf16_t*)WSB(WS_U), (const pg8::bf16_t*)(WSB(WS_W2) + (size_t)l * D * DFF), M, D, DFF}; pg8::StaticOrder S; S.init(M, D, F.G, (int)blockIdx.x);
            pg8::EpiRes E{F.lds + PTAB_OFF, WS_T, WS_ADA + ((size_t)l * BATCH * NADA + 5 * D) * 4, WS_STAT, D, NADA, l * 2, ALPHA, (l == DEPTH - 1) ? (size_t)WS_X : (size_t)0};
            pg8::gemm_phase<pg8::EpiRes, pg8::StaticOrder, PG8_ALIGN, PG8_SP2>(F.lds + RING_OFF, g, S, E);
        }
#endif
 PHASE_END
        PHASE_BEGIN
#ifndef X_NO_LN
 ln_rows(F, WSB(WS_T), (l == DEPTH - 1) ? (const GAS float*)WSF(WS_X) : (const GAS float*)nullptr, INF(I_LNG) + (size_t)(l * 2 + 1) * D, INF(I_LNB) + (size_t)(l * 2 + 1) * D, (GAS float*)ptab_get(F, I_OUT), WSF(WS_STAT), ada_l + (size_t)BATCH * NADA, 1, 0, l < DEPTH - 1);
#endif
 PHASE_END
    }
#undef PHASE_BEGIN
#undef PHASE_END
}

extern "C" void kernel_launch(void* const* d_in, const int* in_sizes, int n_in, void* d_out, int out_size, void* d_ws, size_t ws_size, hipStream_t stream) {
    static int grid = 0;
    if (grid == 0) {
        if (n_in != 19 || in_sizes[0] != M * D || out_size != M * D || ws_size < WS_END) { fprintf(stderr, "kernel_launch: unexpected shapes (n_in %d, in0 %d, out %d, ws %zu)\n", n_in, n_in > 0 ? in_sizes[0] : -1, out_size, ws_size); grid = -1; return; }
        int dev = 0, cus = 0, per_cu = 0;
        if (hipGetDevice(&dev) != hipSuccess || hipDeviceGetAttribute(&cus, hipDeviceAttributeMultiprocessorCount, dev) != hipSuccess) { grid = -1; return; }
        if (hipFuncSetAttribute((const void*)hymba_fwd, hipFuncAttributeMaxDynamicSharedMemorySize, LDS_BYTES) != hipSuccess) { fprintf(stderr, "kernel_launch: hipFuncSetAttribute failed\n"); grid = -1; return; }
        if (hipOccupancyMaxActiveBlocksPerMultiprocessor(&per_cu, (const void*)hymba_fwd, NWAVES * 64, LDS_BYTES) != hipSuccess || per_cu < 1)
            fprintf(stderr, "kernel_launch: note: occupancy query reports %d workgroups per CU\n", per_cu);
        (void)hipGetLastError();
        grid = cus;
    }
    if (grid < 0) return;
    if (hipMemsetAsync((char*)d_ws + WS_CTL, 0, CTL_ZERO_BYTES, stream) != hipSuccess) return;
    Args a{};
    for (int i = 0; i < 19; ++i) a.in[i] = d_in[i];
    a.out = (float*)d_out; a.ws = (unsigned char*)d_ws;
#if MK_PER_PHASE
    for (int p = 0; p < N_PHASES; ++p) { a.ph_lo = p; a.ph_hi = p + 1; hipLaunchKernelGGL(hymba_fwd, dim3(grid), dim3(NWAVES * 64), LDS_BYTES, stream, a); }
#else
    a.ph_lo = 0; a.ph_hi = N_PHASES;
    hipLaunchKernelGGL(hymba_fwd, dim3(grid), dim3(NWAVES * 64), LDS_BYTES, stream, a);
#if defined(PROBE_SET)
#ifndef PROBE_FLAGS
#define PROBE_FLAGS 0
#endif
    {
        const int L3 = 2 + 3 * PH_PER_LAYER;
        const int sets[10][4] = { {0, -1, -1, -1}, {L3 + 0, L3 + 4, L3 + 6, L3 + 7}, {L3 + 1, L3 + 2, L3 + 3, -1}, {L3 + 5, L3 - 1, -1, -1}, {L3 + 1, -1, -1, -1}, {L3 + 2, -1, -1, -1}, {L3 + 0, -1, -1, -1}, {L3 + 7, -1, -1, -1}, {L3 + 4, -1, -1, -1}, {L3 + 6, -1, -1, -1} };
        for (int rep = 0; rep < PROBE_REPS; ++rep) for (int k = 0; k < 4; ++k) { const int p = sets[PROBE_SET][k]; if (p < 0) continue;
            a.ph_lo = p; a.ph_hi = p + 1; a.flags = PROBE_FLAGS; hipLaunchKernelGGL(hymba_fwd, dim3(grid), dim3(NWAVES * 64), LDS_BYTES, stream, a); }
    }
#endif
#endif
    const hipError_t le = hipPeekAtLastError();
    if (le != hipSuccess) fprintf(stderr, "kernel_launch: launch failed: %s\n", hipGetErrorName(le));
}
```

```cpp
#include <hip/hip_runtime.h>
#include <cstdio>
#include <cstdint>
namespace pg8 {
#define PG8_LAS __attribute__((address_space(3)))
typedef unsigned short bf16_t;
typedef short bf16x8 __attribute__((ext_vector_type(8)));
typedef float f32x4 __attribute__((ext_vector_type(4)));
typedef unsigned u32x4 __attribute__((ext_vector_type(4)));
constexpr int BM = 256, BK = 64, HALF = 128, HTB = HALF * BK * 2  , STAGE_BYTES = 8 * HTB, NXCD = 8, WGM = 8;

__host__ __device__ __forceinline__ int lds_byte(int r, int c) { const int st = (r >> 4) * 2 + (c >> 5), rr = r & 15, cc = c & 31, ob = rr * 64 + cc * 2; return st * 1024 + (ob ^ (((ob >> 9) & 1) << 5)); }
__host__ __device__ __forceinline__ void stage_rc(int b, int& R, int& C) { const int st = b / 1024, sb = b % 1024, swz = sb ^ (((sb >> 9) & 1) << 5); R = (st >> 1) * 16 + swz / 64; C = (st & 1) * 32 + (swz % 64) / 2; }
__host__ __device__ __forceinline__ int perm32(int rho) { const int n = rho >> 4, i = rho & 15; return 8 * (i >> 2) + 4 * n + (i & 3); }

struct Unit { int pm, pn; };
struct Gemm { const bf16_t* A; const bf16_t* Bt; int M, N, K; };

struct StaticOrder {
    int nM, nN, nwg, G, c;
    __host__ __device__ void init(int M, int N, int G_, int c_) { nM = M / BM; nN = N / BM; nwg = nM * nN; G = G_; c = c_; }
    __host__ __device__ bool next(int i, Unit& u) const {
        const long L = (long)i * G + c; if (L >= nwg) return false;
        int wgid = (int)L; { const int q = nwg / NXCD, r = nwg % NXCD, xcd = wgid % NXCD, off = wgid / NXCD; wgid = (xcd < r ? xcd * (q + 1) : r * (q + 1) + (xcd - r) * q) + off; }
        const int nig = WGM * nN, gid = wgid / nig, fm = gid * WGM, gsz = (nM - fm) < WGM ? (nM - fm) : WGM;
        u.pm = fm + ((wgid % nig) % gsz); u.pn = (wgid % nig) / gsz; return true;
    }
    __device__ __forceinline__ void a_ready(const Unit&) const {}
    __device__ __forceinline__ void done(const Unit&) const {}
};

typedef float f32x2 __attribute__((ext_vector_type(2)));
#define PG8_GAS __attribute__((address_space(1)))
__device__ __forceinline__ unsigned long long tab_get(PG8_LAS const unsigned char* tab, int i) {
    const unsigned long long v = ((const volatile PG8_LAS unsigned long long*)tab)[i];
    const unsigned lo = __builtin_amdgcn_readfirstlane((unsigned)v), hi = __builtin_amdgcn_readfirstlane((unsigned)(v >> 32));
    return ((unsigned long long)hi << 32) | lo;
}
__device__ __forceinline__ unsigned cvt_pk_bf16(float lo, float hi) { unsigned r; asm volatile("v_cvt_pk_bf16_f32 %0, %1, %2" : "=v"(r) : "v"(lo), "v"(hi)); return r; }

struct EpiProj {
    static constexpr bool PERM = true, AFTER_DRAIN = false;
    PG8_LAS const unsigned char* tab; size_t o_off, dt_off; int ldc; int dt_pn;
    __device__ __forceinline__ void operator()(const f32x4 (&acc)[2][2][4][2], const Unit& u, int wr, int wc, int fr, int fq) const {
        PG8_GAS unsigned char* wsb = (PG8_GAS unsigned char*)tab_get(tab, 20); PG8_GAS bf16_t* O = (PG8_GAS bf16_t*)(wsb + o_off); PG8_GAS float* dtraw = (PG8_GAS float*)(wsb + dt_off);
        const int row0 = u.pm * BM + wr * 64 + fr; const int col0 = u.pn * BM + wc * 32 + 8 * fq;
        const bool isdt = (u.pn == dt_pn) && (wc == 0) && (fq < 2);
#pragma unroll
        for (int ai = 0; ai < 2; ++ai)
#pragma unroll
            for (int m = 0; m < 4; ++m) { const int row = row0 + ai * HALF + m * 16; PG8_GAS bf16_t* rowp = O + (size_t)row * ldc + col0;
#pragma unroll
                for (int bj = 0; bj < 2; ++bj) { const f32x4 v0 = acc[ai][bj][m][0], v1 = acc[ai][bj][m][1];
                    u32x4 w; w.x = cvt_pk_bf16(v0[0], v0[1]); w.y = cvt_pk_bf16(v0[2], v0[3]); w.z = cvt_pk_bf16(v1[0], v1[1]); w.w = cvt_pk_bf16(v1[2], v1[3]);
                    *(PG8_GAS u32x4*)(rowp + bj * HALF) = w;
                    if (bj == 0 && isdt) { PG8_GAS float* dp = dtraw + (size_t)row * 16 + 8 * fq; *(PG8_GAS f32x4*)dp = v0; *(PG8_GAS f32x4*)(dp + 4) = v1; } } }
    }
};
struct EpiRelu2 {
    static constexpr bool PERM = true, AFTER_DRAIN = false;
    PG8_LAS const unsigned char* tab; size_t o_off; int ldc;
    __device__ __forceinline__ void operator()(const f32x4 (&acc)[2][2][4][2], const Unit& u, int wr, int wc, int fr, int fq) const {
        PG8_GAS bf16_t* O = (PG8_GAS bf16_t*)((PG8_GAS unsigned char*)tab_get(tab, 20) + o_off);
        const int row0 = u.pm * BM + wr * 64 + fr; const int col0 = u.pn * BM + wc * 32 + 8 * fq;
#pragma unroll
        for (int ai = 0; ai < 2; ++ai)
#pragma unroll
            for (int m = 0; m < 4; ++m) { PG8_GAS bf16_t* rowp = O + (size_t)(row0 + ai * HALF + m * 16) * ldc + col0;
#pragma unroll
                for (int bj = 0; bj < 2; ++bj) { f32x4 v0 = acc[ai][bj][m][0], v1 = acc[ai][bj][m][1];
#pragma unroll
                    for (int j = 0; j < 4; ++j) { const float a = fmaxf(v0[j], 0.f), b = fmaxf(v1[j], 0.f); v0[j] = a * a; v1[j] = b * b; }
                    u32x4 w; w.x = cvt_pk_bf16(v0[0], v0[1]); w.y = cvt_pk_bf16(v0[2], v0[3]); w.z = cvt_pk_bf16(v1[0], v1[1]); w.w = cvt_pk_bf16(v1[2], v1[3]);
                    *(PG8_GAS u32x4*)(rowp + bj * HALF) = w; } }
    }
};
struct EpiRes {
    static constexpr bool PERM = true, AFTER_DRAIN = false;
    PG8_LAS const unsigned char* tab; size_t t_off, gate_off, stat_off; int ldc, gstride, ln_idx  ; float alpha; size_t tf_off  ;
    __device__ __forceinline__ void operator()(const f32x4 (&acc)[2][2][4][2], const Unit& u, int wr, int wc, int fr, int fq) const {
        PG8_GAS unsigned char* wsb = (PG8_GAS unsigned char*)tab_get(tab, 20);
        PG8_GAS bf16_t* T = (PG8_GAS bf16_t*)(wsb + t_off); const PG8_GAS float* gate = (const PG8_GAS float*)(wsb + gate_off); const PG8_GAS float* stats = (const PG8_GAS float*)(wsb + stat_off);
        const PG8_GAS float* lng = ln_idx >= 0 ? (const PG8_GAS float*)tab_get(tab, 8) + (size_t)ln_idx * ldc : nullptr; const PG8_GAS float* lnb = ln_idx >= 0 ? (const PG8_GAS float*)tab_get(tab, 9) + (size_t)ln_idx * ldc : nullptr;
        const PG8_GAS float* xraw = (const PG8_GAS float*)tab_get(tab, 0);
        const int row0 = u.pm * BM + wr * 64 + fr, col0 = u.pn * BM + wc * 32 + 8 * fq;
        const PG8_GAS float* gp = gate + (size_t)(u.pm >> 3) * gstride + col0;
#pragma unroll
        for (int bj = 0; bj < 2; ++bj) { const int co = bj * HALF;
            const f32x4 gv0 = *(const PG8_GAS f32x4*)(gp + co) + 1.0f, gv1 = *(const PG8_GAS f32x4*)(gp + co + 4) + 1.0f;
            f32x4 lg0 = (f32x4){alpha, alpha, alpha, alpha}, lg1 = lg0, lb0 = (f32x4){0.f, 0.f, 0.f, 0.f}, lb1 = lb0;
            if (lng) { lg0 = *(const PG8_GAS f32x4*)(lng + col0 + co) * alpha; lg1 = *(const PG8_GAS f32x4*)(lng + col0 + co + 4) * alpha; lb0 = *(const PG8_GAS f32x4*)(lnb + col0 + co) * alpha; lb1 = *(const PG8_GAS f32x4*)(lnb + col0 + co + 4) * alpha; }
#pragma unroll
            for (int ai = 0; ai < 2; ++ai)
#pragma unroll
                for (int m = 0; m < 4; ++m) { const int row = row0 + ai * HALF + m * 16; const size_t off = (size_t)row * ldc + col0 + co;
                    float mu_ = 0.f, rs_ = 1.f; if (lng) { const f32x2 st = *(const PG8_GAS f32x2*)(stats + 2 * (size_t)row); mu_ = st.x; rs_ = st.y; }
                    f32x4 x0, x1;
                    if (lng) { const u32x4 tw = *(const PG8_GAS u32x4*)(T + off);
                        x0 = (f32x4){__builtin_bit_cast(float, tw.x << 16), __builtin_bit_cast(float, tw.x & 0xffff0000u), __builtin_bit_cast(float, tw.y << 16), __builtin_bit_cast(float, tw.y & 0xffff0000u)};
                        x1 = (f32x4){__builtin_bit_cast(float, tw.z << 16), __builtin_bit_cast(float, tw.z & 0xffff0000u), __builtin_bit_cast(float, tw.w << 16), __builtin_bit_cast(float, tw.w & 0xffff0000u)}; }
                    else { x0 = *(const PG8_GAS f32x4*)(xraw + off); x1 = *(const PG8_GAS f32x4*)(xraw + off + 4); }
                    const f32x4 t0 = ((x0 - mu_) * rs_) * lg0 + lb0 + gv0 * acc[ai][bj][m][0], t1 = ((x1 - mu_) * rs_) * lg1 + lb1 + gv1 * acc[ai][bj][m][1];
                    if (tf_off) { PG8_GAS float* tf = (PG8_GAS float*)(wsb + tf_off) + off; *(PG8_GAS f32x4*)tf = t0; *(PG8_GAS f32x4*)(tf + 4) = t1; }
                    else { u32x4 w; w.x = cvt_pk_bf16(t0[0], t0[1]); w.y = cvt_pk_bf16(t0[2], t0[3]); w.z = cvt_pk_bf16(t1[0], t1[1]); w.w = cvt_pk_bf16(t1[2], t1[3]);
                        *(PG8_GAS u32x4*)(T + off) = w; } }
            asm volatile("" ::: "memory"); }
    }
};

template <class Epi, class Sched, bool ALIGN_EPI = false, bool SP2 = false>
__device__ __forceinline__ void gemm_phase(PG8_LAS unsigned char* lds, const Gemm g, const Sched& S, const Epi& E) {
    int tid_l; asm volatile("v_mov_b32 %0, %1" : "=v"(tid_l) : "v"((int)threadIdx.x));
    const int tid = tid_l, wid = __builtin_amdgcn_readfirstlane(tid >> 6), lane = tid & 63, wr = wid >> 2, wc = wid & 3, fr = lane & 15, fq = lane >> 4;
    const int K = g.K, nt = K / BK;
    unsigned voffA[2], voffB[2];
#pragma unroll
    for (int i = 0; i < 2; ++i) { int R, C; stage_rc(tid * 16 + i * 8192, R, C); const int Rb = Epi::PERM ? ((R & ~31) + perm32(R & 31)) : R;
        voffA[i] = (unsigned)(R * K + C) * 2u; voffB[i] = (unsigned)(Rb * K + C) * 2u; }
    const size_t kstep = (size_t)(BK * 2);
    const size_t hstep = (size_t)HALF * K * 2;
    const size_t tstep = 2 * hstep;
    const unsigned ldsw = (unsigned)wid * 1024u;
    const int aoff = lds_byte(wr * 64 + fr, fq * 8), boff = lds_byte(wc * 32 + fr, fq * 8);
#define PG8_SA(b, h) (((b) * 2 + (h)) * HTB)
#define PG8_SB(b, h) ((4 + (b) * 2 + (h)) * HTB)
#define PG8_STAGE(bufoff, gbase, voff) do { _Pragma("unroll") for (int _i = 0; _i < 2; ++_i) \
        __builtin_amdgcn_global_load_lds((const unsigned*)((const char*)(gbase) + (voff)[_i]), (PG8_LAS unsigned*)(lds + (bufoff) + ldsw + _i * 8192), 16, 0, 0); } while (0)
#define PG8_LDA(dst, b, h) do { _Pragma("unroll") for (int m = 0; m < 4; ++m) _Pragma("unroll") for (int k = 0; k < 2; ++k) dst[m][k] = *(const PG8_LAS bf16x8*)(lds + PG8_SA(b, h) + aoff + m * 2048 + k * 1024); } while (0)
#define PG8_LDB(dst, b, h) do { _Pragma("unroll") for (int n = 0; n < 2; ++n) _Pragma("unroll") for (int k = 0; k < 2; ++k) dst[n][k] = *(const PG8_LAS bf16x8*)(lds + PG8_SB(b, h) + boff + n * 2048 + k * 1024); } while (0)
#define PG8_MMA(ai, bj, At, Bt) do { __builtin_amdgcn_s_setprio(1); _Pragma("unroll") for (int m = 0; m < 4; ++m) _Pragma("unroll") for (int n = 0; n < 2; ++n) _Pragma("unroll") for (int k = 0; k < 2; ++k) \
        acc[ai][bj][m][n] = __builtin_amdgcn_mfma_f32_16x16x32_bf16(Bt[n][k], At[m][k], acc[ai][bj][m][n], 0, 0, 0); __builtin_amdgcn_s_setprio(0); } while (0)
#define PG8_WAIT_V(n) asm volatile("s_waitcnt vmcnt(" #n ")" ::: "memory")
#define PG8_WAIT_L(n) asm volatile("s_waitcnt lgkmcnt(" #n ")" ::: "memory")
#define PG8_BAR __builtin_amdgcn_s_barrier()
#define PG8_SCHED __builtin_amdgcn_sched_barrier(0)
    Unit cur, nxt; int ui = 0;
    if (!S.next(0, cur)) return;
    f32x4 acc[2][2][4][2];
#pragma unroll
    for (int a = 0; a < 2; ++a)
#pragma unroll
        for (int b = 0; b < 2; ++b)
#pragma unroll
            for (int m = 0; m < 4; ++m)
#pragma unroll
                for (int n = 0; n < 2; ++n) acc[a][b][m][n] = (f32x4){0.f, 0.f, 0.f, 0.f};
    bf16x8 At[4][2], B0[2][2], B1[2][2];
    const char* cA = (const char*)g.A + (size_t)cur.pm * tstep; const char* cB = (const char*)g.Bt + (size_t)cur.pn * tstep;
    S.a_ready(cur);
    if constexpr (SP2) {
        PG8_STAGE(PG8_SB(0, 0), cB, voffB); PG8_STAGE(PG8_SB(0, 1), cB + hstep, voffB); PG8_STAGE(PG8_SA(0, 0), cA, voffA); PG8_STAGE(PG8_SA(0, 1), cA + hstep, voffA);
        if (wr == 1) PG8_BAR;
        PG8_WAIT_V(2); PG8_BAR;
        PG8_STAGE(PG8_SB(1, 0), cB + kstep, voffB); PG8_STAGE(PG8_SA(1, 0), cA + kstep, voffA); PG8_STAGE(PG8_SB(1, 1), cB + hstep + kstep, voffB);
        PG8_WAIT_V(6); PG8_BAR;
    } else {
        PG8_STAGE(PG8_SB(0, 0), cB, voffB); PG8_STAGE(PG8_SA(0, 0), cA, voffA); PG8_STAGE(PG8_SB(0, 1), cB + hstep, voffB); PG8_STAGE(PG8_SA(0, 1), cA + hstep, voffA);
        if (wr == 1) PG8_BAR;
        PG8_WAIT_V(4); PG8_BAR;
        PG8_STAGE(PG8_SB(1, 0), cB + kstep, voffB); PG8_STAGE(PG8_SA(1, 0), cA + kstep, voffA); PG8_STAGE(PG8_SB(1, 1), cB + hstep + kstep, voffB);
        PG8_WAIT_V(6); PG8_BAR;
    }
    for (;;) {
        const bool has_next = S.next(ui + 1, nxt);
        const char* nA = has_next ? (const char*)g.A + (size_t)nxt.pm * tstep : cA; const char* nB = has_next ? (const char*)g.Bt + (size_t)nxt.pn * tstep : cB;
        for (int t = 0; t < nt; t += 2) {
            const bool last = (t == nt - 2);
            const char* a1 = cA + (size_t)(t + 1) * kstep;
            const char* a2 = last ? nA : cA + (size_t)(t + 2) * kstep; const char* b2 = last ? nB : cB + (size_t)(t + 2) * kstep;
            const char* a3 = a2 + kstep; const char* b3 = b2 + kstep;
            if (last && has_next) S.a_ready(nxt);
            if constexpr (SP2) {
            PG8_LDB(B0, 0, 0); PG8_LDB(B1, 0, 1); PG8_SCHED; PG8_LDA(At, 0, 0); PG8_STAGE(PG8_SA(1, 1), a1 + hstep, voffA);
            PG8_WAIT_V(8); PG8_WAIT_L(0); PG8_BAR; PG8_MMA(0, 0, At, B0); PG8_MMA(0, 1, At, B1); PG8_BAR; PG8_SCHED;
            PG8_LDA(At, 0, 1); PG8_STAGE(PG8_SB(0, 0), b2, voffB); PG8_STAGE(PG8_SB(0, 1), b2 + hstep, voffB); PG8_STAGE(PG8_SA(0, 0), a2, voffA);
            PG8_WAIT_V(8); PG8_WAIT_L(0); PG8_BAR; PG8_MMA(1, 0, At, B0); PG8_MMA(1, 1, At, B1); PG8_BAR; PG8_SCHED;
            PG8_LDB(B0, 1, 0); PG8_LDB(B1, 1, 1); PG8_SCHED; PG8_LDA(At, 1, 0); PG8_STAGE(PG8_SA(0, 1), a2 + hstep, voffA);
            PG8_WAIT_V(8); PG8_WAIT_L(0); PG8_BAR; PG8_MMA(0, 0, At, B0); PG8_MMA(0, 1, At, B1); PG8_BAR; PG8_SCHED;
            PG8_LDA(At, 1, 1); PG8_STAGE(PG8_SB(1, 0), b3, voffB); PG8_STAGE(PG8_SB(1, 1), b3 + hstep, voffB); PG8_STAGE(PG8_SA(1, 0), a3, voffA);
            PG8_WAIT_V(8); PG8_WAIT_L(0); PG8_BAR; PG8_MMA(1, 0, At, B0); PG8_MMA(1, 1, At, B1); PG8_BAR; PG8_SCHED;
            } else {
            PG8_LDB(B0, 0, 0); PG8_SCHED; PG8_LDA(At, 0, 0); PG8_STAGE(PG8_SA(1, 1), a1 + hstep, voffA);
            PG8_WAIT_L(8); PG8_BAR; PG8_WAIT_L(0); PG8_MMA(0, 0, At, B0); PG8_BAR; PG8_SCHED;
            PG8_LDB(B1, 0, 1); PG8_STAGE(PG8_SB(0, 0), b2, voffB);
            PG8_BAR; PG8_WAIT_L(0); PG8_MMA(0, 1, At, B1); PG8_BAR;
            PG8_LDA(At, 0, 1); PG8_STAGE(PG8_SA(0, 0), a2, voffA);
            PG8_BAR; PG8_WAIT_L(0); PG8_MMA(1, 0, At, B0); PG8_BAR; PG8_SCHED;
            PG8_STAGE(PG8_SB(0, 1), b2 + hstep, voffB);
            PG8_WAIT_V(6); PG8_BAR; PG8_MMA(1, 1, At, B1); PG8_BAR;
            PG8_LDB(B0, 1, 0); PG8_SCHED; PG8_LDA(At, 1, 0); PG8_STAGE(PG8_SA(0, 1), a2 + hstep, voffA);
            PG8_WAIT_L(8); PG8_BAR; PG8_WAIT_L(0); PG8_MMA(0, 0, At, B0); PG8_BAR; PG8_SCHED;
            PG8_LDB(B1, 1, 1); PG8_STAGE(PG8_SB(1, 0), b3, voffB);
            PG8_BAR; PG8_WAIT_L(0); PG8_MMA(0, 1, At, B1); PG8_BAR;
            PG8_LDA(At, 1, 1); PG8_STAGE(PG8_SA(1, 0), a3, voffA);
            PG8_BAR; PG8_WAIT_L(0); PG8_MMA(1, 0, At, B0); PG8_BAR; PG8_SCHED;
            PG8_STAGE(PG8_SB(1, 1), b3 + hstep, voffB);
            PG8_WAIT_V(6); PG8_BAR; PG8_MMA(1, 1, At, B1); PG8_BAR;
            }
        }
        if constexpr (ALIGN_EPI) { if (wr == 0) PG8_BAR; }
        if constexpr (!Epi::AFTER_DRAIN) { E(acc, cur, wr, wc, fr, fq); S.done(cur); }
        if (!has_next) break;
#pragma unroll
        for (int a = 0; a < 2; ++a)
#pragma unroll
            for (int b = 0; b < 2; ++b)
#pragma unroll
                for (int m = 0; m < 4; ++m)
#pragma unroll
                    for (int n = 0; n < 2; ++n) acc[a][b][m][n] = (f32x4){0.f, 0.f, 0.f, 0.f};
        cur = nxt; cA = nA; cB = nB; ++ui;
        if constexpr (ALIGN_EPI) { if (wr == 1) PG8_BAR; }
    }
    PG8_WAIT_V(0);
    if constexpr (!ALIGN_EPI) { if (wr == 0) PG8_BAR; }
    PG8_BAR;
    if constexpr (Epi::AFTER_DRAIN) { E.fused(acc, cur, wr, wc, fr, fq, lds, wid, lane); S.done(cur); }
#undef PG8_SA
#undef PG8_SB
#undef PG8_STAGE
#undef PG8_LDA
#undef PG8_LDB
#undef PG8_MMA
#undef PG8_WAIT_V
#undef PG8_WAIT_L
#undef PG8_BAR
#undef PG8_SCHED
}
}
#ifndef PG8_SP2
#define PG8_SP2 true
#endif
#ifndef PG8_ALIGN
#define PG8_ALIGN true
#endif
#ifndef MIXER_NAIVE
#define MIXER_NAIVE 0
#endif
#ifndef MK_PER_PHASE
#define MK_PER_PHASE 0
#endif

constexpr int NWAVES = 8;
constexpr int BATCH = 4, SEQ = 2048, D = 2048, DEPTH = 4, M = BATCH * SEQ;
constexpr int IN_COLS = 6672, NPROJ = 6912, DFF = 8192, NADA = 6 * D;
constexpr int C_RQ = 0, C_RK = 512, C_RV = 1024, C_RG = 1536, C_HQ = 2048, C_HF = 2560, C_HI = 3072, C_HG = 3584, C_MZ = 4096, C_MX = 5120, C_MB = 6144, C_MC = 6400, C_DT = 6656;
constexpr int MCONV = 1536;
constexpr float LN_EPS = 1e-5f, RMS_EPS = 1e-6f;
constexpr float ALPHA = 1.681792830507429f;
constexpr int PH_PER_LAYER = 9, N_PHASES = 2 + DEPTH * PH_PER_LAYER;

constexpr size_t MiB = 1u << 20;
constexpr size_t WS_CTL = 0, CTL_ZERO_BYTES = 1 * MiB;
constexpr size_t WS_ADA = 1 * MiB, WS_LBS = 2 * MiB, WS_DTRAW = 3 * MiB, WS_COS = 4 * MiB, WS_SIN = 6 * MiB;
constexpr size_t WS_WIN = 8 * MiB, WS_WOUT = 116 * MiB, WS_W1 = 148 * MiB, WS_W2 = 276 * MiB;
constexpr size_t WS_H = 404 * MiB, WS_Y = 436 * MiB, WS_O = 468 * MiB, WS_T = 500 * MiB, WS_X = 564 * MiB, WS_PROJ = 628 * MiB, WS_U = 736 * MiB;
constexpr size_t WS_NQ = 864 * MiB, WS_NK = 904 * MiB, WS_NV = 944 * MiB, WS_NF = 1008 * MiB, WS_NDT = 1024 * MiB, WS_NDA = 1025 * MiB, WS_END = 1026 * MiB;
static_assert(WS_WIN + (size_t)DEPTH * NPROJ * D * 2 <= WS_WOUT && WS_PROJ + (size_t)M * NPROJ * 2 <= WS_U && WS_U + (size_t)M * DFF * 2 <= WS_NQ, "d_ws map");
constexpr size_t WS_STAT = 2 * MiB + 512 * 1024;
constexpr int CW_BAR = 4096;

constexpr int LDSCTL_OFF = 0, MISC_OFF = LDSCTL_OFF + 320, LDSCTL_BYTES = 1024;
constexpr int RING_OFF = LDSCTL_BYTES, RING_BYTES = 146432;
constexpr int LDS_BYTES = 147456;

#define GAS __attribute__((address_space(1)))
#define LAS __attribute__((address_space(3)))
typedef unsigned short bf16;
typedef unsigned v4u __attribute__((ext_vector_type(4)));
typedef unsigned v2u __attribute__((ext_vector_type(2)));
typedef float f32x4 __attribute__((ext_vector_type(4)));
typedef float f32x2 __attribute__((ext_vector_type(2)));
typedef GAS unsigned gu32;
#define RLX_AGENT __ATOMIC_RELAXED, __HIP_MEMORY_SCOPE_AGENT
#define LDS_WAIT() asm volatile("s_waitcnt lgkmcnt(0)" ::: "memory")
#define VM_WAIT() asm volatile("s_waitcnt vmcnt(0)" ::: "memory")
__device__ __forceinline__ unsigned f2bf(float f) { unsigned u = __builtin_bit_cast(unsigned, f); return (u + 0x7fffu + ((u >> 16) & 1u)) >> 16; }
__device__ __forceinline__ unsigned pk2(float lo, float hi) { return f2bf(lo) | (f2bf(hi) << 16); }
__device__ __forceinline__ float bf2f(unsigned short h) { return __builtin_bit_cast(float, (unsigned)h << 16); }
__device__ __forceinline__ float bflo(unsigned w) { return __builtin_bit_cast(float, w << 16); }
__device__ __forceinline__ float bfhi(unsigned w) { return __builtin_bit_cast(float, w & 0xffff0000u); }
__device__ __forceinline__ float sigmoidf_(float x) { return __builtin_amdgcn_rcpf(1.0f + __expf(-x)); }
__device__ __forceinline__ float siluf_(float x) { return x * __builtin_amdgcn_rcpf(1.0f + __expf(-x)); }

#define XB_TMO      128
#define XB_XCNT(j)  (256  + 64 * (j))
#define XB_XSUB(j)  (1280 + 64 * (j))
#define XB_XGEN(j)  (2304 + 64 * (j))
#define XB_TOP      3328
#define XB_TOPGEN   3392
#define XCD_BAR_WORDS 3456
#define XB_SPIN_CAP (1u << 18)
__device__ __forceinline__ unsigned xb_ld(unsigned* p)              { return __hip_atomic_load(p, __ATOMIC_RELAXED, __HIP_MEMORY_SCOPE_AGENT); }
__device__ __forceinline__ unsigned xb_add(unsigned* p, unsigned v) { return __hip_atomic_fetch_add(p, v, __ATOMIC_RELAXED, __HIP_MEMORY_SCOPE_AGENT); }
__device__ __forceinline__ unsigned xb_xcc_id() { return (unsigned)__builtin_amdgcn_s_getreg((3 << 11) | 20) & 0xFu; }
#define XB_SPIN(cond, bar) do { unsigned _sp = 0; while (cond) { __builtin_amdgcn_s_sleep(1); \
    if ((++_sp & 255u) == 0u) { if (xb_ld(&(bar)[XB_TMO])) break; if (_sp > XB_SPIN_CAP) { atomicAdd(&(bar)[XB_TMO], 1u); break; } } } } while (0)
struct XcdBarrier { unsigned* bar; unsigned x; volatile LAS unsigned* st; };
__device__ __forceinline__ XcdBarrier xcd_barrier_post(unsigned* bar, volatile LAS unsigned* st) {
    XcdBarrier b; b.bar = bar; b.x = xb_xcc_id(); b.st = st;
    if (threadIdx.x == 0) (void)xb_add(&bar[XB_XCNT(b.x)], 1u);
    return b;
}
__device__ __forceinline__ void xcd_barrier_complete(unsigned* bar, unsigned x, unsigned& nloc, unsigned& nx) {
    const unsigned G = gridDim.x * gridDim.y * gridDim.z;
    unsigned sum, cnt, mine, sp = 0u;
    for (;;) {
        sum = 0u; cnt = 0u; mine = 0u;
#pragma unroll
        for (unsigned j = 0; j < 16; ++j) { const unsigned c = xb_ld(&bar[XB_XCNT(j)]); sum += c; cnt += (c > 0u) ? 1u : 0u; mine = (j == x) ? c : mine; }
        if (sum == G) break;
        __builtin_amdgcn_s_sleep(1);
        if ((++sp & 255u) == 0u) { if (xb_ld(&bar[XB_TMO])) break; if (sp > XB_SPIN_CAP) { atomicAdd(&bar[XB_TMO], 1u); break; } }
    }
    nloc = mine > 0u ? mine : 1u; nx = cnt > 0u ? cnt : 1u;
}
__device__ __forceinline__ void xcd_barrier(const XcdBarrier& b) {
    asm volatile("s_waitcnt vmcnt(0)" ::: "memory");
    __syncthreads();
    if (threadIdx.x == 0) {
        unsigned* bar = b.bar;
        __builtin_amdgcn_s_waitcnt(0);
        unsigned nloc = b.st[0], nx = b.st[1];
        if (nloc == 0u) { xcd_barrier_complete(bar, b.x, nloc, nx); b.st[0] = nloc; b.st[1] = nx; }
        const unsigned old = xb_add(&bar[XB_XSUB(b.x)], 1u);
        const unsigned gen = old / nloc;
        if (old + 1u == (gen + 1u) * nloc) {
            __builtin_amdgcn_fence(__ATOMIC_RELEASE, "agent");
            asm volatile("s_waitcnt vmcnt(0)" ::: "memory");
            const unsigned og = xb_add(&bar[XB_TOP], 1u);
            const unsigned tg = og / nx;
            if (og + 1u == (tg + 1u) * nx) xb_add(&bar[XB_TOPGEN], 1u);
            else XB_SPIN(xb_ld(&bar[XB_TOPGEN]) == tg, bar);
            __builtin_amdgcn_fence(__ATOMIC_ACQUIRE, "agent");
            xb_add(&bar[XB_XGEN(b.x)], 1u);
            asm volatile("s_waitcnt vmcnt(0)" ::: "memory");
        } else {
            XB_SPIN(xb_ld(&bar[XB_XGEN(b.x)]) == gen, bar);
            __builtin_amdgcn_fence(__ATOMIC_ACQUIRE, "agent");
            asm volatile("s_waitcnt vmcnt(0)" ::: "memory");
        }
    }
    __syncthreads();
}

struct Frame {
    LAS unsigned char* lds;
    volatile LAS unsigned* MISC;
    gu32* ctl;
    GAS unsigned char* ws;
    int tid, lane, wave, vcu, G;
};
constexpr int PTAB_OFF = MISC_OFF + 128;
enum { I_X = 0, I_C, I_POS, I_LB, I_WIN, I_WOUT, I_WADA, I_BADA, I_LNG, I_LNB, I_HGNW, I_CONVW, I_CONVB, I_DTB, I_ALOG, I_MD, I_MNW, I_W1, I_W2, I_OUT };
__device__ __forceinline__ unsigned long long ptab_get(const Frame& F, int i) {
    const unsigned long long v = ((const volatile LAS unsigned long long*)(F.lds + PTAB_OFF))[i];
    const unsigned lo = __builtin_amdgcn_readfirstlane((unsigned)v), hi = __builtin_amdgcn_readfirstlane((unsigned)(v >> 32));
    return ((unsigned long long)hi << 32) | lo;
}
#define INF(i) ((const GAS float*)ptab_get(F, (i)))
#define WSF(off) ((GAS float*)((GAS unsigned char*)F.ws + (off)))
#define WSB(off) ((GAS bf16*)((GAS unsigned char*)F.ws + (off)))

__device__ __forceinline__ float wave_sum(float v) {
#pragma unroll
    for (int o = 1; o < 64; o <<= 1) v += __shfl_xor(v, o);
    return v;
}
__device__ __forceinline__ float grp16_sum(float v) {
#pragma unroll
    for (int o = 1; o < 16; o <<= 1) v += __shfl_xor(v, o);
    return v;
}

struct TItem { const GAS float* src; GAS bf16* dst; int K, N, k0, n0; };
__device__ __forceinline__ void t_load(const TItem& d, int lane, f32x4 (&v)[16]) {
    const int r4 = lane >> 4, c4 = lane & 15;
    const bool ok = (d.n0 + 4 * c4) < d.N;
    const GAS float* src = d.src + (size_t)(d.k0 + r4) * d.N + d.n0 + 4 * c4;
#pragma unroll
    for (int i = 0; i < 16; ++i) v[i] = ok ? *(const GAS f32x4*)(src + (size_t)(4 * i) * d.N) : (f32x4){0.f, 0.f, 0.f, 0.f};
}
__device__ __forceinline__ void t_emit(const TItem& d, int lane, LAS float* scr, const f32x4 (&v)[16]) {
    const int r4 = lane >> 4, c4 = lane & 15;
#pragma unroll
    for (int i = 0; i < 16; ++i) { LAS float* q = scr + (4 * i + r4) * 65 + 4 * c4; q[0] = v[i].x; q[1] = v[i].y; q[2] = v[i].z; q[3] = v[i].w; }
    LDS_WAIT(); asm volatile("" ::: "memory");
    const int c = lane & 7;
#pragma unroll
    for (int j = 0; j < 8; ++j) { const int n = (lane >> 3) + 8 * j; const LAS float* sp = scr + (8 * c) * 65 + n;
        v4u o; o.x = pk2(sp[0 * 65], sp[1 * 65]); o.y = pk2(sp[2 * 65], sp[3 * 65]); o.z = pk2(sp[4 * 65], sp[5 * 65]); o.w = pk2(sp[6 * 65], sp[7 * 65]);
        *(GAS v4u*)(d.dst + (size_t)(d.n0 + n) * d.K + d.k0 + 8 * c) = o; }
    LDS_WAIT(); asm volatile("" ::: "memory");
}
constexpr int NB_IN = NPROJ / 64, I_IN = (D / 64) * NB_IN, NB_O = D / 64, I_O = (D / 64) * NB_O, NB_1 = DFF / 64, I_1 = (D / 64) * NB_1, NB_2 = D / 64, I_2 = (DFF / 64) * NB_2;
constexpr int L0_ITEMS = I_IN + I_O, PER_L12 = I_1 + I_2;
constexpr int TAIL_KB = 32, TAIL_N = TAIL_KB * NB_IN;
constexpr bool TAIL_WOUT = true;
constexpr int REST_L = (I_IN - TAIL_N) + (TAIL_WOUT ? 0 : I_O);
__device__ __forceinline__ TItem get_item(Frame& F, int mode, int ln, int it) {
    TItem d; int l = ln, r = it, which;
    if (mode == 0) {
        if (it < L0_ITEMS) { l = 0; if (r < I_IN) which = 0; else { which = 1; r -= I_IN; } }
        else if (it < L0_ITEMS + DEPTH * PER_L12) { l = (it - L0_ITEMS) / PER_L12; r = (it - L0_ITEMS) % PER_L12; if (r < I_1) which = 2; else { which = 3; r -= I_1; } }
        else { const int q = it - (L0_ITEMS + DEPTH * PER_L12); constexpr int RL = REST_L > 0 ? REST_L : 1; l = 1 + q / RL; r = q % RL; if (r < I_IN - TAIL_N) { which = 0; r += TAIL_N; } else { which = 1; r -= I_IN - TAIL_N; } }
    } else { if (r < TAIL_N) which = 0; else { which = 1; r -= TAIL_N; } }
    int nblk;
    if (which == 0) { d.src = INF(I_WIN) + (size_t)l * D * IN_COLS; d.dst = WSB(WS_WIN) + (size_t)l * NPROJ * D; d.K = D; d.N = IN_COLS; nblk = NB_IN; }
    else if (which == 1) { d.src = INF(I_WOUT) + (size_t)l * D * D; d.dst = WSB(WS_WOUT) + (size_t)l * D * D; d.K = D; d.N = D; nblk = NB_O; }
    else if (which == 2) { d.src = INF(I_W1) + (size_t)l * D * DFF; d.dst = WSB(WS_W1) + (size_t)l * DFF * D; d.K = D; d.N = DFF; nblk = NB_1; }
    else { d.src = INF(I_W2) + (size_t)l * DFF * D; d.dst = WSB(WS_W2) + (size_t)l * D * DFF; d.K = DFF; d.N = D; nblk = NB_2; }
    d.k0 = 64 * (r / nblk); d.n0 = 64 * (r % nblk);
    return d;
}
__device__ __forceinline__ void run_items(Frame& F, int mode, int ln, int first, int stride, int total) {
    LAS float* scr = (LAS float*)(F.lds + RING_OFF + F.wave * 16640);
    for (int it = first; it < total; it += stride) { f32x4 va[16]; const TItem da = get_item(F, mode, ln, it); t_load(da, F.lane, va); t_emit(da, F.lane, scr, va); }
}

__device__ __forceinline__ void p0_prologue(Frame& F) {
    LAS float* condS = (LAS float*)(F.lds + RING_OFF);
    LAS float* red = (LAS float*)(F.lds + RING_OFF + 32768);
    for (int i = F.tid; i < BATCH * D; i += NWAVES * 64) condS[i] = siluf_(INF(I_C)[i]);
    __syncthreads();
    for (int it = blockIdx.x; it < DEPTH * 64; it += F.G) {
        const int l = it >> 6, col0 = (it & 63) * 192;
        f32x4 acc[4];
#pragma unroll
        for (int b = 0; b < 4; ++b) acc[b] = (f32x4){0.f, 0.f, 0.f, 0.f};
        if (F.lane < 48) {
            const GAS float* wp = INF(I_WADA) + ((size_t)l * D + F.wave * 256) * NADA + col0 + 4 * F.lane;
#pragma unroll 16
            for (int k = 0; k < 256; ++k) { const f32x4 wv = *(const GAS f32x4*)(wp + (size_t)k * NADA); const int kk = F.wave * 256 + k;
#pragma unroll
                for (int b = 0; b < 4; ++b) acc[b] += wv * condS[b * D + kk]; }
#pragma unroll
            for (int b = 0; b < 4; ++b) *(LAS f32x4*)(red + (F.wave * 4 + b) * 192 + 4 * F.lane) = acc[b];
        }
        __syncthreads();
        for (int o = F.tid; o < 4 * 192; o += NWAVES * 64) { const int b = o / 192, j = o % 192; float s = INF(I_BADA)[(size_t)l * NADA + col0 + j];
#pragma unroll
            for (int w = 0; w < 8; ++w) s += red[(w * 4 + b) * 192 + j];
            WSF(WS_ADA)[((size_t)l * BATCH + b) * NADA + col0 + j] = s; }
        __syncthreads();
    }
    if (blockIdx.x == 0) {
        for (int j = F.tid; j < 512; j += NWAVES * 64) { float v[DEPTH], mx = -1e30f;
#pragma unroll
            for (int l = 0; l < DEPTH; ++l) { v[l] = INF(I_LB)[l * 512 + j]; mx = fmaxf(mx, v[l]); }
            float s = 0.f;
#pragma unroll
            for (int l = 0; l < DEPTH; ++l) { v[l] = __expf(v[l] - mx); s += v[l]; }
            float cum = 0.f; const float inv = 1.0f / s;
#pragma unroll
            for (int l = 0; l < DEPTH; ++l) { if (l > 0) cum += v[l] * inv; WSF(WS_LBS)[l * 512 + j] = cum; } }
    }
    {
        const int gt = blockIdx.x * (NWAVES * 64) + F.tid, NT = F.G * NWAVES * 64;
        for (int i = gt; i < M * 64; i += NT) { const int d = i & 63, row = i >> 6;
            const float invf = 1.0f / exp2f(((float)d * (1.0f / 63.0f)) * 13.287712379549449f);
            const float ang = (float)((const GAS int*)ptab_get(F, I_POS))[row] * invf;
            const float kq = rintf(ang * 0.15915494309189535f);
            float r = fmaf(-kq, 6.2831854820251465f, ang); r = fmaf(-kq, -1.7484555e-7f, r);
            WSF(WS_COS)[i] = __cosf(r); WSF(WS_SIN)[i] = __sinf(r); }
    }
    __syncthreads();
    run_items(F, 0, 0, F.vcu * NWAVES + F.wave, F.G * NWAVES, L0_ITEMS + DEPTH * PER_L12 + (DEPTH - 1) * REST_L);
}
__device__ __forceinline__ void convert_next_in_out(Frame& F, int ln, int rank, int nidle) {
    run_items(F, 1, ln, rank * NWAVES + F.wave, nidle * NWAVES, TAIL_N + (TAIL_WOUT ? I_O : 0));
}

__device__ __forceinline__ void mod_rows(Frame& F, const GAS float* xin, const GAS float* ada_l, int sc_chunk, int sh_chunk) {
    const int gw = F.vcu * NWAVES + F.wave, NGW = F.G * NWAVES;
    for (int row = gw; row < M; row += NGW) {
        const int b = row >> 11; const GAS float* ab = ada_l + (size_t)b * NADA;
        const GAS f32x4* xr = (const GAS f32x4*)(xin + (size_t)row * D) + F.lane;
        GAS v2u* ho = (GAS v2u*)(WSB(WS_H) + (size_t)row * D) + F.lane;
#pragma unroll
        for (int j = 0; j < 8; ++j) { const int col = 4 * (F.lane + 64 * j); const f32x4 v = xr[64 * j];
            const f32x4 sc = *(const GAS f32x4*)(ab + sc_chunk * D + col), sh = *(const GAS f32x4*)(ab + sh_chunk * D + col);
            const f32x4 h = v * (sc + 1.0f) + sh; v2u w; w.x = pk2(h.x, h.y); w.y = pk2(h.z, h.w); ho[64 * j] = w; }
    }
}
__device__ __forceinline__ void ln_rows(Frame& F, const GAS bf16* tin, const GAS float* tin32  , const GAS float* g, const GAS float* bt, GAS float* xout, GAS float* stats, const GAS float* ada_l, int sc_chunk, int sh_chunk, bool write_h) {
    const int gw = F.vcu * NWAVES + F.wave, NGW = F.G * NWAVES;
    const int per = (M + NGW - 1) / NGW, r0 = gw * per, r1 = (r0 + per < M) ? r0 + per : M;
    if (r0 >= M) return;
    const GAS float* ab = ada_l + (size_t)(r0 >> 11) * NADA;
    f32x4 G[8], B[8];
#pragma unroll
    for (int k = 0; k < 8; ++k) { const int col = 8 * (F.lane + 64 * (k >> 1)) + 4 * (k & 1); G[k] = *(const GAS f32x4*)(g + col); B[k] = *(const GAS f32x4*)(bt + col);
        if (write_h) { const f32x4 sc = *(const GAS f32x4*)(ab + sc_chunk * D + col) + 1.0f, sh = *(const GAS f32x4*)(ab + sh_chunk * D + col); G[k] = G[k] * sc; B[k] = B[k] * sc + sh; } }
    for (int rowa = r0; rowa < r1; rowa += 2) {
        const int rowb = rowa + 1; const bool hasb = rowb < r1; const int rowb_ = hasb ? rowb : rowa;
        const GAS v4u* ta = (const GAS v4u*)(tin + (size_t)rowa * D) + F.lane; const GAS v4u* tb = (const GAS v4u*)(tin + (size_t)rowb_ * D) + F.lane;
        f32x4 va[8], vb[8]; float sa = 0.f, sb = 0.f;
        if (tin32) {
            const GAS f32x4* fa = (const GAS f32x4*)(tin32 + (size_t)rowa * D) + 2 * F.lane; const GAS f32x4* fb = (const GAS f32x4*)(tin32 + (size_t)rowb_ * D) + 2 * F.lane;
#pragma unroll
            for (int j = 0; j < 4; ++j) { va[2 * j] = fa[128 * j]; va[2 * j + 1] = fa[128 * j + 1]; vb[2 * j] = fb[128 * j]; vb[2 * j + 1] = fb[128 * j + 1]; }
        } else {
        v4u wa[4], wb[4];
#pragma unroll
        for (int j = 0; j < 4; ++j) { wa[j] = ta[64 * j]; wb[j] = tb[64 * j]; }
#pragma unroll
        for (int j = 0; j < 4; ++j) {
            va[2 * j] = (f32x4){bflo(wa[j].x), bfhi(wa[j].x), bflo(wa[j].y), bfhi(wa[j].y)}; va[2 * j + 1] = (f32x4){bflo(wa[j].z), bfhi(wa[j].z), bflo(wa[j].w), bfhi(wa[j].w)};
            vb[2 * j] = (f32x4){bflo(wb[j].x), bfhi(wb[j].x), bflo(wb[j].y), bfhi(wb[j].y)}; vb[2 * j + 1] = (f32x4){bflo(wb[j].z), bfhi(wb[j].z), bflo(wb[j].w), bfhi(wb[j].w)}; }
        }
#pragma unroll
        for (int j = 0; j < 8; ++j) { sa += (va[j].x + va[j].y) + (va[j].z + va[j].w); sb += (vb[j].x + vb[j].y) + (vb[j].z + vb[j].w); }
        const float ma = wave_sum(sa) * (1.f / D), mb = wave_sum(sb) * (1.f / D); float qa = 0.f, qb = 0.f;
#pragma unroll
        for (int j = 0; j < 8; ++j) { va[j] = va[j] - ma; vb[j] = vb[j] - mb; qa += (va[j].x * va[j].x + va[j].y * va[j].y) + (va[j].z * va[j].z + va[j].w * va[j].w); qb += (vb[j].x * vb[j].x + vb[j].y * vb[j].y) + (vb[j].z * vb[j].z + vb[j].w * vb[j].w); }
        const float ra = 1.f / sqrtf(wave_sum(qa) * (1.f / D) + LN_EPS), rb = 1.f / sqrtf(wave_sum(qb) * (1.f / D) + LN_EPS);
        if (F.lane == 0) { *(GAS f32x2*)(stats + 2 * (size_t)rowa) = (f32x2){ma, ra}; if (hasb) *(GAS f32x2*)(stats + 2 * (size_t)rowb) = (f32x2){mb, rb}; }
#pragma unroll
        for (int half = 0; half < 2; ++half) {
            if (half == 1 && !hasb) break;
            const int row = half ? rowb : rowa; const float rstd = half ? rb : ra;
            GAS f32x4* xo = (GAS f32x4*)(xout + (size_t)row * D) + 2 * F.lane;
            GAS v4u* ho = (GAS v4u*)(WSB(WS_H) + (size_t)row * D) + F.lane;
#pragma unroll
            for (int j = 0; j < 4; ++j) { const f32x4 x0 = (half ? vb[2 * j] : va[2 * j]) * rstd * G[2 * j] + B[2 * j], x1 = (half ? vb[2 * j + 1] : va[2 * j + 1]) * rstd * G[2 * j + 1] + B[2 * j + 1];
                if (write_h) { v4u w; w.x = pk2(x0.x, x0.y); w.y = pk2(x0.z, x0.w); w.z = pk2(x1.x, x1.y); w.w = pk2(x1.z, x1.w); ho[64 * j] = w; }
                else { xo[128 * j] = x0; xo[128 * j + 1] = x1; } }
        }
    }
}

typedef short bf16x8 __attribute__((ext_vector_type(8)));
typedef short s16x4 __attribute__((ext_vector_type(4)));
typedef float f32x16 __attribute__((ext_vector_type(16)));
typedef __bf16 bf16x2_t __attribute__((ext_vector_type(2)));
constexpr int TS = 272;
constexpr int XS = 528;
constexpr size_t WS_QI = 864 * MiB, WS_SLR = 884 * MiB, WS_SLH = 892 * MiB, WS_SLM = 908 * MiB, WS_DECH = 924 * MiB, WS_RS = 925 * MiB, WS_CD = 926 * MiB;
constexpr int QIW = 1280;
#define MFMA32(a, b, c) __builtin_amdgcn_mfma_f32_32x32x16_bf16((a), (b), (c), 0, 0, 0)
__device__ __forceinline__ unsigned pkf(float lo, float hi) { f32x2 v = {lo, hi}; bf16x2_t b = __builtin_convertvector(v, bf16x2_t); return __builtin_bit_cast(unsigned, b); }
__device__ __forceinline__ unsigned short bf1(float x) { return (unsigned short)(pkf(x, 0.f) & 0xffffu); }
__device__ __forceinline__ void unpack8(const v4u w, float* f) { f[0] = bflo(w.x); f[1] = bfhi(w.x); f[2] = bflo(w.y); f[3] = bfhi(w.y); f[4] = bflo(w.z); f[5] = bfhi(w.z); f[6] = bflo(w.w); f[7] = bfhi(w.w); }
__device__ __forceinline__ v4u pack8(const float* f) { v4u w; w.x = pkf(f[0], f[1]); w.y = pkf(f[2], f[3]); w.z = pkf(f[4], f[5]); w.w = pkf(f[6], f[7]); return w; }
__device__ __forceinline__ int crow(int r, int hi) { return (r & 3) + 8 * (r >> 2) + 4 * hi; }
__device__ __forceinline__ bf16x8 frag_row(LAS const unsigned char* T, int stride, int r0, int k0, int lane) {
    return *(const LAS bf16x8*)(T + (r0 + (lane & 31)) * stride + (k0 + 8 * (lane >> 5)) * 2);
}
__device__ __forceinline__ bf16x8 frag_tr(LAS const unsigned char* T, int stride, int k0, int c0, int lane) {
    const int h = lane >> 5, blk = (lane >> 4) & 1, q = (lane & 15) >> 2, p = lane & 3;
    LAS unsigned char* a = (LAS unsigned char*)T + (k0 + 8 * h + q) * stride + (c0 + 16 * blk + 4 * p) * 2;
    const s16x4 lo = __builtin_amdgcn_ds_read_tr16_b64_v4i16((LAS s16x4*)a), hi = __builtin_amdgcn_ds_read_tr16_b64_v4i16((LAS s16x4*)(a + 4 * stride));
    return (bf16x8){lo[0], lo[1], lo[2], lo[3], hi[0], hi[1], hi[2], hi[3]};
}
__device__ __forceinline__ f32x16 zero16() { f32x16 z; for (int i = 0; i < 16; ++i) z[i] = 0.f; return z; }

__device__ __forceinline__ void st_acc4(GAS bf16* base, const f32x16& a) {
#pragma unroll
    for (int g = 0; g < 4; ++g) { v2u w; w.x = pkf(a[4 * g], a[4 * g + 1]); w.y = pkf(a[4 * g + 2], a[4 * g + 3]); *(GAS v2u*)(base + 8 * g) = w; }
}

__device__ __forceinline__ void pre_ret_unit(Frame& F, int u) {
    const int c = u & 15, h = (u >> 4) & 3, b = u >> 6;
    const int tid = F.tid, lane = F.lane, w = F.wave;
    LAS unsigned char* Qs = F.lds + RING_OFF; LAS unsigned char* Ks = Qs + 34816; LAS unsigned char* Vs = Ks + 34816;
    const size_t row0 = (size_t)b * SEQ + c * 128;
    const float gam = 1.0f - exp2f(-5.0f - (float)h), l2g = log2f(gam);
    {
        const int i = tid >> 2, s = tid & 3; const size_t row = row0 + i;
        const GAS bf16* pr = WSB(WS_PROJ) + row * NPROJ;
        const GAS float* cs = WSF(WS_COS) + row * 64 + 16 * s; const GAS float* sn = WSF(WS_SIN) + row * 64 + 16 * s;
        float cv[16], sv[16];
#pragma unroll
        for (int e = 0; e < 4; ++e) { const f32x4 a = *(const GAS f32x4*)(cs + 4 * e), d = *(const GAS f32x4*)(sn + 4 * e);
            cv[4 * e] = a.x; cv[4 * e + 1] = a.y; cv[4 * e + 2] = a.z; cv[4 * e + 3] = a.w; sv[4 * e] = d.x; sv[4 * e + 1] = d.y; sv[4 * e + 2] = d.z; sv[4 * e + 3] = d.w; }
#pragma unroll
        for (int t = 0; t < 2; ++t) {
            const GAS bf16* src = pr + (t ? C_RK : C_RQ) + h * 128 + 16 * s;
            float x1[16], x2[16], o1[16], o2[16];
            unpack8(*(const GAS v4u*)(src), x1); unpack8(*(const GAS v4u*)(src + 8), x1 + 8); unpack8(*(const GAS v4u*)(src + 64), x2); unpack8(*(const GAS v4u*)(src + 72), x2 + 8);
            const float sc = t ? 0.08838834764831845f : 1.0f;
#pragma unroll
            for (int e = 0; e < 16; ++e) { o1[e] = (x1[e] * cv[e] - x2[e] * sv[e]) * sc; o2[e] = (x1[e] * sv[e] + x2[e] * cv[e]) * sc; }
            LAS unsigned char* dst = (t ? Ks : Qs) + i * TS + 32 * s;
            const v4u a0 = pack8(o1), a1 = pack8(o1 + 8), b0 = pack8(o2), b1 = pack8(o2 + 8);
            *(LAS v4u*)(dst) = a0; *(LAS v4u*)(dst + 16) = a1; *(LAS v4u*)(dst + 128) = b0; *(LAS v4u*)(dst + 144) = b1;
            if (t == 0) { GAS bf16* qd = WSB(WS_QI) + row * QIW + h * 128 + 16 * s; *(GAS v4u*)(qd) = a0; *(GAS v4u*)(qd + 8) = a1; *(GAS v4u*)(qd + 64) = b0; *(GAS v4u*)(qd + 72) = b1; }
        }
        const GAS bf16* vsrc = pr + C_RV + h * 128 + 32 * s; LAS unsigned char* vd = Vs + i * TS + 64 * s;
#pragma unroll
        for (int e = 0; e < 4; ++e) *(LAS v4u*)(vd + 16 * e) = *(const GAS v4u*)(vsrc + 8 * e);
    }
    __syncthreads();
    const int rb = w >> 1, cb0 = (w & 1) * 2;
    f32x16 acc0 = zero16(), acc1 = zero16();
    if (cb0 <= rb) {
#pragma unroll
        for (int kk = 0; kk < 8; ++kk) { const bf16x8 a = frag_row(Qs, TS, rb * 32, 16 * kk, lane);
            acc0 = MFMA32(a, frag_row(Ks, TS, cb0 * 32, 16 * kk, lane), acc0);
            if (cb0 + 1 <= rb) acc1 = MFMA32(a, frag_row(Ks, TS, cb0 * 32 + 32, 16 * kk, lane), acc1); }
    }
    __syncthreads();
#pragma unroll
    for (int t = 0; t < 2; ++t) { const int cb = cb0 + t, j = cb * 32 + (lane & 31);
#pragma unroll
        for (int r = 0; r < 16; ++r) { const int i = rb * 32 + crow(r, lane >> 5); const float a = t ? acc1[r] : acc0[r];
            const float v = (cb <= rb && i >= j) ? a * exp2f((float)(i - j) * l2g) : 0.f;
            *(LAS unsigned short*)(Qs + i * TS + 2 * j) = bf1(v); } }
    {
        const int i = tid >> 2, s = tid & 3; const float f = exp2f((float)(127 - i) * l2g); LAS unsigned char* kp = Ks + i * TS + 64 * s;
#pragma unroll
        for (int e = 0; e < 4; ++e) { float x[8]; unpack8(*(LAS v4u*)(kp + 16 * e), x);
#pragma unroll
            for (int q = 0; q < 8; ++q) x[q] *= f;
            *(LAS v4u*)(kp + 16 * e) = pack8(x); }
    }
    __syncthreads();
    {
        const int pb0 = (w & 1) * 2; acc0 = zero16(); acc1 = zero16();
        for (int kk = 0; kk < 2 * (rb + 1); ++kk) { const bf16x8 a = frag_row(Qs, TS, rb * 32, 16 * kk, lane);
            acc0 = MFMA32(frag_tr(Vs, TS, 16 * kk, pb0 * 32, lane), a, acc0); acc1 = MFMA32(frag_tr(Vs, TS, 16 * kk, pb0 * 32 + 32, lane), a, acc1); }
        GAS bf16* yb = WSB(WS_Y) + (row0 + rb * 32 + (lane & 31)) * 2048 + h * 128 + pb0 * 32 + 4 * (lane >> 5);
        st_acc4(yb, acc0); st_acc4(yb + 32, acc1);
    }
    {
        const int pb = w >> 1, nb0 = (w & 1) * 2; acc0 = zero16(); acc1 = zero16();
#pragma unroll
        for (int kk = 0; kk < 8; ++kk) { const bf16x8 a = frag_tr(Vs, TS, 16 * kk, pb * 32, lane);
            acc0 = MFMA32(frag_tr(Ks, TS, 16 * kk, nb0 * 32, lane), a, acc0); acc1 = MFMA32(frag_tr(Ks, TS, 16 * kk, nb0 * 32 + 32, lane), a, acc1); }
        GAS bf16* sb = WSB(WS_SLR) + (size_t)u * 16384 + (pb * 32 + (lane & 31)) * 128 + nb0 * 32 + 4 * (lane >> 5);
        st_acc4(sb, acc0); st_acc4(sb + 32, acc1);
    }
    __syncthreads();
}

__device__ __forceinline__ void pre_hg_unit(Frame& F, int l, int u) {
    const int c = u & 31, h = (u >> 5) & 3, b = u >> 7;
    const int tid = F.tid, lane = F.lane, w = F.wave;
    LAS float* CUM = (LAS float*)(F.lds + RING_OFF);
    LAS unsigned char* Qm = F.lds + RING_OFF + 33792; LAS unsigned char* Km = Qm + 17408; LAS unsigned char* Kes = Km + 17408; LAS unsigned char* Vs = Kes + 17408;
    LAS unsigned char* Ps = Vs + 17408;
    LAS float* PT = (LAS float*)(Ps + 9216);
    const size_t row0 = (size_t)b * SEQ + c * 64;
    const int j = tid >> 3, s = tid & 7, d0 = 16 * s; const size_t row = row0 + j;
    const GAS bf16* pr = WSB(WS_PROJ) + row * NPROJ;
    float q[16], k[16];
    {
        float fr[16], lb[16];
        unpack8(*(const GAS v4u*)(pr + C_HQ + h * 128 + d0), q); unpack8(*(const GAS v4u*)(pr + C_HQ + h * 128 + d0 + 8), q + 8);
        unpack8(*(const GAS v4u*)(pr + C_HF + h * 128 + d0), fr); unpack8(*(const GAS v4u*)(pr + C_HF + h * 128 + d0 + 8), fr + 8);
        const GAS float* lbp = WSF(WS_LBS) + l * 512 + h * 128 + d0;
#pragma unroll
        for (int e = 0; e < 4; ++e) { const f32x4 a = *(const GAS f32x4*)(lbp + 4 * e); lb[4 * e] = a.x; lb[4 * e + 1] = a.y; lb[4 * e + 2] = a.z; lb[4 * e + 3] = a.w; }
        float lf[16];
#pragma unroll
        for (int e = 0; e < 16; ++e) { const float sg = sigmoidf_(fr[e]); const float f = lb[e] + (1.f - lb[e]) * sg; k[e] = (1.f - lb[e]) * (1.f - sg); lf[e] = __logf(f); }
#pragma unroll
        for (int e = 0; e < 4; ++e) *(LAS f32x4*)(CUM + j * 132 + d0 + 4 * e) = (f32x4){lf[4 * e], lf[4 * e + 1], lf[4 * e + 2], lf[4 * e + 3]};
        const GAS bf16* vsrc = pr + C_HI + h * 128 + d0; *(LAS v4u*)(Vs + j * TS + 2 * d0) = *(const GAS v4u*)(vsrc); *(LAS v4u*)(Vs + j * TS + 2 * d0 + 16) = *(const GAS v4u*)(vsrc + 8);
    }
    __syncthreads();
    {
        const int d = tid & 127, qd = tid >> 7; float loc[16], run = 0.f;
#pragma unroll
        for (int jj = 0; jj < 16; ++jj) { run += CUM[(16 * qd + jj) * 132 + d]; loc[jj] = run; }
        PT[qd * 128 + d] = run;
        __syncthreads();
        float off = 0.f;
#pragma unroll
        for (int qq = 0; qq < 3; ++qq) off += (qq < qd) ? PT[qq * 128 + d] : 0.f;
#pragma unroll
        for (int jj = 0; jj < 16; ++jj) CUM[(16 * qd + jj) * 132 + d] = loc[jj] + off;
    }
    __syncthreads();
    {
        float cum[16], mid[16], tot[16];
#pragma unroll
        for (int e = 0; e < 4; ++e) { const f32x4 a = *(const LAS f32x4*)(CUM + j * 132 + d0 + 4 * e), m4 = *(const LAS f32x4*)(CUM + 31 * 132 + d0 + 4 * e), t4 = *(const LAS f32x4*)(CUM + 63 * 132 + d0 + 4 * e);
            cum[4 * e] = a.x; cum[4 * e + 1] = a.y; cum[4 * e + 2] = a.z; cum[4 * e + 3] = a.w; mid[4 * e] = m4.x; mid[4 * e + 1] = m4.y; mid[4 * e + 2] = m4.z; mid[4 * e + 3] = m4.w;
            tot[4 * e] = t4.x; tot[4 * e + 1] = t4.y; tot[4 * e + 2] = t4.z; tot[4 * e + 3] = t4.w; }
        float qm[16], km[16], q2[16], ke[16];
#pragma unroll
        for (int e = 0; e < 16; ++e) { qm[e] = q[e] * __expf(fminf(cum[e] - mid[e], 80.f)); km[e] = k[e] * __expf(fminf(mid[e] - cum[e], 80.f)); q2[e] = q[e] * __expf(cum[e]); ke[e] = k[e] * __expf(tot[e] - cum[e]); }
        *(LAS v4u*)(Qm + j * TS + 2 * d0) = pack8(qm); *(LAS v4u*)(Qm + j * TS + 2 * d0 + 16) = pack8(qm + 8);
        *(LAS v4u*)(Km + j * TS + 2 * d0) = pack8(km); *(LAS v4u*)(Km + j * TS + 2 * d0 + 16) = pack8(km + 8);
        *(LAS v4u*)(Kes + j * TS + 2 * d0) = pack8(ke); *(LAS v4u*)(Kes + j * TS + 2 * d0 + 16) = pack8(ke + 8);
        GAS bf16* qd = WSB(WS_QI) + row * QIW + 512 + h * 128 + d0; *(GAS v4u*)(qd) = pack8(q2); *(GAS v4u*)(qd + 8) = pack8(q2 + 8);
        if (j == 0) { GAS float* dp = WSF(WS_DECH) + (size_t)u * 128 + d0;
#pragma unroll
            for (int e = 0; e < 4; ++e) *(GAS f32x4*)(dp + 4 * e) = (f32x4){__expf(tot[4 * e]), __expf(tot[4 * e + 1]), __expf(tot[4 * e + 2]), __expf(tot[4 * e + 3])}; }
    }
    __syncthreads();
    if (w < 4) {
        const int rb = w >> 1, cb = w & 1; f32x16 acc = zero16();
        if (cb <= rb) {
#pragma unroll
            for (int kk = 0; kk < 8; ++kk) acc = MFMA32(frag_row(Qm, TS, rb * 32, 16 * kk, lane), frag_row(Km, TS, cb * 32, 16 * kk, lane), acc);
        }
        const int jj = cb * 32 + (lane & 31);
#pragma unroll
        for (int r = 0; r < 16; ++r) { const int i = rb * 32 + crow(r, lane >> 5); *(LAS unsigned short*)(Ps + i * 144 + 2 * jj) = bf1((cb <= rb && i >= jj) ? acc[r] : 0.f); }
    }
    {
        const int vb = w >> 1, db0 = (w & 1) * 2; f32x16 acc0 = zero16(), acc1 = zero16();
#pragma unroll
        for (int kk = 0; kk < 4; ++kk) { const bf16x8 a = frag_tr(Vs, TS, 16 * kk, vb * 32, lane);
            acc0 = MFMA32(frag_tr(Kes, TS, 16 * kk, db0 * 32, lane), a, acc0); acc1 = MFMA32(frag_tr(Kes, TS, 16 * kk, db0 * 32 + 32, lane), a, acc1); }
        GAS bf16* sb = WSB(WS_SLH) + (size_t)u * 16384 + (vb * 32 + (lane & 31)) * 128 + db0 * 32 + 4 * (lane >> 5);
        st_acc4(sb, acc0); st_acc4(sb + 32, acc1);
    }
    __syncthreads();
    {
        const int rb = w >> 2, vb = w & 3; f32x16 acc = zero16();
        for (int kk = 0; kk < 2 * (rb + 1); ++kk) acc = MFMA32(frag_tr(Vs, TS, 16 * kk, vb * 32, lane), frag_row(Ps, 144, rb * 32, 16 * kk, lane), acc);
        st_acc4(WSB(WS_Y) + (row0 + rb * 32 + (lane & 31)) * 2048 + 512 + h * 128 + vb * 32 + 4 * (lane >> 5), acc);
    }
    __syncthreads();
}

__device__ __forceinline__ float softplus2_(float x) { return fmaxf(x, 0.f) + log1pf(__expf(-fabsf(x))); }
__device__ __forceinline__ void pre_mamba_unit(Frame& F, int l, int u) {
    const int half = u & 1, c = (u >> 1) & 15, g = (u >> 5) & 1, b = u >> 6, head0 = g * 8 + half * 4;
    const int tid = F.tid, lane = F.lane, w = F.wave;
    LAS unsigned char* Cs = F.lds + RING_OFF; LAS unsigned char* Bs = Cs + 34816; LAS unsigned char* Xs = Bs + 34816;
    LAS float* dtS = (LAS float*)(Xs + 67584); LAS float* cumS = dtS + 512; LAS float* wS = cumS + 512; LAS float* tot0 = wS + 512;
    const size_t row0 = (size_t)b * SEQ + c * 128;
    const int v4 = tid & 127, tg = tid >> 7;
    const int cch = (v4 < 32) ? 1024 + g * 128 + 4 * v4 : (v4 < 64) ? 1280 + g * 128 + 4 * (v4 - 32) : head0 * 64 + 4 * (v4 - 64);
    const GAS float* cw = INF(I_CONVW) + (size_t)l * 4 * MCONV + cch;
    const f32x4 w0 = *(const GAS f32x4*)(cw), w1 = *(const GAS f32x4*)(cw + MCONV), w2 = *(const GAS f32x4*)(cw + 2 * MCONV), w3 = *(const GAS f32x4*)(cw + 3 * MCONV), bias = *(const GAS f32x4*)(INF(I_CONVB) + (size_t)l * MCONV + cch);
    const GAS bf16* srcu = WSB(WS_PROJ) + ((ptrdiff_t)row0 - 3) * NPROJ + C_MX;
    const unsigned off0 = (unsigned)(tg * 32) * NPROJ + (unsigned)cch;
    const int tq0 = c * 128 + tg * 32;
    v2u raw[19];
#pragma unroll
    for (int q = 0; q < 3; ++q) raw[q] = (tq0 >= 3) ? *(const GAS v2u*)(srcu + (off0 + (unsigned)q * NPROJ)) : (v2u){0u, 0u};
#pragma unroll
    for (int tt = 0; tt < 16; ++tt) raw[3 + tt] = *(const GAS v2u*)(srcu + (off0 + (unsigned)(3 + tt) * NPROJ));
    float dskv[4];
#pragma unroll
    for (int hl = 0; hl < 4; ++hl) dskv[hl] = INF(I_MD)[l * 16 + head0 + hl];
    {
        const int hl = tid >> 7, j = tid & 127, head = head0 + hl;
        const float dt = softplus2_(WSF(WS_DTRAW)[(row0 + j) * 16 + head] + INF(I_DTB)[l * 16 + head]);
        float v = -__expf(INF(I_ALOG)[l * 16 + head]) * dt;
#pragma unroll
        for (int o = 1; o < 64; o <<= 1) { const float t = __shfl_up(v, o); if (lane >= o) v += t; }
        dtS[hl * 128 + j] = dt;
        if ((w & 1) == 0 && lane == 63) tot0[hl] = v;
        __syncthreads();
        if (w & 1) v += tot0[hl];
        cumS[hl * 128 + j] = v;
        __syncthreads();
        const float last = cumS[hl * 128 + 127];
        wS[hl * 128 + j] = __expf(last - v) * dt;
        WSF(WS_RS)[((size_t)b * 16 + head) * SEQ + c * 128 + j] = __expf(v);
        if (j == 127) WSF(WS_CD)[((size_t)b * 16 + head) * 16 + c] = __expf(v);
    }
    {
        GAS bf16* qiu = WSB(WS_QI) + row0 * QIW + 1024 + g * 128; const unsigned qoff0 = (unsigned)(tg * 32) * QIW + (unsigned)(4 * ((v4 - 32) & 31));
        LAS unsigned char* dst = (v4 < 32) ? Bs + 8 * v4 : (v4 < 64) ? Cs + 8 * (v4 - 32) : Xs + 8 * (v4 - 64);
        const int dstride = (v4 < 64) ? TS : XS;
        f32x4 x3 = (f32x4){bflo(raw[0].x), bfhi(raw[0].x), bflo(raw[0].y), bfhi(raw[0].y)}, x2 = (f32x4){bflo(raw[1].x), bfhi(raw[1].x), bflo(raw[1].y), bfhi(raw[1].y)}, x1 = (f32x4){bflo(raw[2].x), bfhi(raw[2].x), bflo(raw[2].y), bfhi(raw[2].y)};
#pragma unroll 1
        for (int hf = 0; hf < 2; ++hf) {
            if (hf == 1) {
#pragma unroll
                for (int tt = 0; tt < 16; ++tt) raw[3 + tt] = *(const GAS v2u*)(srcu + (off0 + (unsigned)(19 + tt) * NPROJ)); }
#pragma unroll
            for (int tt = 0; tt < 16; ++tt) { const int jj = tg * 32 + hf * 16 + tt;
                const f32x4 x0 = (f32x4){bflo(raw[3 + tt].x), bfhi(raw[3 + tt].x), bflo(raw[3 + tt].y), bfhi(raw[3 + tt].y)};
                const f32x4 a = bias + w0 * x3 + w1 * x2 + w2 * x1 + w3 * x0;
                v2u pk; pk.x = pkf(siluf_(a.x), siluf_(a.y)); pk.y = pkf(siluf_(a.z), siluf_(a.w));
                x3 = x2; x2 = x1; x1 = x0;
                *(LAS v2u*)(dst + jj * dstride) = pk;
                if (half == 0 && v4 >= 32 && v4 < 64) *(GAS v2u*)(qiu + (qoff0 + (unsigned)(hf * 16 + tt) * QIW)) = pk; }
        }
    }
    __syncthreads();
    const int rb = w >> 1, cb0 = (w & 1) * 2;
    f32x16 cbA = zero16(), cbB = zero16();
    if (cb0 <= rb) {
#pragma unroll
        for (int kk = 0; kk < 8; ++kk) { const bf16x8 a = frag_row(Cs, TS, rb * 32, 16 * kk, lane);
            cbA = MFMA32(a, frag_row(Bs, TS, cb0 * 32, 16 * kk, lane), cbA);
            if (cb0 + 1 <= rb) cbB = MFMA32(a, frag_row(Bs, TS, cb0 * 32 + 32, 16 * kk, lane), cbB); }
    }
    __syncthreads();
    for (int hl = 0; hl < 4; ++hl) {
        const int head = head0 + hl; const float dsk = (hl == 0) ? dskv[0] : (hl == 1) ? dskv[1] : (hl == 2) ? dskv[2] : dskv[3];
#pragma unroll
        for (int t = 0; t < 2; ++t) { const int cb = cb0 + t, j = cb * 32 + (lane & 31); const float cj = cumS[hl * 128 + j], dj = dtS[hl * 128 + j];
#pragma unroll
            for (int r = 0; r < 16; ++r) { const int i = rb * 32 + crow(r, lane >> 5); const float a = t ? cbB[r] : cbA[r];
                float v = (cb <= rb && i >= j) ? a * __expf(cumS[hl * 128 + i] - cj) * dj : 0.f; if (i == j) v += dsk;
                *(LAS unsigned short*)(Cs + i * TS + 2 * j) = bf1(v); } }
        __syncthreads();
        {
            const int pb = w & 1; f32x16 acc = zero16();
            for (int kk = 0; kk < 2 * (rb + 1); ++kk) acc = MFMA32(frag_tr(Xs, XS, 16 * kk, hl * 64 + pb * 32, lane), frag_row(Cs, TS, rb * 32, 16 * kk, lane), acc);
            st_acc4(WSB(WS_Y) + (row0 + rb * 32 + (lane & 31)) * 2048 + 1024 + head * 64 + pb * 32 + 4 * (lane >> 5), acc);
        }
        {
            const int pb = w >> 2, nb = w & 3; f32x16 acc = zero16();
#pragma unroll
            for (int kk = 0; kk < 8; ++kk) { const bf16x8 a = frag_tr(Xs, XS, 16 * kk, hl * 64 + pb * 32, lane);
                const LAS float* wp = wS + hl * 128 + 16 * kk + 8 * (lane >> 5); const f32x4 w0 = *(const LAS f32x4*)wp, w1 = *(const LAS f32x4*)(wp + 4);
                float x[8]; const v4u aw = __builtin_bit_cast(v4u, a); unpack8(aw, x);
                x[0] *= w0.x; x[1] *= w0.y; x[2] *= w0.z; x[3] *= w0.w; x[4] *= w1.x; x[5] *= w1.y; x[6] *= w1.z; x[7] *= w1.w;
                const v4u sw = pack8(x);
                acc = MFMA32(frag_tr(Bs, TS, 16 * kk, nb * 32, lane), __builtin_bit_cast(bf16x8, sw), acc); }
            st_acc4(WSB(WS_SLM) + (((size_t)b * 16 + head) * 16 + c) * 8192 + (pb * 32 + (lane & 31)) * 128 + nb * 32 + 4 * (lane >> 5), acc);
        }
        __syncthreads();
    }
}
__device__ __forceinline__ void mixer_pre(Frame& F, int l, int flags) {
    if (flags == 0 || (flags & 1)) for (int u = blockIdx.x; u < 256; u += F.G) pre_mamba_unit(F, l, u);
    if (flags == 0 || (flags & 2)) for (int u = blockIdx.x; u < 256; u += F.G) pre_ret_unit(F, u);
    if (flags == 0 || (flags & 4)) for (int u = blockIdx.x; u < 512; u += F.G) pre_hg_unit(F, l, u);
}

template <int MODE> __device__ __forceinline__ void lp_load(const GAS bf16* qb, const GAS bf16* yb, const GAS float* rsb, size_t rowb, int lane, bf16x8 (&A)[8], v2u (&yv)[4], float& rs) {
    const GAS bf16* qp = qb + (rowb + (lane & 31)) * QIW;
#pragma unroll
    for (int kk = 0; kk < 8; ++kk) A[kk] = *(const GAS bf16x8*)(qp + 16 * kk);
    const GAS bf16* yp = yb + (rowb + (lane & 31)) * 2048;
#pragma unroll
    for (int g = 0; g < 4; ++g) yv[g] = *(const GAS v2u*)(yp + 8 * g);
    if (MODE == 2) rs = rsb[rowb + (lane & 31)];
}
template <int MODE> __device__ __forceinline__ void loop_unit(Frame& F, int uu) {
    constexpr int NC = (MODE == 1) ? 32 : 16, CL = (MODE == 1) ? 64 : 128, PW = (MODE == 2) ? 64 : 128, RB = CL / 32, NT = 2 * RB;
    const int tid = F.tid, lane = F.lane, w = F.wave;
    int ps, hd, b;
    if (MODE == 2) { ps = uu & 1; hd = (uu >> 1) & 15; b = uu >> 5; } else { ps = uu & 3; hd = (uu >> 2) & 3; b = uu >> 4; }
    const int bh = (MODE == 2) ? b * 16 + hd : b * 4 + hd, p0 = ps * 32;
    const GAS bf16* SL = (MODE == 0) ? WSB(WS_SLR) : (MODE == 1) ? WSB(WS_SLH) : WSB(WS_SLM);
    const int qcol = (MODE == 0) ? hd * 128 : (MODE == 1) ? 512 + hd * 128 : 1024 + (hd >> 3) * 128;
    const int ycol = (MODE == 0) ? hd * 128 + p0 : (MODE == 1) ? 512 + hd * 128 + p0 : 1024 + hd * 64 + p0;
    const float gam = 1.0f - exp2f(-5.0f - (float)hd), l2g = log2f(gam), g128 = exp2f(128.f * l2g);
    LAS unsigned char* SP = F.lds + RING_OFF;
    const int p = tid >> 4, n8 = tid & 15;
    const GAS bf16* qb = WSB(WS_QI) + qcol + 8 * (lane >> 5);
    const GAS bf16* yb = WSB(WS_Y) + ycol + 4 * (lane >> 5);
    const GAS float* rsb = WSF(WS_RS) + (size_t)bh * SEQ - (size_t)b * SEQ;
    float S[8];
#pragma unroll
    for (int e = 0; e < 8; ++e) S[e] = 0.f;
    for (int pass = 0; pass < NC / 16; ++pass) {
#pragma unroll
        for (int hf = 0; hf < 2; ++hf) {
            v4u lw[8]; f32x4 dv[8][2]; float dsc[8];
#pragma unroll
            for (int cl = 0; cl < 8; ++cl) { const int c = pass * 16 + hf * 8 + cl;
                lw[cl] = *(const GAS v4u*)(SL + ((size_t)(bh * NC + c) * PW + p0 + p) * 128 + 8 * n8);
                if (MODE == 1) { const GAS float* dp = WSF(WS_DECH) + (size_t)(bh * NC + c) * 128 + 8 * n8; dv[cl][0] = *(const GAS f32x4*)dp; dv[cl][1] = *(const GAS f32x4*)(dp + 4); }
                if (MODE == 2) dsc[cl] = WSF(WS_CD)[bh * 16 + c]; }
#pragma unroll
            for (int cl = 0; cl < 8; ++cl) {
                *(LAS v4u*)(SP + (hf * 8 + cl) * 8704 + p * TS + 16 * n8) = pack8(S);
                float loc[8]; unpack8(lw[cl], loc);
                if (MODE == 1) { S[0] = S[0] * dv[cl][0].x + loc[0]; S[1] = S[1] * dv[cl][0].y + loc[1]; S[2] = S[2] * dv[cl][0].z + loc[2]; S[3] = S[3] * dv[cl][0].w + loc[3];
                    S[4] = S[4] * dv[cl][1].x + loc[4]; S[5] = S[5] * dv[cl][1].y + loc[5]; S[6] = S[6] * dv[cl][1].z + loc[6]; S[7] = S[7] * dv[cl][1].w + loc[7]; }
                else { const float dec = (MODE == 0) ? g128 : dsc[cl];
#pragma unroll
                    for (int e = 0; e < 8; ++e) S[e] = S[e] * dec + loc[e]; } }
            asm volatile("" ::: "memory");
        }
        __syncthreads();
        {
            bf16x8 A0[8], A1[8], Bf[8]; v2u y0[4], y1[4]; float r0 = 1.f, r1 = 1.f;
            lp_load<MODE>(qb, yb, rsb, (size_t)b * SEQ + (size_t)(pass * 16 + w) * CL, lane, A0, y0, r0);
#pragma unroll
            for (int t = 0; t < NT; ++t) {
                const int cl = w + 8 * (t / RB), rb = t % RB, c = pass * 16 + cl;
                const size_t rowb = (size_t)b * SEQ + (size_t)c * CL + rb * 32;
                if (t + 1 < NT) { const int cl2 = w + 8 * ((t + 1) / RB), rb2 = (t + 1) % RB; const size_t rowb2 = (size_t)b * SEQ + (size_t)(pass * 16 + cl2) * CL + rb2 * 32;
                    if (t & 1) lp_load<MODE>(qb, yb, rsb, rowb2, lane, A0, y0, r0); else lp_load<MODE>(qb, yb, rsb, rowb2, lane, A1, y1, r1); }
                asm volatile("" ::: "memory");
                if (rb == 0) {
#pragma unroll
                    for (int kk = 0; kk < 8; ++kk) Bf[kk] = frag_row(SP + cl * 8704, TS, 0, 16 * kk, lane); }
                f32x16 acc = zero16();
#pragma unroll
                for (int kk = 0; kk < 8; ++kk) acc = MFMA32(Bf[kk], (t & 1) ? A1[kk] : A0[kk], acc);
                float sc = 1.f;
                if (MODE == 0) sc = exp2f((float)(rb * 32 + (lane & 31) + 1) * l2g);
                if (MODE == 2) sc = (t & 1) ? r1 : r0;
                GAS bf16* yp = WSB(WS_Y) + (rowb + (lane & 31)) * 2048 + ycol + 4 * (lane >> 5);
#pragma unroll
                for (int g = 0; g < 4; ++g) { const v2u yy = (t & 1) ? y1[g] : y0[g]; v2u o;
                    o.x = pkf(bflo(yy.x) + sc * acc[4 * g], bfhi(yy.x) + sc * acc[4 * g + 1]); o.y = pkf(bflo(yy.y) + sc * acc[4 * g + 2], bfhi(yy.y) + sc * acc[4 * g + 3]);
                    *(GAS v2u*)(yp + 8 * g) = o; }
                asm volatile("" ::: "memory");
            }
        }
        __syncthreads();
    }
}
__device__ __forceinline__ void mixer_loop(Frame& F) {
    for (int u = blockIdx.x; u < 256; u += F.G) {
        if (u < 64) loop_unit<0>(F, u);
        else if (u < 128) loop_unit<1>(F, u - 64);
        else loop_unit<2>(F, u - 128);
    }
}
__device__ __forceinline__ float softplusf_(float x) { return fmaxf(x, 0.f) + log1pf(__expf(-fabsf(x))); }
__device__ __forceinline__ void npre_rows(Frame& F, int l) {
    const int gw = F.vcu * NWAVES + F.wave, NGW = F.G * NWAVES, lane = F.lane;
    for (int row = gw; row < M; row += NGW) {
        const int t = row & (SEQ - 1);
        const GAS bf16* pr = WSB(WS_PROJ) + (size_t)row * NPROJ;
        GAS float* nq = WSF(WS_NQ) + (size_t)row * 1280; GAS float* nk = WSF(WS_NK) + (size_t)row * 1280; GAS float* nv = WSF(WS_NV) + (size_t)row * 2048;
        const float cs = WSF(WS_COS)[(size_t)row * 64 + lane], sn = WSF(WS_SIN)[(size_t)row * 64 + lane];
#pragma unroll
        for (int h = 0; h < 4; ++h) {
            const float q1 = bf2f(pr[C_RQ + h * 128 + lane]), q2 = bf2f(pr[C_RQ + h * 128 + 64 + lane]);
            const float k1 = bf2f(pr[C_RK + h * 128 + lane]) * 0.08838834764831845f, k2 = bf2f(pr[C_RK + h * 128 + 64 + lane]) * 0.08838834764831845f;
            nq[h * 128 + lane] = q1 * cs - q2 * sn; nq[h * 128 + 64 + lane] = q1 * sn + q2 * cs;
            nk[h * 128 + lane] = k1 * cs - k2 * sn; nk[h * 128 + 64 + lane] = k1 * sn + k2 * cs;
        }
#pragma unroll
        for (int j = 0; j < 8; ++j) { const int c = lane + 64 * j; nv[c] = bf2f(pr[C_RV + c]);
            const float lb = WSF(WS_LBS)[l * 512 + c], sg = sigmoidf_(bf2f(pr[C_HF + c])), f = lb + (1.f - lb) * sg;
            WSF(WS_NF)[(size_t)row * 512 + c] = f; nk[512 + c] = (1.f - lb) * (1.f - sg); nq[512 + c] = bf2f(pr[C_HQ + c]); nv[512 + c] = bf2f(pr[C_HI + c]); }
        for (int j = 0; j < 24; ++j) { const int ch = lane + 64 * j; float acc = INF(I_CONVB)[l * MCONV + ch];
#pragma unroll
            for (int k = 0; k < 4; ++k) { const int tt = t - 3 + k; if (tt >= 0) acc += INF(I_CONVW)[(l * 4 + k) * MCONV + ch] * bf2f(WSB(WS_PROJ)[(size_t)(row - 3 + k) * NPROJ + C_MX + ch]); }
            const float a = siluf_(acc);
            if (ch < 1024) nv[1024 + ch] = a; else if (ch < 1280) nk[1024 + ch - 1024] = a; else nq[1024 + ch - 1280] = a; }
        if (lane < 16) { const float dt = softplusf_(WSF(WS_DTRAW)[(size_t)row * 16 + lane] + INF(I_DTB)[l * 16 + lane]);
            WSF(WS_NDT)[(size_t)row * 16 + lane] = dt; WSF(WS_NDA)[(size_t)row * 16 + lane] = __expf(-__expf(INF(I_ALOG)[l * 16 + lane]) * dt); }
    }
}
template <int MODE> __device__ __forceinline__ void nscan(Frame& F, int l, int b, int hd, int half) {
    const int lane = F.lane;
    LAS float* kS = (LAS float*)(F.lds + RING_OFF + F.wave * 12288); LAS float* qS = kS + 1024; LAS float* fS = kS + 2048;
    const int kb = (MODE == 0) ? hd * 128 : (MODE == 1) ? 512 + hd * 128 : 1024 + (hd >> 3) * 128;
    const int vc = (MODE == 0) ? hd * 128 + half * 64 + lane : (MODE == 1) ? 512 + hd * 128 + half * 64 + lane : 1024 + hd * 64 + lane;
    const float gamma = 1.0f - exp2f(-5.0f - (float)hd);
    const float dsk = (MODE == 2) ? INF(I_MD)[l * 16 + hd] : 0.f;
    float S[128];
#pragma unroll
    for (int n = 0; n < 128; ++n) S[n] = 0.f;
    for (int t0 = 0; t0 < SEQ; t0 += 8) {
        const size_t row0 = (size_t)b * SEQ + t0;
#pragma unroll
        for (int tt = 0; tt < 8; ++tt) {
            *(LAS f32x2*)(kS + tt * 128 + 2 * lane) = *(const GAS f32x2*)(WSF(WS_NK) + (row0 + tt) * 1280 + kb + 2 * lane);
            *(LAS f32x2*)(qS + tt * 128 + 2 * lane) = *(const GAS f32x2*)(WSF(WS_NQ) + (row0 + tt) * 1280 + kb + 2 * lane);
            if (MODE == 1) *(LAS f32x2*)(fS + tt * 128 + 2 * lane) = *(const GAS f32x2*)(WSF(WS_NF) + (row0 + tt) * 512 + hd * 128 + 2 * lane);
        }
        LDS_WAIT(); asm volatile("" ::: "memory");
        for (int tt = 0; tt < 8; ++tt) {
            const size_t row = row0 + tt;
            const float v = WSF(WS_NV)[row * 2048 + vc];
            float dec = gamma, vv = v;
            if (MODE == 2) { dec = WSF(WS_NDA)[row * 16 + hd]; vv = v * WSF(WS_NDT)[row * 16 + hd]; }
            float o = 0.f;
#pragma unroll
            for (int n4 = 0; n4 < 32; ++n4) {
                const f32x4 k4 = *(const LAS f32x4*)(kS + tt * 128 + 4 * n4), q4 = *(const LAS f32x4*)(qS + tt * 128 + 4 * n4);
                f32x4 f4 = (f32x4){dec, dec, dec, dec};
                if (MODE == 1) f4 = *(const LAS f32x4*)(fS + tt * 128 + 4 * n4);
#pragma unroll
                for (int i = 0; i < 4; ++i) { S[4 * n4 + i] = S[4 * n4 + i] * f4[i] + k4[i] * vv; o += S[4 * n4 + i] * q4[i]; }
            }
            if (MODE == 2) o += dsk * v;
            WSB(WS_Y)[row * 2048 + vc] = (bf16)f2bf(o);
        }
        LDS_WAIT(); asm volatile("" ::: "memory");
    }
}
__device__ __forceinline__ void nloop(Frame& F, int l) {
    const int gw = blockIdx.x * NWAVES + F.wave, NGW = F.G * NWAVES;
    const int stride = NGW >= 128 ? NGW / 128 : 1;
    for (int u = 0; u < 128; ++u) {
        if ((u * stride) % NGW != gw) continue;
        if (u < 32) nscan<0>(F, l, u >> 3, (u >> 1) & 3, u & 1);
        else if (u < 64) { const int v = u - 32; nscan<1>(F, l, v >> 3, (v >> 1) & 3, v & 1); }
        else { const int v = u - 64; nscan<2>(F, l, v >> 4, v & 15, 0); }
    }
}
__device__ __forceinline__ void post_rows(Frame& F, int l) {
    const int gw = F.vcu * NWAVES + F.wave, NGW = F.G * NWAVES, lane = F.lane;
    const GAS float* hgw = INF(I_HGNW) + l * 512 + 8 * lane; const GAS float* mnw = INF(I_MNW) + l * 1024 + 8 * lane;
    const GAS bf16* Yb = WSB(WS_Y); const GAS bf16* Pb = WSB(WS_PROJ); GAS bf16* Ob = WSB(WS_O);
    float wv[3][8];
    { const f32x4 a = *(const GAS f32x4*)hgw, b4 = *(const GAS f32x4*)(hgw + 4), c4 = *(const GAS f32x4*)mnw, d4 = *(const GAS f32x4*)(mnw + 4), e4 = *(const GAS f32x4*)(mnw + 512), f4 = *(const GAS f32x4*)(mnw + 516);
      wv[0][0] = a.x; wv[0][1] = a.y; wv[0][2] = a.z; wv[0][3] = a.w; wv[0][4] = b4.x; wv[0][5] = b4.y; wv[0][6] = b4.z; wv[0][7] = b4.w;
      wv[1][0] = c4.x; wv[1][1] = c4.y; wv[1][2] = c4.z; wv[1][3] = c4.w; wv[1][4] = d4.x; wv[1][5] = d4.y; wv[1][6] = d4.z; wv[1][7] = d4.w;
      wv[2][0] = e4.x; wv[2][1] = e4.y; wv[2][2] = e4.z; wv[2][3] = e4.w; wv[2][4] = f4.x; wv[2][5] = f4.y; wv[2][6] = f4.z; wv[2][7] = f4.w; }
    for (int row = gw; row < M; row += NGW) {
        const GAS bf16* yr = Yb + (size_t)row * 2048 + 8 * lane; const GAS bf16* pr = Pb + (size_t)row * NPROJ + 8 * lane; GAS bf16* orow = Ob + (size_t)row * 2048 + 8 * lane;
        v4u yw[4], gq[4];
#pragma unroll
        for (int j = 0; j < 4; ++j) yw[j] = *(const GAS v4u*)(yr + 512 * j);
        gq[0] = *(const GAS v4u*)(pr + C_RG); gq[1] = *(const GAS v4u*)(pr + C_HG); gq[2] = *(const GAS v4u*)(pr + C_MZ); gq[3] = *(const GAS v4u*)(pr + C_MZ + 512);
#pragma unroll
        for (int j = 0; j < 4; ++j) {
            float y[8], g[8], o[8]; unpack8(yw[j], y); unpack8(gq[j], g);
            if (j < 2) {
                float ss = 0.f;
#pragma unroll
                for (int e = 0; e < 8; ++e) ss += y[e] * y[e];
                ss = grp16_sum(ss);
                const float r = 1.f / sqrtf(ss * (1.f / 128.f) + RMS_EPS);
#pragma unroll
                for (int e = 0; e < 8; ++e) o[e] = y[e] * r * (j == 1 ? wv[0][e] : 1.f) * siluf_(g[e]);
            } else {
                float ss = 0.f;
#pragma unroll
                for (int e = 0; e < 8; ++e) { y[e] = y[e] * siluf_(g[e]); ss += y[e] * y[e]; }
                ss = wave_sum(ss);
                const float r = 1.f / sqrtf(ss * (1.f / 512.f) + RMS_EPS);
#pragma unroll
                for (int e = 0; e < 8; ++e) o[e] = y[e] * r * wv[j - 1][e];
            }
            *(GAS v4u*)(orow + 512 * j) = pack8(o);
        }
    }
}

struct Args { const void* in[19]; float* out; unsigned char* ws; int ph_lo, ph_hi, flags, pad; };
__global__ void __launch_bounds__(NWAVES * 64, 2) hymba_fwd(Args args) {
    extern __shared__ __attribute__((aligned(16))) unsigned char lds[];
    asm volatile("s_nop 0\ns_nop 0\ns_nop 0\ns_nop 0\ns_nop 0\ns_nop 0\ns_nop 0\ns_nop 0\ns_nop 0\ns_nop 0\ns_nop 0\ns_nop 0\ns_nop 0\ns_nop 0\ns_nop 0\ns_nop 0\ns_nop 0\ns_nop 0\ns_nop 0\ns_nop 0\ns_nop 0\ns_nop 0\ns_nop 0\ns_nop 0\n" ::: );
    Frame F;
    F.lds = (LAS unsigned char*)lds;
    F.MISC = (volatile LAS unsigned*)(F.lds + MISC_OFF);
    F.tid = threadIdx.x; F.lane = F.tid & 63; F.wave = __builtin_amdgcn_readfirstlane(F.tid >> 6);
    F.G = gridDim.x; { const int bx = blockIdx.x; F.vcu = (F.G % 8 == 0) ? (bx % 8) * (F.G / 8) + bx / 8 : bx; }
    F.ws = (GAS unsigned char*)args.ws;
    F.ctl = (gu32*)(args.ws + WS_CTL);
    for (int u = F.tid; u < LDSCTL_BYTES / 4; u += NWAVES * 64) ((LAS unsigned*)(F.lds + LDSCTL_OFF))[u] = 0u;
    __syncthreads();
    if (F.tid == 0) {
#pragma unroll
        for (int i = 0; i < 19; ++i) ((LAS unsigned long long*)(F.lds + PTAB_OFF))[i] = (unsigned long long)args.in[i];
        ((LAS unsigned long long*)(F.lds + PTAB_OFF))[19] = (unsigned long long)args.out;
        ((LAS unsigned long long*)(F.lds + PTAB_OFF))[20] = (unsigned long long)args.ws;
    }
    __syncthreads();
    const int lo = args.ph_lo, hi = args.ph_hi;
    XcdBarrier bar; bar.bar = (unsigned*)(F.ctl + CW_BAR); bar.x = 0; bar.st = nullptr;
    if (hi - lo > 1) bar = xcd_barrier_post((unsigned*)(F.ctl + CW_BAR), F.MISC + 8);
    int ph = 0;
#define PHASE_BEGIN if (ph >= lo && ph < hi) { { int t_; asm volatile("v_mov_b32 %0, %1" : "=v"(t_) : "v"((int)threadIdx.x)); F.tid = t_; F.lane = t_ & 63; F.wave = __builtin_amdgcn_readfirstlane(t_ >> 6); }
#define PHASE_END   if (ph + 1 < hi) xcd_barrier(bar); } ++ph;

    PHASE_BEGIN
#ifndef X_NO_PRO
 p0_prologue(F);
#endif
 PHASE_END
    PHASE_BEGIN
#ifndef X_NO_LN
 mod_rows(F, INF(I_X), WSF(WS_ADA), 1, 0);
#endif
 PHASE_END
    for (int l = 0; l < DEPTH; ++l) {
        const GAS float* ada_l = WSF(WS_ADA) + (size_t)l * BATCH * NADA;
        PHASE_BEGIN
#ifndef X_NO_GIN
{
            pg8::Gemm g{(const pg8::bf16_t*)WSB(WS_H), (const pg8::bf16_t*)(WSB(WS_WIN) + (size_t)l * NPROJ * D), M, NPROJ, D}; pg8::StaticOrder S; S.init(M, NPROJ, F.G, (int)blockIdx.x);
            pg8::EpiProj E{F.lds + PTAB_OFF, WS_PROJ, WS_DTRAW, NPROJ, C_DT / 256};
            pg8::gemm_phase<pg8::EpiProj, pg8::StaticOrder, PG8_ALIGN, PG8_SP2>(F.lds + RING_OFF, g, S, E);
            constexpr int NU = (M / 256) * (NPROJ / 256); const int full = NU / F.G, rem = NU % F.G;
            if (l + 1 < DEPTH) { if (rem != 0 && (int)blockIdx.x >= rem) convert_next_in_out(F, l + 1, (int)blockIdx.x - rem, F.G - rem); else if (rem == 0) convert_next_in_out(F, l + 1, (int)blockIdx.x, F.G); }
            (void)full;
        }
#endif
 PHASE_END
        PHASE_BEGIN
#if MIXER_NAIVE
 npre_rows(F, l);
#else
 mixer_pre(F, l, args.flags);
#endif
 PHASE_END
        PHASE_BEGIN
#if MIXER_NAIVE
 nloop(F, l);
#else
#ifndef X_NO_LOOP
 mixer_loop(F);
#endif
#endif
 PHASE_END
        PHASE_BEGIN
#ifndef X_NO_POST
 post_rows(F, l);
#endif
 PHASE_END
        PHASE_BEGIN
#ifndef X_NO_GOUT
{
            pg8::Gemm g{(const pg8::bf16_t*)WSB(WS_O), (const pg8::bf16_t*)(WSB(WS_WOUT) + (size_t)l * D * D), M, D, D}; pg8::StaticOrder S; S.init(M, D, F.G, (int)blockIdx.x);
            pg8::EpiRes E{F.lds + PTAB_OFF, WS_T, WS_ADA + ((size_t)l * BATCH * NADA + 2 * D) * 4, WS_STAT, D, NADA, l == 0 ? -1 : l * 2 - 1, ALPHA, (size_t)0};
            pg8::gemm_phase<pg8::EpiRes, pg8::StaticOrder, PG8_ALIGN, PG8_SP2>(F.lds + RING_OFF, g, S, E);
        }
#endif
 PHASE_END
        PHASE_BEGIN
#ifndef X_NO_LN
 ln_rows(F, WSB(WS_T), (const GAS float*)nullptr, INF(I_LNG) + (size_t)(l * 2 + 0) * D, INF(I_LNB) + (size_t)(l * 2 + 0) * D, WSF(WS_X), WSF(WS_STAT), ada_l, 4, 3, true);
#endif
 PHASE_END
        PHASE_BEGIN
#ifndef X_NO_G1
{
            pg8::Gemm g{(const pg8::bf16_t*)WSB(WS_H), (const pg8::bf16_t*)(WSB(WS_W1) + (size_t)l * DFF * D), M, DFF, D}; pg8::StaticOrder S; S.init(M, DFF, F.G, (int)blockIdx.x);
            pg8::EpiRelu2 E{F.lds + PTAB_OFF, WS_U, DFF};
            pg8::gemm_phase<pg8::EpiRelu2, pg8::StaticOrder, PG8_ALIGN, PG8_SP2>(F.lds + RING_OFF, g, S, E);
        }
#endif
 PHASE_END
        PHASE_BEGIN
#ifndef X_NO_G2
{
            pg8::Gemm g{(const pg8::bf16_t*)WSB(WS_U), (const pg8::bf16_t*)(WSB(WS_W2) + (size_t)l * D * DFF), M, D, DFF}; pg8::StaticOrder S; S.init(M, D, F.G, (int)blockIdx.x);
            pg8::EpiRes E{F.lds + PTAB_OFF, WS_T, WS_ADA + ((size_t)l * BATCH * NADA + 5 * D) * 4, WS_STAT, D, NADA, l * 2, ALPHA, (l == DEPTH - 1) ? (size_t)WS_X : (size_t)0};
            pg8::gemm_phase<pg8::EpiRes, pg8::StaticOrder, PG8_ALIGN, PG8_SP2>(F.lds + RING_OFF, g, S, E);
        }
#endif
 PHASE_END
        PHASE_BEGIN
#ifndef X_NO_LN
 ln_rows(F, WSB(WS_T), (l == DEPTH - 1) ? (const GAS float*)WSF(WS_X) : (const GAS float*)nullptr, INF(I_LNG) + (size_t)(l * 2 + 1) * D, INF(I_LNB) + (size_t)(l * 2 + 1) * D, (GAS float*)ptab_get(F, I_OUT), WSF(WS_STAT), ada_l + (size_t)BATCH * NADA, 1, 0, l < DEPTH - 1);
#endif
 PHASE_END
    }
#undef PHASE_BEGIN
#undef PHASE_END
}

extern "C" void kernel_launch(void* const* d_in, const int* in_sizes, int n_in, void* d_out, int out_size, void* d_ws, size_t ws_size, hipStream_t stream) {
    static int grid = 0;
    if (grid == 0) {
        if (n_in != 19 || in_sizes[0] != M * D || out_size != M * D || ws_size < WS_END) { fprintf(stderr, "kernel_launch: unexpected shapes (n_in %d, in0 %d, out %d, ws %zu)\n", n_in, n_in > 0 ? in_sizes[0] : -1, out_size, ws_size); grid = -1; return; }
        int dev = 0, cus = 0, per_cu = 0;
        if (hipGetDevice(&dev) != hipSuccess || hipDeviceGetAttribute(&cus, hipDeviceAttributeMultiprocessorCount, dev) != hipSuccess) { grid = -1; return; }
        if (hipFuncSetAttribute((const void*)hymba_fwd, hipFuncAttributeMaxDynamicSharedMemorySize, LDS_BYTES) != hipSuccess) { fprintf(stderr, "kernel_launch: hipFuncSetAttribute failed\n"); grid = -1; return; }
        if (hipOccupancyMaxActiveBlocksPerMultiprocessor(&per_cu, (const void*)hymba_fwd, NWAVES * 64, LDS_BYTES) != hipSuccess || per_cu < 1)
            fprintf(stderr, "kernel_launch: note: occupancy query reports %d workgroups per CU\n", per_cu);
        (void)hipGetLastError();
        grid = cus;
    }
    if (grid < 0) return;
    if (hipMemsetAsync((char*)d_ws + WS_CTL, 0, CTL_ZERO_BYTES, stream) != hipSuccess) return;
    Args a{};
    for (int i = 0; i < 19; ++i) a.in[i] = d_in[i];
    a.out = (float*)d_out; a.ws = (unsigned char*)d_ws;
#if MK_PER_PHASE
    for (int p = 0; p < N_PHASES; ++p) { a.ph_lo = p; a.ph_hi = p + 1; hipLaunchKernelGGL(hymba_fwd, dim3(grid), dim3(NWAVES * 64), LDS_BYTES, stream, a); }
#else
    a.ph_lo = 0; a.ph_hi = N_PHASES;
    hipLaunchKernelGGL(hymba_fwd, dim3(grid), dim3(NWAVES * 64), LDS_BYTES, stream, a);
#if defined(PROBE_SET)
#ifndef PROBE_FLAGS
#define PROBE_FLAGS 0
#endif
    {
        const int L3 = 2 + 3 * PH_PER_LAYER;
        const int sets[10][4] = { {0, -1, -1, -1}, {L3 + 0, L3 + 4, L3 + 6, L3 + 7}, {L3 + 1, L3 + 2, L3 + 3, -1}, {L3 + 5, L3 - 1, -1, -1}, {L3 + 1, -1, -1, -1}, {L3 + 2, -1, -1, -1}, {L3 + 0, -1, -1, -1}, {L3 + 7, -1, -1, -1}, {L3 + 4, -1, -1, -1}, {L3 + 6, -1, -1, -1} };
        for (int rep = 0; rep < PROBE_REPS; ++rep) for (int k = 0; k < 4; ++k) { const int p = sets[PROBE_SET][k]; if (p < 0) continue;
            a.ph_lo = p; a.ph_hi = p + 1; a.flags = PROBE_FLAGS; hipLaunchKernelGGL(hymba_fwd, dim3(grid), dim3(NWAVES * 64), LDS_BYTES, stream, a); }
    }
#endif
#endif
    const hipError_t le = hipPeekAtLastError();
    if (le != hipSuccess) fprintf(stderr, "kernel_launch: launch failed: %s\n", hipGetErrorName(le));
}
```

```cpp
#include <hip/hip_runtime.h>
#include <cstdio>
#include <cstdint>
namespace pg8 {
#define PG8_LAS __attribute__((address_space(3)))
typedef unsigned short bf16_t;
typedef short bf16x8 __attribute__((ext_vector_type(8)));
typedef float f32x4 __attribute__((ext_vector_type(4)));
typedef unsigned u32x4 __attribute__((ext_vector_type(4)));
constexpr int BM = 256, BK = 64, HALF = 128, HTB = HALF * BK * 2  , STAGE_BYTES = 8 * HTB, NXCD = 8, WGM = 8;

__host__ __device__ __forceinline__ int lds_byte(int r, int c) { const int st = (r >> 4) * 2 + (c >> 5), rr = r & 15, cc = c & 31, ob = rr * 64 + cc * 2; return st * 1024 + (ob ^ (((ob >> 9) & 1) << 5)); }
__host__ __device__ __forceinline__ void stage_rc(int b, int& R, int& C) { const int st = b / 1024, sb = b % 1024, swz = sb ^ (((sb >> 9) & 1) << 5); R = (st >> 1) * 16 + swz / 64; C = (st & 1) * 32 + (swz % 64) / 2; }
__host__ __device__ __forceinline__ int perm32(int rho) { const int n = rho >> 4, i = rho & 15; return 8 * (i >> 2) + 4 * n + (i & 3); }

struct Unit { int pm, pn; };
struct Gemm { const bf16_t* A; const bf16_t* Bt; int M, N, K; };

struct StaticOrder {
    int nM, nN, nwg, G, c;
    __host__ __device__ void init(int M, int N, int G_, int c_) { nM = M / BM; nN = N / BM; nwg = nM * nN; G = G_; c = c_; }
    __host__ __device__ bool next(int i, Unit& u) const {
        const long L = (long)i * G + c; if (L >= nwg) return false;
        int wgid = (int)L; { const int q = nwg / NXCD, r = nwg % NXCD, xcd = wgid % NXCD, off = wgid / NXCD; wgid = (xcd < r ? xcd * (q + 1) : r * (q + 1) + (xcd - r) * q) + off; }
        const int nig = WGM * nN, gid = wgid / nig, fm = gid * WGM, gsz = (nM - fm) < WGM ? (nM - fm) : WGM;
        u.pm = fm + ((wgid % nig) % gsz); u.pn = (wgid % nig) / gsz; return true;
    }
    __device__ __forceinline__ void a_ready(const Unit&) const {}
    __device__ __forceinline__ void done(const Unit&) const {}
};

typedef float f32x2 __attribute__((ext_vector_type(2)));
#define PG8_GAS __attribute__((address_space(1)))
__device__ __forceinline__ unsigned long long tab_get(PG8_LAS const unsigned char* tab, int i) {
    const unsigned long long v = ((const volatile PG8_LAS unsigned long long*)tab)[i];
    const unsigned lo = __builtin_amdgcn_readfirstlane((unsigned)v), hi = __builtin_amdgcn_readfirstlane((unsigned)(v >> 32));
    return ((unsigned long long)hi << 32) | lo;
}
__device__ __forceinline__ unsigned cvt_pk_bf16(float lo, float hi) { unsigned r; asm volatile("v_cvt_pk_bf16_f32 %0, %1, %2" : "=v"(r) : "v"(lo), "v"(hi)); return r; }

struct EpiProj {
    static constexpr bool PERM = true, AFTER_DRAIN = false;
    PG8_LAS const unsigned char* tab; size_t o_off, dt_off; int ldc; int dt_pn;
    __device__ __forceinline__ void operator()(const f32x4 (&acc)[2][2][4][2], const Unit& u, int wr, int wc, int fr, int fq) const {
        PG8_GAS unsigned char* wsb = (PG8_GAS unsigned char*)tab_get(tab, 20); PG8_GAS bf16_t* O = (PG8_GAS bf16_t*)(wsb + o_off); PG8_GAS float* dtraw = (PG8_GAS float*)(wsb + dt_off);
        const int row0 = u.pm * BM + wr * 64 + fr; const int col0 = u.pn * BM + wc * 32 + 8 * fq;
        const bool isdt = (u.pn == dt_pn) && (wc == 0) && (fq < 2);
#pragma unroll
        for (int ai = 0; ai < 2; ++ai)
#pragma unroll
            for (int m = 0; m < 4; ++m) { const int row = row0 + ai * HALF + m * 16; PG8_GAS bf16_t* rowp = O + (size_t)row * ldc + col0;
#pragma unroll
                for (int bj = 0; bj < 2; ++bj) { const f32x4 v0 = acc[ai][bj][m][0], v1 = acc[ai][bj][m][1];
                    u32x4 w; w.x = cvt_pk_bf16(v0[0], v0[1]); w.y = cvt_pk_bf16(v0[2], v0[3]); w.z = cvt_pk_bf16(v1[0], v1[1]); w.w = cvt_pk_bf16(v1[2], v1[3]);
                    *(PG8_GAS u32x4*)(rowp + bj * HALF) = w;
                    if (bj == 0 && isdt) { PG8_GAS float* dp = dtraw + (size_t)row * 16 + 8 * fq; *(PG8_GAS f32x4*)dp = v0; *(PG8_GAS f32x4*)(dp + 4) = v1; } } }
    }
};
struct EpiRelu2 {
    static constexpr bool PERM = true, AFTER_DRAIN = false;
    PG8_LAS const unsigned char* tab; size_t o_off; int ldc;
    __device__ __forceinline__ void operator()(const f32x4 (&acc)[2][2][4][2], const Unit& u, int wr, int wc, int fr, int fq) const {
        PG8_GAS bf16_t* O = (PG8_GAS bf16_t*)((PG8_GAS unsigned char*)tab_get(tab, 20) + o_off);
        const int row0 = u.pm * BM + wr * 64 + fr; const int col0 = u.pn * BM + wc * 32 + 8 * fq;
#pragma unroll
        for (int ai = 0; ai < 2; ++ai)
#pragma unroll
            for (int m = 0; m < 4; ++m) { PG8_GAS bf16_t* rowp = O + (size_t)(row0 + ai * HALF + m * 16) * ldc + col0;
#pragma unroll
                for (int bj = 0; bj < 2; ++bj) { f32x4 v0 = acc[ai][bj][m][0], v1 = acc[ai][bj][m][1];
#pragma unroll
                    for (int j = 0; j < 4; ++j) { const float a = fmaxf(v0[j], 0.f), b = fmaxf(v1[j], 0.f); v0[j] = a * a; v1[j] = b * b; }
                    u32x4 w; w.x = cvt_pk_bf16(v0[0], v0[1]); w.y = cvt_pk_bf16(v0[2], v0[3]); w.z = cvt_pk_bf16(v1[0], v1[1]); w.w = cvt_pk_bf16(v1[2], v1[3]);
                    *(PG8_GAS u32x4*)(rowp + bj * HALF) = w; } }
    }
};
struct EpiRes {
    static constexpr bool PERM = true, AFTER_DRAIN = false;
    PG8_LAS const unsigned char* tab; size_t t_off, gate_off, stat_off; int ldc, gstride, ln_idx  ; float alpha; size_t tf_off  ;
    __device__ __forceinline__ void operator()(const f32x4 (&acc)[2][2][4][2], const Unit& u, int wr, int wc, int fr, int fq) const {
        PG8_GAS unsigned char* wsb = (PG8_GAS unsigned char*)tab_get(tab, 20);
        PG8_GAS bf16_t* T = (PG8_GAS bf16_t*)(wsb + t_off); const PG8_GAS float* gate = (const PG8_GAS float*)(wsb + gate_off); const PG8_GAS float* stats = (const PG8_GAS float*)(wsb + stat_off);
        const PG8_GAS float* lng = ln_idx >= 0 ? (const PG8_GAS float*)tab_get(tab, 8) + (size_t)ln_idx * ldc : nullptr; const PG8_GAS float* lnb = ln_idx >= 0 ? (const PG8_GAS float*)tab_get(tab, 9) + (size_t)ln_idx * ldc : nullptr;
        const PG8_GAS float* xraw = (const PG8_GAS float*)tab_get(tab, 0);
        const int row0 = u.pm * BM + wr * 64 + fr, col0 = u.pn * BM + wc * 32 + 8 * fq;
        const PG8_GAS float* gp = gate + (size_t)(u.pm >> 3) * gstride + col0;
#pragma unroll
        for (int bj = 0; bj < 2; ++bj) { const int co = bj * HALF;
            const f32x4 gv0 = *(const PG8_GAS f32x4*)(gp + co) + 1.0f, gv1 = *(const PG8_GAS f32x4*)(gp + co + 4) + 1.0f;
            f32x4 lg0 = (f32x4){alpha, alpha, alpha, alpha}, lg1 = lg0, lb0 = (f32x4){0.f, 0.f, 0.f, 0.f}, lb1 = lb0;
            if (lng) { lg0 = *(const PG8_GAS f32x4*)(lng + col0 + co) * alpha; lg1 = *(const PG8_GAS f32x4*)(lng + col0 + co + 4) * alpha; lb0 = *(const PG8_GAS f32x4*)(lnb + col0 + co) * alpha; lb1 = *(const PG8_GAS f32x4*)(lnb + col0 + co + 4) * alpha; }
#pragma unroll
            for (int ai = 0; ai < 2; ++ai)
#pragma unroll
                for (int m = 0; m < 4; ++m) { const int row = row0 + ai * HALF + m * 16; const size_t off = (size_t)row * ldc + col0 + co;
                    float mu_ = 0.f, rs_ = 1.f; if (lng) { const f32x2 st = *(const PG8_GAS f32x2*)(stats + 2 * (size_t)row); mu_ = st.x; rs_ = st.y; }
                    f32x4 x0, x1;
                    if (lng) { const u32x4 tw = *(const PG8_GAS u32x4*)(T + off);
                        x0 = (f32x4){__builtin_bit_cast(float, tw.x << 16), __builtin_bit_cast(float, tw.x & 0xffff0000u), __builtin_bit_cast(float, tw.y << 16), __builtin_bit_cast(float, tw.y & 0xffff0000u)};
                        x1 = (f32x4){__builtin_bit_cast(float, tw.z << 16), __builtin_bit_cast(float, tw.z & 0xffff0000u), __builtin_bit_cast(float, tw.w << 16), __builtin_bit_cast(float, tw.w & 0xffff0000u)}; }
                    else { x0 = *(const PG8_GAS f32x4*)(xraw + off); x1 = *(const PG8_GAS f32x4*)(xraw + off + 4); }
                    const f32x4 t0 = ((x0 - mu_) * rs_) * lg0 + lb0 + gv0 * acc[ai][bj][m][0], t1 = ((x1 - mu_) * rs_) * lg1 + lb1 + gv1 * acc[ai][bj][m][1];
                    if (tf_off) { PG8_GAS float* tf = (PG8_GAS float*)(wsb + tf_off) + off; *(PG8_GAS f32x4*)tf = t0; *(PG8_GAS f32x4*)(tf + 4) = t1; }
                    else { u32x4 w; w.x = cvt_pk_bf16(t0[0], t0[1]); w.y = cvt_pk_bf16(t0[2], t0[3]); w.z = cvt_pk_bf16(t1[0], t1[1]); w.w = cvt_pk_bf16(t1[2], t1[3]);
                        *(PG8_GAS u32x4*)(T + off) = w; } }
            asm volatile("" ::: "memory"); }
    }
};

template <class Epi, class Sched, bool ALIGN_EPI = false, bool SP2 = false>
__device__ __forceinline__ void gemm_phase(PG8_LAS unsigned char* lds, const Gemm g, const Sched& S, const Epi& E) {
    int tid_l; asm volatile("v_mov_b32 %0, %1" : "=v"(tid_l) : "v"((int)threadIdx.x));
    const int tid = tid_l, wid = __builtin_amdgcn_readfirstlane(tid >> 6), lane = tid & 63, wr = wid >> 2, wc = wid & 3, fr = lane & 15, fq = lane >> 4;
    const int K = g.K, nt = K / BK;
    unsigned voffA[2], voffB[2];
#pragma unroll
    for (int i = 0; i < 2; ++i) { int R, C; stage_rc(tid * 16 + i * 8192, R, C); const int Rb = Epi::PERM ? ((R & ~31) + perm32(R & 31)) : R;
        voffA[i] = (unsigned)(R * K + C) * 2u; voffB[i] = (unsigned)(Rb * K + C) * 2u; }
    const size_t kstep = (size_t)(BK * 2);
    const size_t hstep = (size_t)HALF * K * 2;
    const size_t tstep = 2 * hstep;
    const unsigned ldsw = (unsigned)wid * 1024u;
    const int aoff = lds_byte(wr * 64 + fr, fq * 8), boff = lds_byte(wc * 32 + fr, fq * 8);
#define PG8_SA(b, h) (((b) * 2 + (h)) * HTB)
#define PG8_SB(b, h) ((4 + (b) * 2 + (h)) * HTB)
#define PG8_STAGE(bufoff, gbase, voff) do { _Pragma("unroll") for (int _i = 0; _i < 2; ++_i) \
        __builtin_amdgcn_global_load_lds((const unsigned*)((const char*)(gbase) + (voff)[_i]), (PG8_LAS unsigned*)(lds + (bufoff) + ldsw + _i * 8192), 16, 0, 0); } while (0)
#define PG8_LDA(dst, b, h) do { _Pragma("unroll") for (int m = 0; m < 4; ++m) _Pragma("unroll") for (int k = 0; k < 2; ++k) dst[m][k] = *(const PG8_LAS bf16x8*)(lds + PG8_SA(b, h) + aoff + m * 2048 + k * 1024); } while (0)
#define PG8_LDB(dst, b, h) do { _Pragma("unroll") for (int n = 0; n < 2; ++n) _Pragma("unroll") for (int k = 0; k < 2; ++k) dst[n][k] = *(const PG8_LAS bf16x8*)(lds + PG8_SB(b, h) + boff + n * 2048 + k * 1024); } while (0)
#define PG8_MMA(ai, bj, At, Bt) do { __builtin_amdgcn_s_setprio(1); _Pragma("unroll") for (int m = 0; m < 4; ++m) _Pragma("unroll") for (int n = 0; n < 2; ++n) _Pragma("unroll") for (int k = 0; k < 2; ++k) \
        acc[ai][bj][m][n] = __builtin_amdgcn_mfma_f32_16x16x32_bf16(Bt[n][k], At[m][k], acc[ai][bj][m][n], 0, 0, 0); __builtin_amdgcn_s_setprio(0); } while (0)
#define PG8_WAIT_V(n) asm volatile("s_waitcnt vmcnt(" #n ")" ::: "memory")
#define PG8_WAIT_L(n) asm volatile("s_waitcnt lgkmcnt(" #n ")" ::: "memory")
#define PG8_BAR __builtin_amdgcn_s_barrier()
#define PG8_SCHED __builtin_amdgcn_sched_barrier(0)
    Unit cur, nxt; int ui = 0;
    if (!S.next(0, cur)) return;
    f32x4 acc[2][2][4][2];
#pragma unroll
    for (int a = 0; a < 2; ++a)
#pragma unroll
        for (int b = 0; b < 2; ++b)
#pragma unroll
            for (int m = 0; m < 4; ++m)
#pragma unroll
                for (int n = 0; n < 2; ++n) acc[a][b][m][n] = (f32x4){0.f, 0.f, 0.f, 0.f};
    bf16x8 At[4][2], B0[2][2], B1[2][2];
    const char* cA = (const char*)g.A + (size_t)cur.pm * tstep; const char* cB = (const char*)g.Bt + (size_t)cur.pn * tstep;
    S.a_ready(cur);
    if constexpr (SP2) {
        PG8_STAGE(PG8_SB(0, 0), cB, voffB); PG8_STAGE(PG8_SB(0, 1), cB + hstep, voffB); PG8_STAGE(PG8_SA(0, 0), cA, voffA); PG8_STAGE(PG8_SA(0, 1), cA + hstep, voffA);
        if (wr == 1) PG8_BAR;
        PG8_WAIT_V(2); PG8_BAR;
        PG8_STAGE(PG8_SB(1, 0), cB + kstep, voffB); PG8_STAGE(PG8_SA(1, 0), cA + kstep, voffA); PG8_STAGE(PG8_SB(1, 1), cB + hstep + kstep, voffB);
        PG8_WAIT_V(6); PG8_BAR;
    } else {
        PG8_STAGE(PG8_SB(0, 0), cB, voffB); PG8_STAGE(PG8_SA(0, 0), cA, voffA); PG8_STAGE(PG8_SB(0, 1), cB + hstep, voffB); PG8_STAGE(PG8_SA(0, 1), cA + hstep, voffA);
        if (wr == 1) PG8_BAR;
        PG8_WAIT_V(4); PG8_BAR;
        PG8_STAGE(PG8_SB(1, 0), cB + kstep, voffB); PG8_STAGE(PG8_SA(1, 0), cA + kstep, voffA); PG8_STAGE(PG8_SB(1, 1), cB + hstep + kstep, voffB);
        PG8_WAIT_V(6); PG8_BAR;
    }
    for (;;) {
        const bool has_next = S.next(ui + 1, nxt);
        const char* nA = has_next ? (const char*)g.A + (size_t)nxt.pm * tstep : cA; const char* nB = has_next ? (const char*)g.Bt + (size_t)nxt.pn * tstep : cB;
        for (int t = 0; t < nt; t += 2) {
            const bool last = (t == nt - 2);
            const char* a1 = cA + (size_t)(t + 1) * kstep;
            const char* a2 = last ? nA : cA + (size_t)(t + 2) * kstep; const char* b2 = last ? nB : cB + (size_t)(t + 2) * kstep;
            const char* a3 = a2 + kstep; const char* b3 = b2 + kstep;
            if (last && has_next) S.a_ready(nxt);
            if constexpr (SP2) {
            PG8_LDB(B0, 0, 0); PG8_LDB(B1, 0, 1); PG8_SCHED; PG8_LDA(At, 0, 0); PG8_STAGE(PG8_SA(1, 1), a1 + hstep, voffA);
            PG8_WAIT_V(8); PG8_WAIT_L(0); PG8_BAR; PG8_MMA(0, 0, At, B0); PG8_MMA(0, 1, At, B1); PG8_BAR; PG8_SCHED;
            PG8_LDA(At, 0, 1); PG8_STAGE(PG8_SB(0, 0), b2, voffB); PG8_STAGE(PG8_SB(0, 1), b2 + hstep, voffB); PG8_STAGE(PG8_SA(0, 0), a2, voffA);
            PG8_WAIT_V(8); PG8_WAIT_L(0); PG8_BAR; PG8_MMA(1, 0, At, B0); PG8_MMA(1, 1, At, B1); PG8_BAR; PG8_SCHED;
            PG8_LDB(B0, 1, 0); PG8_LDB(B1, 1, 1); PG8_SCHED; PG8_LDA(At, 1, 0); PG8_STAGE(PG8_SA(0, 1), a2 + hstep, voffA);
            PG8_WAIT_V(8); PG8_WAIT_L(0); PG8_BAR; PG8_MMA(0, 0, At, B0); PG8_MMA(0, 1, At, B1); PG8_BAR; PG8_SCHED;
            PG8_LDA(At, 1, 1); PG8_STAGE(PG8_SB(1, 0), b3, voffB); PG8_STAGE(PG8_SB(1, 1), b3 + hstep, voffB); PG8_STAGE(PG8_SA(1, 0), a3, voffA);
            PG8_WAIT_V(8); PG8_WAIT_L(0); PG8_BAR; PG8_MMA(1, 0, At, B0); PG8_MMA(1, 1, At, B1); PG8_BAR; PG8_SCHED;
            } else {
            PG8_LDB(B0, 0, 0); PG8_SCHED; PG8_LDA(At, 0, 0); PG8_STAGE(PG8_SA(1, 1), a1 + hstep, voffA);
            PG8_WAIT_L(8); PG8_BAR; PG8_WAIT_L(0); PG8_MMA(0, 0, At, B0); PG8_BAR; PG8_SCHED;
            PG8_LDB(B1, 0, 1); PG8_STAGE(PG8_SB(0, 0), b2, voffB);
            PG8_BAR; PG8_WAIT_L(0); PG8_MMA(0, 1, At, B1); PG8_BAR;
            PG8_LDA(At, 0, 1); PG8_STAGE(PG8_SA(0, 0), a2, voffA);
            PG8_BAR; PG8_WAIT_L(0); PG8_MMA(1, 0, At, B0); PG8_BAR; PG8_SCHED;
            PG8_STAGE(PG8_SB(0, 1), b2 + hstep, voffB);
            PG8_WAIT_V(6); PG8_BAR; PG8_MMA(1, 1, At, B1); PG8_BAR;
            PG8_LDB(B0, 1, 0); PG8_SCHED; PG8_LDA(At, 1, 0); PG8_STAGE(PG8_SA(0, 1), a2 + hstep, voffA);
            PG8_WAIT_L(8); PG8_BAR; PG8_WAIT_L(0); PG8_MMA(0, 0, At, B0); PG8_BAR; PG8_SCHED;
            PG8_LDB(B1, 1, 1); PG8_STAGE(PG8_SB(1, 0), b3, voffB);
            PG8_BAR; PG8_WAIT_L(0); PG8_MMA(0, 1, At, B1); PG8_BAR;
            PG8_LDA(At, 1, 1); PG8_STAGE(PG8_SA(1, 0), a3, voffA);
            PG8_BAR; PG8_WAIT_L(0); PG8_MMA(1, 0, At, B0); PG8_BAR; PG8_SCHED;
            PG8_STAGE(PG8_SB(1, 1), b3 + hstep, voffB);
            PG8_WAIT_V(6); PG8_BAR; PG8_MMA(1, 1, At, B1); PG8_BAR;
            }
        }
        if constexpr (ALIGN_EPI) { if (wr == 0) PG8_BAR; }
        if constexpr (!Epi::AFTER_DRAIN) { E(acc, cur, wr, wc, fr, fq); S.done(cur); }
        if (!has_next) break;
#pragma unroll
        for (int a = 0; a < 2; ++a)
#pragma unroll
            for (int b = 0; b < 2; ++b)
#pragma unroll
                for (int m = 0; m < 4; ++m)
#pragma unroll
                    for (int n = 0; n < 2; ++n) acc[a][b][m][n] = (f32x4){0.f, 0.f, 0.f, 0.f};
        cur = nxt; cA = nA; cB = nB; ++ui;
        if constexpr (ALIGN_EPI) { if (wr == 1) PG8_BAR; }
    }
    PG8_WAIT_V(0);
    if constexpr (!ALIGN_EPI) { if (wr == 0) PG8_BAR; }
    PG8_BAR;
    if constexpr (Epi::AFTER_DRAIN) { E.fused(acc, cur, wr, wc, fr, fq, lds, wid, lane); S.done(cur); }
#undef PG8_SA
#undef PG8_SB
#undef PG8_STAGE
#undef PG8_LDA
#undef PG8_LDB
#undef PG8_MMA
#undef PG8_WAIT_V
#undef PG8_WAIT_L
#undef PG8_BAR
#undef PG8_SCHED
}
}
#ifndef PG8_SP2
#define PG8_SP2 true
#endif
#ifndef PG8_ALIGN
#define PG8_ALIGN true
#endif
#ifndef MIXER_V2
#define MIXER_V2 0
#endif
#ifndef MIXER_NAIVE
#define MIXER_NAIVE 0
#endif
#ifndef MK_PER_PHASE
#define MK_PER_PHASE 0
#endif

constexpr int NWAVES = 8;
constexpr int BATCH = 4, SEQ = 2048, D = 2048, DEPTH = 4, M = BATCH * SEQ;
constexpr int IN_COLS = 6672, NPROJ = 6912, DFF = 8192, NADA = 6 * D;
constexpr int C_RQ = 0, C_RK = 512, C_RV = 1024, C_RG = 1536, C_HQ = 2048, C_HF = 2560, C_HI = 3072, C_HG = 3584, C_MZ = 4096, C_MX = 5120, C_MB = 6144, C_MC = 6400, C_DT = 6656;
constexpr int MCONV = 1536;
constexpr float LN_EPS = 1e-5f, RMS_EPS = 1e-6f;
constexpr float ALPHA = 1.681792830507429f;
constexpr int PH_PER_LAYER = 9, N_PHASES = 2 + DEPTH * PH_PER_LAYER;

constexpr size_t MiB = 1u << 20;
constexpr size_t WS_CTL = 0, CTL_ZERO_BYTES = 1 * MiB;
constexpr size_t WS_ADA = 1 * MiB, WS_LBS = 2 * MiB, WS_DTRAW = 3 * MiB, WS_COS = 4 * MiB, WS_SIN = 6 * MiB;
constexpr size_t WS_WIN = 8 * MiB, WS_WOUT = 116 * MiB, WS_W1 = 148 * MiB, WS_W2 = 276 * MiB;
constexpr size_t WS_H = 404 * MiB, WS_Y = 436 * MiB, WS_O = 468 * MiB, WS_T = 500 * MiB, WS_X = 564 * MiB, WS_PROJ = 628 * MiB, WS_U = 736 * MiB;
constexpr size_t WS_NQ = 864 * MiB, WS_NK = 904 * MiB, WS_NV = 944 * MiB, WS_NF = 1008 * MiB, WS_NDT = 1024 * MiB, WS_NDA = 1025 * MiB, WS_END = 1026 * MiB;
static_assert(WS_WIN + (size_t)DEPTH * NPROJ * D * 2 <= WS_WOUT && WS_PROJ + (size_t)M * NPROJ * 2 <= WS_U && WS_U + (size_t)M * DFF * 2 <= WS_NQ, "d_ws map");
constexpr size_t WS_STAT = 2 * MiB + 512 * 1024;
constexpr int CW_BAR = 4096;

constexpr int LDSCTL_OFF = 0, MISC_OFF = LDSCTL_OFF + 320, LDSCTL_BYTES = 1024;
constexpr int RING_OFF = LDSCTL_BYTES, RING_BYTES = 162816;
constexpr int LDS_BYTES = 163840;

#define GAS __attribute__((address_space(1)))
#define LAS __attribute__((address_space(3)))
typedef unsigned short bf16;
typedef unsigned v4u __attribute__((ext_vector_type(4)));
typedef unsigned v2u __attribute__((ext_vector_type(2)));
typedef float f32x4 __attribute__((ext_vector_type(4)));
typedef float f32x2 __attribute__((ext_vector_type(2)));
typedef GAS unsigned gu32;
#define RLX_AGENT __ATOMIC_RELAXED, __HIP_MEMORY_SCOPE_AGENT
#define LDS_WAIT() asm volatile("s_waitcnt lgkmcnt(0)" ::: "memory")
#define VM_WAIT() asm volatile("s_waitcnt vmcnt(0)" ::: "memory")
__device__ __forceinline__ unsigned f2bf(float f) { unsigned u = __builtin_bit_cast(unsigned, f); return (u + 0x7fffu + ((u >> 16) & 1u)) >> 16; }
__device__ __forceinline__ unsigned pk2(float lo, float hi) { return f2bf(lo) | (f2bf(hi) << 16); }
__device__ __forceinline__ float bf2f(unsigned short h) { return __builtin_bit_cast(float, (unsigned)h << 16); }
__device__ __forceinline__ float bflo(unsigned w) { return __builtin_bit_cast(float, w << 16); }
__device__ __forceinline__ float bfhi(unsigned w) { return __builtin_bit_cast(float, w & 0xffff0000u); }
__device__ __forceinline__ float sigmoidf_(float x) { return __builtin_amdgcn_rcpf(1.0f + __expf(-x)); }
__device__ __forceinline__ float siluf_(float x) { return x * __builtin_amdgcn_rcpf(1.0f + __expf(-x)); }

#define XB_TMO      128
#define XB_XCNT(j)  (256  + 64 * (j))
#define XB_XSUB(j)  (1280 + 64 * (j))
#define XB_XGEN(j)  (2304 + 64 * (j))
#define XB_TOP      3328
#define XB_TOPGEN   3392
#define XCD_BAR_WORDS 3456
#define XB_SPIN_CAP (1u << 18)
__device__ __forceinline__ unsigned xb_ld(unsigned* p)              { return __hip_atomic_load(p, __ATOMIC_RELAXED, __HIP_MEMORY_SCOPE_AGENT); }
__device__ __forceinline__ unsigned xb_add(unsigned* p, unsigned v) { return __hip_atomic_fetch_add(p, v, __ATOMIC_RELAXED, __HIP_MEMORY_SCOPE_AGENT); }
__device__ __forceinline__ unsigned xb_xcc_id() { return (unsigned)__builtin_amdgcn_s_getreg((3 << 11) | 20) & 0xFu; }
#define XB_SPIN(cond, bar) do { unsigned _sp = 0; while (cond) { __builtin_amdgcn_s_sleep(1); \
    if ((++_sp & 255u) == 0u) { if (xb_ld(&(bar)[XB_TMO])) break; if (_sp > XB_SPIN_CAP) { atomicAdd(&(bar)[XB_TMO], 1u); break; } } } } while (0)
struct XcdBarrier { unsigned* bar; unsigned x; volatile LAS unsigned* st; };
__device__ __forceinline__ XcdBarrier xcd_barrier_post(unsigned* bar, volatile LAS unsigned* st) {
    XcdBarrier b; b.bar = bar; b.x = xb_xcc_id(); b.st = st;
    if (threadIdx.x == 0) (void)xb_add(&bar[XB_XCNT(b.x)], 1u);
    return b;
}
__device__ __forceinline__ void xcd_barrier_complete(unsigned* bar, unsigned x, unsigned& nloc, unsigned& nx) {
    const unsigned G = gridDim.x * gridDim.y * gridDim.z;
    unsigned sum, cnt, mine, sp = 0u;
    for (;;) {
        sum = 0u; cnt = 0u; mine = 0u;
#pragma unroll
        for (unsigned j = 0; j < 16; ++j) { const unsigned c = xb_ld(&bar[XB_XCNT(j)]); sum += c; cnt += (c > 0u) ? 1u : 0u; mine = (j == x) ? c : mine; }
        if (sum == G) break;
        __builtin_amdgcn_s_sleep(1);
        if ((++sp & 255u) == 0u) { if (xb_ld(&bar[XB_TMO])) break; if (sp > XB_SPIN_CAP) { atomicAdd(&bar[XB_TMO], 1u); break; } }
    }
    nloc = mine > 0u ? mine : 1u; nx = cnt > 0u ? cnt : 1u;
}
__device__ __forceinline__ void xcd_barrier(const XcdBarrier& b) {
    asm volatile("s_waitcnt vmcnt(0)" ::: "memory");
    __syncthreads();
    if (threadIdx.x == 0) {
        unsigned* bar = b.bar;
        __builtin_amdgcn_s_waitcnt(0);
        unsigned nloc = b.st[0], nx = b.st[1];
        if (nloc == 0u) { xcd_barrier_complete(bar, b.x, nloc, nx); b.st[0] = nloc; b.st[1] = nx; }
        const unsigned old = xb_add(&bar[XB_XSUB(b.x)], 1u);
        const unsigned gen = old / nloc;
        if (old + 1u == (gen + 1u) * nloc) {
            __builtin_amdgcn_fence(__ATOMIC_RELEASE, "agent");
            asm volatile("s_waitcnt vmcnt(0)" ::: "memory");
            const unsigned og = xb_add(&bar[XB_TOP], 1u);
            const unsigned tg = og / nx;
            if (og + 1u == (tg + 1u) * nx) xb_add(&bar[XB_TOPGEN], 1u);
            else XB_SPIN(xb_ld(&bar[XB_TOPGEN]) == tg, bar);
            __builtin_amdgcn_fence(__ATOMIC_ACQUIRE, "agent");
            xb_add(&bar[XB_XGEN(b.x)], 1u);
            asm volatile("s_waitcnt vmcnt(0)" ::: "memory");
        } else {
            XB_SPIN(xb_ld(&bar[XB_XGEN(b.x)]) == gen, bar);
            __builtin_amdgcn_fence(__ATOMIC_ACQUIRE, "agent");
            asm volatile("s_waitcnt vmcnt(0)" ::: "memory");
        }
    }
    __syncthreads();
}

struct Frame {
    LAS unsigned char* lds;
    volatile LAS unsigned* MISC;
    gu32* ctl;
    GAS unsigned char* ws;
    int tid, lane, wave, vcu, G;
};
constexpr int PTAB_OFF = MISC_OFF + 128;
enum { I_X = 0, I_C, I_POS, I_LB, I_WIN, I_WOUT, I_WADA, I_BADA, I_LNG, I_LNB, I_HGNW, I_CONVW, I_CONVB, I_DTB, I_ALOG, I_MD, I_MNW, I_W1, I_W2, I_OUT };
__device__ __forceinline__ unsigned long long ptab_get(const Frame& F, int i) {
    const unsigned long long v = ((const volatile LAS unsigned long long*)(F.lds + PTAB_OFF))[i];
    const unsigned lo = __builtin_amdgcn_readfirstlane((unsigned)v), hi = __builtin_amdgcn_readfirstlane((unsigned)(v >> 32));
    return ((unsigned long long)hi << 32) | lo;
}
#define INF(i) ((const GAS float*)ptab_get(F, (i)))
#define WSF(off) ((GAS float*)((GAS unsigned char*)F.ws + (off)))
#define WSB(off) ((GAS bf16*)((GAS unsigned char*)F.ws + (off)))

__device__ __forceinline__ float wave_sum(float v) {
#pragma unroll
    for (int o = 1; o < 64; o <<= 1) v += __shfl_xor(v, o);
    return v;
}
__device__ __forceinline__ float grp16_sum(float v) {
#pragma unroll
    for (int o = 1; o < 16; o <<= 1) v += __shfl_xor(v, o);
    return v;
}

struct TItem { const GAS float* src; GAS bf16* dst; int K, N, k0, n0; };
__device__ __forceinline__ void t_load(const TItem& d, int lane, f32x4 (&v)[16]) {
    const int r4 = lane >> 4, c4 = lane & 15;
    const bool ok = (d.n0 + 4 * c4) < d.N;
    const GAS float* src = d.src + (size_t)(d.k0 + r4) * d.N + d.n0 + 4 * c4;
#pragma unroll
    for (int i = 0; i < 16; ++i) v[i] = ok ? *(const GAS f32x4*)(src + (size_t)(4 * i) * d.N) : (f32x4){0.f, 0.f, 0.f, 0.f};
}
__device__ __forceinline__ void t_emit(const TItem& d, int lane, LAS float* scr, const f32x4 (&v)[16]) {
    const int r4 = lane >> 4, c4 = lane & 15;
#pragma unroll
    for (int i = 0; i < 16; ++i) { LAS float* q = scr + (4 * i + r4) * 65 + 4 * c4; q[0] = v[i].x; q[1] = v[i].y; q[2] = v[i].z; q[3] = v[i].w; }
    LDS_WAIT(); asm volatile("" ::: "memory");
    const int c = lane & 7;
#pragma unroll
    for (int j = 0; j < 8; ++j) { const int n = (lane >> 3) + 8 * j; const LAS float* sp = scr + (8 * c) * 65 + n;
        v4u o; o.x = pk2(sp[0 * 65], sp[1 * 65]); o.y = pk2(sp[2 * 65], sp[3 * 65]); o.z = pk2(sp[4 * 65], sp[5 * 65]); o.w = pk2(sp[6 * 65], sp[7 * 65]);
        *(GAS v4u*)(d.dst + (size_t)(d.n0 + n) * d.K + d.k0 + 8 * c) = o; }
    LDS_WAIT(); asm volatile("" ::: "memory");
}
constexpr int NB_IN = NPROJ / 64, I_IN = (D / 64) * NB_IN, NB_O = D / 64, I_O = (D / 64) * NB_O, NB_1 = DFF / 64, I_1 = (D / 64) * NB_1, NB_2 = D / 64, I_2 = (DFF / 64) * NB_2;
constexpr int L0_ITEMS = I_IN + I_O, PER_L12 = I_1 + I_2;
constexpr int TAIL_KB = 32, TAIL_N = TAIL_KB * NB_IN;
constexpr bool TAIL_WOUT = true;
constexpr int REST_L = (I_IN - TAIL_N) + (TAIL_WOUT ? 0 : I_O);
__device__ __forceinline__ TItem get_item(Frame& F, int mode, int ln, int it) {
    TItem d; int l = ln, r = it, which;
    if (mode == 0) {
        if (it < L0_ITEMS) { l = 0; if (r < I_IN) which = 0; else { which = 1; r -= I_IN; } }
        else if (it < L0_ITEMS + DEPTH * PER_L12) { l = (it - L0_ITEMS) / PER_L12; r = (it - L0_ITEMS) % PER_L12; if (r < I_1) which = 2; else { which = 3; r -= I_1; } }
        else { const int q = it - (L0_ITEMS + DEPTH * PER_L12); constexpr int RL = REST_L > 0 ? REST_L : 1; l = 1 + q / RL; r = q % RL; if (r < I_IN - TAIL_N) { which = 0; r += TAIL_N; } else { which = 1; r -= I_IN - TAIL_N; } }
    } else { if (r < TAIL_N) which = 0; else { which = 1; r -= TAIL_N; } }
    int nblk;
    if (which == 0) { d.src = INF(I_WIN) + (size_t)l * D * IN_COLS; d.dst = WSB(WS_WIN) + (size_t)l * NPROJ * D; d.K = D; d.N = IN_COLS; nblk = NB_IN; }
    else if (which == 1) { d.src = INF(I_WOUT) + (size_t)l * D * D; d.dst = WSB(WS_WOUT) + (size_t)l * D * D; d.K = D; d.N = D; nblk = NB_O; }
    else if (which == 2) { d.src = INF(I_W1) + (size_t)l * D * DFF; d.dst = WSB(WS_W1) + (size_t)l * DFF * D; d.K = D; d.N = DFF; nblk = NB_1; }
    else { d.src = INF(I_W2) + (size_t)l * DFF * D; d.dst = WSB(WS_W2) + (size_t)l * D * DFF; d.K = DFF; d.N = D; nblk = NB_2; }
    d.k0 = 64 * (r / nblk); d.n0 = 64 * (r % nblk);
    return d;
}
__device__ __forceinline__ void run_items(Frame& F, int mode, int ln, int first, int stride, int total) {
    LAS float* scr = (LAS float*)(F.lds + RING_OFF + F.wave * 16640);
    for (int it = first; it < total; it += stride) { f32x4 va[16]; const TItem da = get_item(F, mode, ln, it); t_load(da, F.lane, va); t_emit(da, F.lane, scr, va); }
}

__device__ __forceinline__ void p0_prologue(Frame& F) {
    LAS float* condS = (LAS float*)(F.lds + RING_OFF);
    LAS float* red = (LAS float*)(F.lds + RING_OFF + 32768);
    for (int i = F.tid; i < BATCH * D; i += NWAVES * 64) condS[i] = siluf_(INF(I_C)[i]);
    __syncthreads();
    for (int it = blockIdx.x; it < DEPTH * 64; it += F.G) {
        const int l = it >> 6, col0 = (it & 63) * 192;
        f32x4 acc[4];
#pragma unroll
        for (int b = 0; b < 4; ++b) acc[b] = (f32x4){0.f, 0.f, 0.f, 0.f};
        if (F.lane < 48) {
            const GAS float* wp = INF(I_WADA) + ((size_t)l * D + F.wave * 256) * NADA + col0 + 4 * F.lane;
#pragma unroll 16
            for (int k = 0; k < 256; ++k) { const f32x4 wv = *(const GAS f32x4*)(wp + (size_t)k * NADA); const int kk = F.wave * 256 + k;
#pragma unroll
                for (int b = 0; b < 4; ++b) acc[b] += wv * condS[b * D + kk]; }
#pragma unroll
            for (int b = 0; b < 4; ++b) *(LAS f32x4*)(red + (F.wave * 4 + b) * 192 + 4 * F.lane) = acc[b];
        }
        __syncthreads();
        for (int o = F.tid; o < 4 * 192; o += NWAVES * 64) { const int b = o / 192, j = o % 192; float s = INF(I_BADA)[(size_t)l * NADA + col0 + j];
#pragma unroll
            for (int w = 0; w < 8; ++w) s += red[(w * 4 + b) * 192 + j];
            WSF(WS_ADA)[((size_t)l * BATCH + b) * NADA + col0 + j] = s; }
        __syncthreads();
    }
    if (blockIdx.x == 0) {
        for (int j = F.tid; j < 512; j += NWAVES * 64) { float v[DEPTH], mx = -1e30f;
#pragma unroll
            for (int l = 0; l < DEPTH; ++l) { v[l] = INF(I_LB)[l * 512 + j]; mx = fmaxf(mx, v[l]); }
            float s = 0.f;
#pragma unroll
            for (int l = 0; l < DEPTH; ++l) { v[l] = __expf(v[l] - mx); s += v[l]; }
            float cum = 0.f; const float inv = 1.0f / s;
#pragma unroll
            for (int l = 0; l < DEPTH; ++l) { if (l > 0) cum += v[l] * inv; WSF(WS_LBS)[l * 512 + j] = cum; } }
    }
    {
        const int gt = blockIdx.x * (NWAVES * 64) + F.tid, NT = F.G * NWAVES * 64;
        for (int i = gt; i < M * 64; i += NT) { const int d = i & 63, row = i >> 6;
            const float invf = 1.0f / exp2f(((float)d * (1.0f / 63.0f)) * 13.287712379549449f);
            const float ang = (float)((const GAS int*)ptab_get(F, I_POS))[row] * invf;
            const float kq = rintf(ang * 0.15915494309189535f);
            float r = fmaf(-kq, 6.2831854820251465f, ang); r = fmaf(-kq, -1.7484555e-7f, r);
            WSF(WS_COS)[i] = __cosf(r); WSF(WS_SIN)[i] = __sinf(r); }
    }
    __syncthreads();
    run_items(F, 0, 0, F.vcu * NWAVES + F.wave, F.G * NWAVES, L0_ITEMS + DEPTH * PER_L12 + (DEPTH - 1) * REST_L);
}
__device__ __forceinline__ void convert_next_in_out(Frame& F, int ln, int rank, int nidle) {
    run_items(F, 1, ln, rank * NWAVES + F.wave, nidle * NWAVES, TAIL_N + (TAIL_WOUT ? I_O : 0));
}

__device__ __forceinline__ void mod_rows(Frame& F, const GAS float* xin, const GAS float* ada_l, int sc_chunk, int sh_chunk) {
    const int gw = F.vcu * NWAVES + F.wave, NGW = F.G * NWAVES;
    for (int row = gw; row < M; row += NGW) {
        const int b = row >> 11; const GAS float* ab = ada_l + (size_t)b * NADA;
        const GAS f32x4* xr = (const GAS f32x4*)(xin + (size_t)row * D) + F.lane;
        GAS v2u* ho = (GAS v2u*)(WSB(WS_H) + (size_t)row * D) + F.lane;
#pragma unroll
        for (int j = 0; j < 8; ++j) { const int col = 4 * (F.lane + 64 * j); const f32x4 v = xr[64 * j];
            const f32x4 sc = *(const GAS f32x4*)(ab + sc_chunk * D + col), sh = *(const GAS f32x4*)(ab + sh_chunk * D + col);
            const f32x4 h = v * (sc + 1.0f) + sh; v2u w; w.x = pk2(h.x, h.y); w.y = pk2(h.z, h.w); ho[64 * j] = w; }
    }
}
__device__ __forceinline__ void ln_rows(Frame& F, const GAS bf16* tin, const GAS float* tin32  , const GAS float* g, const GAS float* bt, GAS float* xout, GAS float* stats, const GAS float* ada_l, int sc_chunk, int sh_chunk, bool write_h) {
    const int gw = F.vcu * NWAVES + F.wave, NGW = F.G * NWAVES;
    const int per = (M + NGW - 1) / NGW, r0 = gw * per, r1 = (r0 + per < M) ? r0 + per : M;
    if (r0 >= M) return;
    const GAS float* ab = ada_l + (size_t)(r0 >> 11) * NADA;
    f32x4 G[8], B[8];
#pragma unroll
    for (int k = 0; k < 8; ++k) { const int col = 8 * (F.lane + 64 * (k >> 1)) + 4 * (k & 1); G[k] = *(const GAS f32x4*)(g + col); B[k] = *(const GAS f32x4*)(bt + col);
        if (write_h) { const f32x4 sc = *(const GAS f32x4*)(ab + sc_chunk * D + col) + 1.0f, sh = *(const GAS f32x4*)(ab + sh_chunk * D + col); G[k] = G[k] * sc; B[k] = B[k] * sc + sh; } }
    for (int rowa = r0; rowa < r1; rowa += 2) {
        const int rowb = rowa + 1; const bool hasb = rowb < r1; const int rowb_ = hasb ? rowb : rowa;
        const GAS v4u* ta = (const GAS v4u*)(tin + (size_t)rowa * D) + F.lane; const GAS v4u* tb = (const GAS v4u*)(tin + (size_t)rowb_ * D) + F.lane;
        f32x4 va[8], vb[8]; float sa = 0.f, sb = 0.f;
        if (tin32) {
            const GAS f32x4* fa = (const GAS f32x4*)(tin32 + (size_t)rowa * D) + 2 * F.lane; const GAS f32x4* fb = (const GAS f32x4*)(tin32 + (size_t)rowb_ * D) + 2 * F.lane;
#pragma unroll
            for (int j = 0; j < 4; ++j) { va[2 * j] = fa[128 * j]; va[2 * j + 1] = fa[128 * j + 1]; vb[2 * j] = fb[128 * j]; vb[2 * j + 1] = fb[128 * j + 1]; }
        } else {
        v4u wa[4], wb[4];
#pragma unroll
        for (int j = 0; j < 4; ++j) { wa[j] = ta[64 * j]; wb[j] = tb[64 * j]; }
#pragma unroll
        for (int j = 0; j < 4; ++j) {
            va[2 * j] = (f32x4){bflo(wa[j].x), bfhi(wa[j].x), bflo(wa[j].y), bfhi(wa[j].y)}; va[2 * j + 1] = (f32x4){bflo(wa[j].z), bfhi(wa[j].z), bflo(wa[j].w), bfhi(wa[j].w)};
            vb[2 * j] = (f32x4){bflo(wb[j].x), bfhi(wb[j].x), bflo(wb[j].y), bfhi(wb[j].y)}; vb[2 * j + 1] = (f32x4){bflo(wb[j].z), bfhi(wb[j].z), bflo(wb[j].w), bfhi(wb[j].w)}; }
        }
#pragma unroll
        for (int j = 0; j < 8; ++j) { sa += (va[j].x + va[j].y) + (va[j].z + va[j].w); sb += (vb[j].x + vb[j].y) + (vb[j].z + vb[j].w); }
        const float ma = wave_sum(sa) * (1.f / D), mb = wave_sum(sb) * (1.f / D); float qa = 0.f, qb = 0.f;
#pragma unroll
        for (int j = 0; j < 8; ++j) { va[j] = va[j] - ma; vb[j] = vb[j] - mb; qa += (va[j].x * va[j].x + va[j].y * va[j].y) + (va[j].z * va[j].z + va[j].w * va[j].w); qb += (vb[j].x * vb[j].x + vb[j].y * vb[j].y) + (vb[j].z * vb[j].z + vb[j].w * vb[j].w); }
        const float ra = 1.f / sqrtf(wave_sum(qa) * (1.f / D) + LN_EPS), rb = 1.f / sqrtf(wave_sum(qb) * (1.f / D) + LN_EPS);
        if (F.lane == 0) { *(GAS f32x2*)(stats + 2 * (size_t)rowa) = (f32x2){ma, ra}; if (hasb) *(GAS f32x2*)(stats + 2 * (size_t)rowb) = (f32x2){mb, rb}; }
#pragma unroll
        for (int half = 0; half < 2; ++half) {
            if (half == 1 && !hasb) break;
            const int row = half ? rowb : rowa; const float rstd = half ? rb : ra;
            GAS f32x4* xo = (GAS f32x4*)(xout + (size_t)row * D) + 2 * F.lane;
            GAS v4u* ho = (GAS v4u*)(WSB(WS_H) + (size_t)row * D) + F.lane;
#pragma unroll
            for (int j = 0; j < 4; ++j) { const f32x4 x0 = (half ? vb[2 * j] : va[2 * j]) * rstd * G[2 * j] + B[2 * j], x1 = (half ? vb[2 * j + 1] : va[2 * j + 1]) * rstd * G[2 * j + 1] + B[2 * j + 1];
                if (write_h) { v4u w; w.x = pk2(x0.x, x0.y); w.y = pk2(x0.z, x0.w); w.z = pk2(x1.x, x1.y); w.w = pk2(x1.z, x1.w); ho[64 * j] = w; }
                else { xo[128 * j] = x0; xo[128 * j + 1] = x1; } }
        }
    }
}

typedef short bf16x8 __attribute__((ext_vector_type(8)));
typedef short s16x4 __attribute__((ext_vector_type(4)));
typedef float f32x16 __attribute__((ext_vector_type(16)));
typedef __bf16 bf16x2_t __attribute__((ext_vector_type(2)));
constexpr int TS = 272;
constexpr int XS = 528;
constexpr size_t WS_QI = 864 * MiB, WS_SLR = 884 * MiB, WS_SLH = 892 * MiB, WS_SLM = 908 * MiB, WS_DECH = 924 * MiB, WS_RS = 925 * MiB, WS_CD = 926 * MiB;
constexpr int QIW = 1280;
#define MFMA32(a, b, c) __builtin_amdgcn_mfma_f32_32x32x16_bf16((a), (b), (c), 0, 0, 0)
__device__ __forceinline__ unsigned pkf(float lo, float hi) { f32x2 v = {lo, hi}; bf16x2_t b = __builtin_convertvector(v, bf16x2_t); return __builtin_bit_cast(unsigned, b); }
__device__ __forceinline__ unsigned short bf1(float x) { return (unsigned short)(pkf(x, 0.f) & 0xffffu); }
__device__ __forceinline__ void unpack8(const v4u w, float* f) { f[0] = bflo(w.x); f[1] = bfhi(w.x); f[2] = bflo(w.y); f[3] = bfhi(w.y); f[4] = bflo(w.z); f[5] = bfhi(w.z); f[6] = bflo(w.w); f[7] = bfhi(w.w); }
__device__ __forceinline__ v4u pack8(const float* f) { v4u w; w.x = pkf(f[0], f[1]); w.y = pkf(f[2], f[3]); w.z = pkf(f[4], f[5]); w.w = pkf(f[6], f[7]); return w; }
__device__ __forceinline__ int crow(int r, int hi) { return (r & 3) + 8 * (r >> 2) + 4 * hi; }
__device__ __forceinline__ bf16x8 frag_row(LAS const unsigned char* T, int stride, int r0, int k0, int lane) {
    return *(const LAS bf16x8*)(T + (r0 + (lane & 31)) * stride + (k0 + 8 * (lane >> 5)) * 2);
}
__device__ __forceinline__ bf16x8 frag_tr(LAS const unsigned char* T, int stride, int k0, int c0, int lane) {
    const int h = lane >> 5, blk = (lane >> 4) & 1, q = (lane & 15) >> 2, p = lane & 3;
    LAS unsigned char* a = (LAS unsigned char*)T + (k0 + 8 * h + q) * stride + (c0 + 16 * blk + 4 * p) * 2;
    const s16x4 lo = __builtin_amdgcn_ds_read_tr16_b64_v4i16((LAS s16x4*)a), hi = __builtin_amdgcn_ds_read_tr16_b64_v4i16((LAS s16x4*)(a + 4 * stride));
    return (bf16x8){lo[0], lo[1], lo[2], lo[3], hi[0], hi[1], hi[2], hi[3]};
}
__device__ __forceinline__ f32x16 zero16() { f32x16 z; for (int i = 0; i < 16; ++i) z[i] = 0.f; return z; }

__device__ __forceinline__ void st_acc4(GAS bf16* base, const f32x16& a) {
#pragma unroll
    for (int g = 0; g < 4; ++g) { v2u w; w.x = pkf(a[4 * g], a[4 * g + 1]); w.y = pkf(a[4 * g + 2], a[4 * g + 3]); *(GAS v2u*)(base + 8 * g) = w; }
}

__device__ __forceinline__ void pre_ret_unit(Frame& F, int u) {
    const int c = u & 15, h = (u >> 4) & 3, b = u >> 6;
    const int tid = F.tid, lane = F.lane, w = F.wave;
    LAS unsigned char* Qs = F.lds + RING_OFF; LAS unsigned char* Ks = Qs + 34816; LAS unsigned char* Vs = Ks + 34816;
    const size_t row0 = (size_t)b * SEQ + c * 128;
    const float gam = 1.0f - exp2f(-5.0f - (float)h), l2g = log2f(gam);
    {
        const int i = tid >> 2, s = tid & 3; const size_t row = row0 + i;
        const GAS bf16* pr = WSB(WS_PROJ) + row * NPROJ;
        const GAS float* cs = WSF(WS_COS) + row * 64 + 16 * s; const GAS float* sn = WSF(WS_SIN) + row * 64 + 16 * s;
        float cv[16], sv[16];
#pragma unroll
        for (int e = 0; e < 4; ++e) { const f32x4 a = *(const GAS f32x4*)(cs + 4 * e), d = *(const GAS f32x4*)(sn + 4 * e);
            cv[4 * e] = a.x; cv[4 * e + 1] = a.y; cv[4 * e + 2] = a.z; cv[4 * e + 3] = a.w; sv[4 * e] = d.x; sv[4 * e + 1] = d.y; sv[4 * e + 2] = d.z; sv[4 * e + 3] = d.w; }
#pragma unroll
        for (int t = 0; t < 2; ++t) {
            const GAS bf16* src = pr + (t ? C_RK : C_RQ) + h * 128 + 16 * s;
            float x1[16], x2[16], o1[16], o2[16];
            unpack8(*(const GAS v4u*)(src), x1); unpack8(*(const GAS v4u*)(src + 8), x1 + 8); unpack8(*(const GAS v4u*)(src + 64), x2); unpack8(*(const GAS v4u*)(src + 72), x2 + 8);
            const float sc = t ? 0.08838834764831845f : 1.0f;
#pragma unroll
            for (int e = 0; e < 16; ++e) { o1[e] = (x1[e] * cv[e] - x2[e] * sv[e]) * sc; o2[e] = (x1[e] * sv[e] + x2[e] * cv[e]) * sc; }
            LAS unsigned char* dst = (t ? Ks : Qs) + i * TS + 32 * s;
            const v4u a0 = pack8(o1), a1 = pack8(o1 + 8), b0 = pack8(o2), b1 = pack8(o2 + 8);
            *(LAS v4u*)(dst) = a0; *(LAS v4u*)(dst + 16) = a1; *(LAS v4u*)(dst + 128) = b0; *(LAS v4u*)(dst + 144) = b1;
            if (t == 0) { GAS bf16* qd = WSB(WS_QI) + row * QIW + h * 128 + 16 * s; *(GAS v4u*)(qd) = a0; *(GAS v4u*)(qd + 8) = a1; *(GAS v4u*)(qd + 64) = b0; *(GAS v4u*)(qd + 72) = b1; }
        }
        const GAS bf16* vsrc = pr + C_RV + h * 128 + 32 * s; LAS unsigned char* vd = Vs + i * TS + 64 * s;
#pragma unroll
        for (int e = 0; e < 4; ++e) *(LAS v4u*)(vd + 16 * e) = *(const GAS v4u*)(vsrc + 8 * e);
    }
    __syncthreads();
    const int rb = w >> 1, cb0 = (w & 1) * 2;
    f32x16 acc0 = zero16(), acc1 = zero16();
    if (cb0 <= rb) {
#pragma unroll
        for (int kk = 0; kk < 8; ++kk) { const bf16x8 a = frag_row(Qs, TS, rb * 32, 16 * kk, lane);
            acc0 = MFMA32(a, frag_row(Ks, TS, cb0 * 32, 16 * kk, lane), acc0);
            if (cb0 + 1 <= rb) acc1 = MFMA32(a, frag_row(Ks, TS, cb0 * 32 + 32, 16 * kk, lane), acc1); }
    }
    __syncthreads();
#pragma unroll
    for (int t = 0; t < 2; ++t) { const int cb = cb0 + t, j = cb * 32 + (lane & 31);
#pragma unroll
        for (int r = 0; r < 16; ++r) { const int i = rb * 32 + crow(r, lane >> 5); const float a = t ? acc1[r] : acc0[r];
            const float v = (cb <= rb && i >= j) ? a * exp2f((float)(i - j) * l2g) : 0.f;
            *(LAS unsigned short*)(Qs + i * TS + 2 * j) = bf1(v); } }
    {
        const int i = tid >> 2, s = tid & 3; const float f = exp2f((float)(127 - i) * l2g); LAS unsigned char* kp = Ks + i * TS + 64 * s;
#pragma unroll
        for (int e = 0; e < 4; ++e) { float x[8]; unpack8(*(LAS v4u*)(kp + 16 * e), x);
#pragma unroll
            for (int q = 0; q < 8; ++q) x[q] *= f;
            *(LAS v4u*)(kp + 16 * e) = pack8(x); }
    }
    __syncthreads();
    {
        const int pb0 = (w & 1) * 2; acc0 = zero16(); acc1 = zero16();
        for (int kk = 0; kk < 2 * (rb + 1); ++kk) { const bf16x8 a = frag_row(Qs, TS, rb * 32, 16 * kk, lane);
            acc0 = MFMA32(frag_tr(Vs, TS, 16 * kk, pb0 * 32, lane), a, acc0); acc1 = MFMA32(frag_tr(Vs, TS, 16 * kk, pb0 * 32 + 32, lane), a, acc1); }
        GAS bf16* yb = WSB(WS_Y) + (row0 + rb * 32 + (lane & 31)) * 2048 + h * 128 + pb0 * 32 + 4 * (lane >> 5);
        st_acc4(yb, acc0); st_acc4(yb + 32, acc1);
    }
    {
        const int pb = w >> 1, nb0 = (w & 1) * 2; acc0 = zero16(); acc1 = zero16();
#pragma unroll
        for (int kk = 0; kk < 8; ++kk) { const bf16x8 a = frag_tr(Vs, TS, 16 * kk, pb * 32, lane);
            acc0 = MFMA32(frag_tr(Ks, TS, 16 * kk, nb0 * 32, lane), a, acc0); acc1 = MFMA32(frag_tr(Ks, TS, 16 * kk, nb0 * 32 + 32, lane), a, acc1); }
        GAS bf16* sb = WSB(WS_SLR) + (size_t)u * 16384 + (pb * 32 + (lane & 31)) * 128 + nb0 * 32 + 4 * (lane >> 5);
        st_acc4(sb, acc0); st_acc4(sb + 32, acc1);
    }
    __syncthreads();
}

__device__ __forceinline__ void pre_hg_unit(Frame& F, int l, int u) {
    const int c = u & 31, h = (u >> 5) & 3, b = u >> 7;
    const int tid = F.tid, lane = F.lane, w = F.wave;
    LAS float* CUM = (LAS float*)(F.lds + RING_OFF);
    LAS unsigned char* Qm = F.lds + RING_OFF + 33792; LAS unsigned char* Km = Qm + 17408; LAS unsigned char* Kes = Km + 17408; LAS unsigned char* Vs = Kes + 17408;
    LAS unsigned char* Ps = Vs + 17408;
    LAS float* PT = (LAS float*)(Ps + 9216);
    const size_t row0 = (size_t)b * SEQ + c * 64;
    const int j = tid >> 3, s = tid & 7, d0 = 16 * s; const size_t row = row0 + j;
    const GAS bf16* pr = WSB(WS_PROJ) + row * NPROJ;
    float q[16], k[16];
    {
        float fr[16], lb[16];
        unpack8(*(const GAS v4u*)(pr + C_HQ + h * 128 + d0), q); unpack8(*(const GAS v4u*)(pr + C_HQ + h * 128 + d0 + 8), q + 8);
        unpack8(*(const GAS v4u*)(pr + C_HF + h * 128 + d0), fr); unpack8(*(const GAS v4u*)(pr + C_HF + h * 128 + d0 + 8), fr + 8);
        const GAS float* lbp = WSF(WS_LBS) + l * 512 + h * 128 + d0;
#pragma unroll
        for (int e = 0; e < 4; ++e) { const f32x4 a = *(const GAS f32x4*)(lbp + 4 * e); lb[4 * e] = a.x; lb[4 * e + 1] = a.y; lb[4 * e + 2] = a.z; lb[4 * e + 3] = a.w; }
        float lf[16];
#pragma unroll
        for (int e = 0; e < 16; ++e) { const float sg = sigmoidf_(fr[e]); const float f = lb[e] + (1.f - lb[e]) * sg; k[e] = (1.f - lb[e]) * (1.f - sg); lf[e] = __logf(f); }
#pragma unroll
        for (int e = 0; e < 4; ++e) *(LAS f32x4*)(CUM + j * 132 + d0 + 4 * e) = (f32x4){lf[4 * e], lf[4 * e + 1], lf[4 * e + 2], lf[4 * e + 3]};
        const GAS bf16* vsrc = pr + C_HI + h * 128 + d0; *(LAS v4u*)(Vs + j * TS + 2 * d0) = *(const GAS v4u*)(vsrc); *(LAS v4u*)(Vs + j * TS + 2 * d0 + 16) = *(const GAS v4u*)(vsrc + 8);
    }
    __syncthreads();
    {
        const int d = tid & 127, qd = tid >> 7; float loc[16], run = 0.f;
#pragma unroll
        for (int jj = 0; jj < 16; ++jj) { run += CUM[(16 * qd + jj) * 132 + d]; loc[jj] = run; }
        PT[qd * 128 + d] = run;
        __syncthreads();
        float off = 0.f;
#pragma unroll
        for (int qq = 0; qq < 3; ++qq) off += (qq < qd) ? PT[qq * 128 + d] : 0.f;
#pragma unroll
        for (int jj = 0; jj < 16; ++jj) CUM[(16 * qd + jj) * 132 + d] = loc[jj] + off;
    }
    __syncthreads();
    {
        float cum[16], mid[16], tot[16];
#pragma unroll
        for (int e = 0; e < 4; ++e) { const f32x4 a = *(const LAS f32x4*)(CUM + j * 132 + d0 + 4 * e), m4 = *(const LAS f32x4*)(CUM + 31 * 132 + d0 + 4 * e), t4 = *(const LAS f32x4*)(CUM + 63 * 132 + d0 + 4 * e);
            cum[4 * e] = a.x; cum[4 * e + 1] = a.y; cum[4 * e + 2] = a.z; cum[4 * e + 3] = a.w; mid[4 * e] = m4.x; mid[4 * e + 1] = m4.y; mid[4 * e + 2] = m4.z; mid[4 * e + 3] = m4.w;
            tot[4 * e] = t4.x; tot[4 * e + 1] = t4.y; tot[4 * e + 2] = t4.z; tot[4 * e + 3] = t4.w; }
        float qm[16], km[16], q2[16], ke[16];
#pragma unroll
        for (int e = 0; e < 16; ++e) { qm[e] = q[e] * __expf(fminf(cum[e] - mid[e], 80.f)); km[e] = k[e] * __expf(fminf(mid[e] - cum[e], 80.f)); q2[e] = q[e] * __expf(cum[e]); ke[e] = k[e] * __expf(tot[e] - cum[e]); }
        *(LAS v4u*)(Qm + j * TS + 2 * d0) = pack8(qm); *(LAS v4u*)(Qm + j * TS + 2 * d0 + 16) = pack8(qm + 8);
        *(LAS v4u*)(Km + j * TS + 2 * d0) = pack8(km); *(LAS v4u*)(Km + j * TS + 2 * d0 + 16) = pack8(km + 8);
        *(LAS v4u*)(Kes + j * TS + 2 * d0) = pack8(ke); *(LAS v4u*)(Kes + j * TS + 2 * d0 + 16) = pack8(ke + 8);
        GAS bf16* qd = WSB(WS_QI) + row * QIW + 512 + h * 128 + d0; *(GAS v4u*)(qd) = pack8(q2); *(GAS v4u*)(qd + 8) = pack8(q2 + 8);
        if (j == 0) { GAS float* dp = WSF(WS_DECH) + (size_t)u * 128 + d0;
#pragma unroll
            for (int e = 0; e < 4; ++e) *(GAS f32x4*)(dp + 4 * e) = (f32x4){__expf(tot[4 * e]), __expf(tot[4 * e + 1]), __expf(tot[4 * e + 2]), __expf(tot[4 * e + 3])}; }
    }
    __syncthreads();
    if (w < 4) {
        const int rb = w >> 1, cb = w & 1; f32x16 acc = zero16();
        if (cb <= rb) {
#pragma unroll
            for (int kk = 0; kk < 8; ++kk) acc = MFMA32(frag_row(Qm, TS, rb * 32, 16 * kk, lane), frag_row(Km, TS, cb * 32, 16 * kk, lane), acc);
        }
        const int jj = cb * 32 + (lane & 31);
#pragma unroll
        for (int r = 0; r < 16; ++r) { const int i = rb * 32 + crow(r, lane >> 5); *(LAS unsigned short*)(Ps + i * 144 + 2 * jj) = bf1((cb <= rb && i >= jj) ? acc[r] : 0.f); }
    }
    {
        const int vb = w >> 1, db0 = (w & 1) * 2; f32x16 acc0 = zero16(), acc1 = zero16();
#pragma unroll
        for (int kk = 0; kk < 4; ++kk) { const bf16x8 a = frag_tr(Vs, TS, 16 * kk, vb * 32, lane);
            acc0 = MFMA32(frag_tr(Kes, TS, 16 * kk, db0 * 32, lane), a, acc0); acc1 = MFMA32(frag_tr(Kes, TS, 16 * kk, db0 * 32 + 32, lane), a, acc1); }
        GAS bf16* sb = WSB(WS_SLH) + (size_t)u * 16384 + (vb * 32 + (lane & 31)) * 128 + db0 * 32 + 4 * (lane >> 5);
        st_acc4(sb, acc0); st_acc4(sb + 32, acc1);
    }
    __syncthreads();
    {
        const int rb = w >> 2, vb = w & 3; f32x16 acc = zero16();
        for (int kk = 0; kk < 2 * (rb + 1); ++kk) acc = MFMA32(frag_tr(Vs, TS, 16 * kk, vb * 32, lane), frag_row(Ps, 144, rb * 32, 16 * kk, lane), acc);
        st_acc4(WSB(WS_Y) + (row0 + rb * 32 + (lane & 31)) * 2048 + 512 + h * 128 + vb * 32 + 4 * (lane >> 5), acc);
    }
    __syncthreads();
}

__device__ __forceinline__ float softplus2_(float x) { return fmaxf(x, 0.f) + log1pf(__expf(-fabsf(x))); }
__device__ __forceinline__ void pre_mamba_unit(Frame& F, int l, int u) {
    const int half = u & 1, c = (u >> 1) & 15, g = (u >> 5) & 1, b = u >> 6, head0 = g * 8 + half * 4;
    const int tid = F.tid, lane = F.lane, w = F.wave;
    LAS unsigned char* Cs = F.lds + RING_OFF; LAS unsigned char* Bs = Cs + 34816; LAS unsigned char* Xs = Bs + 34816;
    LAS float* dtS = (LAS float*)(Xs + 67584); LAS float* cumS = dtS + 512; LAS float* wS = cumS + 512; LAS float* tot0 = wS + 512;
    const size_t row0 = (size_t)b * SEQ + c * 128;
    const int v4 = tid & 127, tg = tid >> 7;
    const int cch = (v4 < 32) ? 1024 + g * 128 + 4 * v4 : (v4 < 64) ? 1280 + g * 128 + 4 * (v4 - 32) : head0 * 64 + 4 * (v4 - 64);
    const GAS float* cw = INF(I_CONVW) + (size_t)l * 4 * MCONV + cch;
    const f32x4 w0 = *(const GAS f32x4*)(cw), w1 = *(const GAS f32x4*)(cw + MCONV), w2 = *(const GAS f32x4*)(cw + 2 * MCONV), w3 = *(const GAS f32x4*)(cw + 3 * MCONV), bias = *(const GAS f32x4*)(INF(I_CONVB) + (size_t)l * MCONV + cch);
    const GAS bf16* srcu = WSB(WS_PROJ) + ((ptrdiff_t)row0 - 3) * NPROJ + C_MX;
    const unsigned off0 = (unsigned)(tg * 32) * NPROJ + (unsigned)cch;
    const int tq0 = c * 128 + tg * 32;
    v2u raw[19];
#pragma unroll
    for (int q = 0; q < 3; ++q) raw[q] = (tq0 >= 3) ? *(const GAS v2u*)(srcu + (off0 + (unsigned)q * NPROJ)) : (v2u){0u, 0u};
#pragma unroll
    for (int tt = 0; tt < 16; ++tt) raw[3 + tt] = *(const GAS v2u*)(srcu + (off0 + (unsigned)(3 + tt) * NPROJ));
    float dskv[4];
#pragma unroll
    for (int hl = 0; hl < 4; ++hl) dskv[hl] = INF(I_MD)[l * 16 + head0 + hl];
    {
        const int hl = tid >> 7, j = tid & 127, head = head0 + hl;
        const float dt = softplus2_(WSF(WS_DTRAW)[(row0 + j) * 16 + head] + INF(I_DTB)[l * 16 + head]);
        float v = -__expf(INF(I_ALOG)[l * 16 + head]) * dt;
#pragma unroll
        for (int o = 1; o < 64; o <<= 1) { const float t = __shfl_up(v, o); if (lane >= o) v += t; }
        dtS[hl * 128 + j] = dt;
        if ((w & 1) == 0 && lane == 63) tot0[hl] = v;
        __syncthreads();
        if (w & 1) v += tot0[hl];
        cumS[hl * 128 + j] = v;
        __syncthreads();
        const float last = cumS[hl * 128 + 127];
        wS[hl * 128 + j] = __expf(last - v) * dt;
        WSF(WS_RS)[((size_t)b * 16 + head) * SEQ + c * 128 + j] = __expf(v);
        if (j == 127) WSF(WS_CD)[((size_t)b * 16 + head) * 16 + c] = __expf(v);
    }
    {
        GAS bf16* qiu = WSB(WS_QI) + row0 * QIW + 1024 + g * 128; const unsigned qoff0 = (unsigned)(tg * 32) * QIW + (unsigned)(4 * ((v4 - 32) & 31));
        LAS unsigned char* dst = (v4 < 32) ? Bs + 8 * v4 : (v4 < 64) ? Cs + 8 * (v4 - 32) : Xs + 8 * (v4 - 64);
        const int dstride = (v4 < 64) ? TS : XS;
        f32x4 x3 = (f32x4){bflo(raw[0].x), bfhi(raw[0].x), bflo(raw[0].y), bfhi(raw[0].y)}, x2 = (f32x4){bflo(raw[1].x), bfhi(raw[1].x), bflo(raw[1].y), bfhi(raw[1].y)}, x1 = (f32x4){bflo(raw[2].x), bfhi(raw[2].x), bflo(raw[2].y), bfhi(raw[2].y)};
#pragma unroll 1
        for (int hf = 0; hf < 2; ++hf) {
            if (hf == 1) {
#pragma unroll
                for (int tt = 0; tt < 16; ++tt) raw[3 + tt] = *(const GAS v2u*)(srcu + (off0 + (unsigned)(19 + tt) * NPROJ)); }
#pragma unroll
            for (int tt = 0; tt < 16; ++tt) { const int jj = tg * 32 + hf * 16 + tt;
                const f32x4 x0 = (f32x4){bflo(raw[3 + tt].x), bfhi(raw[3 + tt].x), bflo(raw[3 + tt].y), bfhi(raw[3 + tt].y)};
                const f32x4 a = bias + w0 * x3 + w1 * x2 + w2 * x1 + w3 * x0;
                v2u pk; pk.x = pkf(siluf_(a.x), siluf_(a.y)); pk.y = pkf(siluf_(a.z), siluf_(a.w));
                x3 = x2; x2 = x1; x1 = x0;
                *(LAS v2u*)(dst + jj * dstride) = pk;
                if (half == 0 && v4 >= 32 && v4 < 64) *(GAS v2u*)(qiu + (qoff0 + (unsigned)(hf * 16 + tt) * QIW)) = pk; }
        }
    }
    __syncthreads();
    const int rb = w >> 1, cb0 = (w & 1) * 2;
    f32x16 cbA = zero16(), cbB = zero16();
    if (cb0 <= rb) {
#pragma unroll
        for (int kk = 0; kk < 8; ++kk) { const bf16x8 a = frag_row(Cs, TS, rb * 32, 16 * kk, lane);
            cbA = MFMA32(a, frag_row(Bs, TS, cb0 * 32, 16 * kk, lane), cbA);
            if (cb0 + 1 <= rb) cbB = MFMA32(a, frag_row(Bs, TS, cb0 * 32 + 32, 16 * kk, lane), cbB); }
    }
    __syncthreads();
    for (int hl = 0; hl < 4; ++hl) {
        const int head = head0 + hl; const float dsk = (hl == 0) ? dskv[0] : (hl == 1) ? dskv[1] : (hl == 2) ? dskv[2] : dskv[3];
#pragma unroll
        for (int t = 0; t < 2; ++t) { const int cb = cb0 + t, j = cb * 32 + (lane & 31); const float cj = cumS[hl * 128 + j], dj = dtS[hl * 128 + j];
#pragma unroll
            for (int r = 0; r < 16; ++r) { const int i = rb * 32 + crow(r, lane >> 5); const float a = t ? cbB[r] : cbA[r];
                float v = (cb <= rb && i >= j) ? a * __expf(cumS[hl * 128 + i] - cj) * dj : 0.f; if (i == j) v += dsk;
                *(LAS unsigned short*)(Cs + i * TS + 2 * j) = bf1(v); } }
        __syncthreads();
        {
            const int pb = w & 1; f32x16 acc = zero16();
            for (int kk = 0; kk < 2 * (rb + 1); ++kk) acc = MFMA32(frag_tr(Xs, XS, 16 * kk, hl * 64 + pb * 32, lane), frag_row(Cs, TS, rb * 32, 16 * kk, lane), acc);
            st_acc4(WSB(WS_Y) + (row0 + rb * 32 + (lane & 31)) * 2048 + 1024 + head * 64 + pb * 32 + 4 * (lane >> 5), acc);
        }
        {
            const int pb = w >> 2, nb = w & 3; f32x16 acc = zero16();
#pragma unroll
            for (int kk = 0; kk < 8; ++kk) { const bf16x8 a = frag_tr(Xs, XS, 16 * kk, hl * 64 + pb * 32, lane);
                const LAS float* wp = wS + hl * 128 + 16 * kk + 8 * (lane >> 5); const f32x4 w0 = *(const LAS f32x4*)wp, w1 = *(const LAS f32x4*)(wp + 4);
                float x[8]; const v4u aw = __builtin_bit_cast(v4u, a); unpack8(aw, x);
                x[0] *= w0.x; x[1] *= w0.y; x[2] *= w0.z; x[3] *= w0.w; x[4] *= w1.x; x[5] *= w1.y; x[6] *= w1.z; x[7] *= w1.w;
                const v4u sw = pack8(x);
                acc = MFMA32(frag_tr(Bs, TS, 16 * kk, nb * 32, lane), __builtin_bit_cast(bf16x8, sw), acc); }
            st_acc4(WSB(WS_SLM) + (((size_t)b * 16 + head) * 16 + c) * 8192 + (pb * 32 + (lane & 31)) * 128 + nb * 32 + 4 * (lane >> 5), acc);
        }
        __syncthreads();
    }
}
__device__ __forceinline__ void mixer_pre(Frame& F, int l, int flags) {
    if (flags == 0 || (flags & 1)) for (int u = blockIdx.x; u < 256; u += F.G) pre_mamba_unit(F, l, u);
    if (flags == 0 || (flags & 2)) for (int u = blockIdx.x; u < 256; u += F.G) pre_ret_unit(F, u);
    if (flags == 0 || (flags & 4)) for (int u = blockIdx.x; u < 512; u += F.G) pre_hg_unit(F, l, u);
}

struct LTile { v4u q[8]; v4u y[2]; float rs; };
constexpr int YP = 80;
template <int MODE> __device__ __forceinline__ void lp_fetch(LTile& T, const GAS bf16* qrow, const GAS bf16* yrow, const GAS float* rsb, size_t rowb, int lane) {
#pragma unroll
    for (int k = 0; k < 8; ++k) T.q[k] = *(const GAS v4u*)(qrow + (size_t)(4 * k + (lane >> 4)) * QIW + 8 * (lane & 15));
#pragma unroll
    for (int k = 0; k < 2; ++k) T.y[k] = *(const GAS v4u*)(yrow + (size_t)(16 * k + (lane >> 2)) * 2048 + 8 * (lane & 3));
    if (MODE == 2) T.rs = rsb[rowb + (lane & 31)];
}
template <int MODE> __device__ __forceinline__ void loop_unit(Frame& F, int uu) {
    constexpr int NC = (MODE == 1) ? 32 : 16, CL = (MODE == 1) ? 64 : 128, PW = (MODE == 2) ? 64 : 128, RB = CL / 32, PC = 8;
    const int tid = F.tid, lane = F.lane, w = F.wave, hi = lane >> 5, li = lane & 31;
    int ps, hd, b;
    if (MODE == 2) { ps = uu & 1; hd = (uu >> 1) & 15; b = uu >> 5; } else { ps = uu & 3; hd = (uu >> 2) & 3; b = uu >> 4; }
    const int bh = (MODE == 2) ? b * 16 + hd : b * 4 + hd, p0 = ps * 32;
    const GAS bf16* SL = (MODE == 0) ? WSB(WS_SLR) : (MODE == 1) ? WSB(WS_SLH) : WSB(WS_SLM);
    const int qcol = (MODE == 0) ? hd * 128 : (MODE == 1) ? 512 + hd * 128 : 1024 + (hd >> 3) * 128;
    const int ycol = (MODE == 0) ? hd * 128 + p0 : (MODE == 1) ? 512 + hd * 128 + p0 : 1024 + hd * 64 + p0;
    const float gam = 1.0f - exp2f(-5.0f - (float)hd), l2g = log2f(gam), g128 = exp2f(128.f * l2g);
    LAS unsigned char* SP = F.lds + RING_OFF;
    LAS unsigned char* Qst = SP + PC * 8704 + w * 8704;
    LAS unsigned char* Yst = SP + 2 * PC * 8704 + w * (32 * YP);
    const int p = tid >> 4, n8 = tid & 15;
    const GAS float* rsb = WSF(WS_RS) + (size_t)bh * SEQ - (size_t)b * SEQ;
    float S[8];
#pragma unroll
    for (int e = 0; e < 8; ++e) S[e] = 0.f;
    for (int pass = 0; pass < NC / PC; ++pass) {
        {
            v4u lw[8]; f32x4 dv[8][2]; float dsc[8];
#pragma unroll
            for (int cl = 0; cl < 8; ++cl) { const int c = pass * PC + cl;
                lw[cl] = *(const GAS v4u*)(SL + ((size_t)(bh * NC + c) * PW + p0 + p) * 128 + 8 * n8);
                if (MODE == 1) { const GAS float* dp = WSF(WS_DECH) + (size_t)(bh * NC + c) * 128 + 8 * n8; dv[cl][0] = *(const GAS f32x4*)dp; dv[cl][1] = *(const GAS f32x4*)(dp + 4); }
                if (MODE == 2) dsc[cl] = WSF(WS_CD)[bh * 16 + c]; }
#pragma unroll
            for (int cl = 0; cl < 8; ++cl) {
                *(LAS v4u*)(SP + cl * 8704 + p * TS + 16 * n8) = pack8(S);
                float loc[8]; unpack8(lw[cl], loc);
                if (MODE == 1) { S[0] = S[0] * dv[cl][0].x + loc[0]; S[1] = S[1] * dv[cl][0].y + loc[1]; S[2] = S[2] * dv[cl][0].z + loc[2]; S[3] = S[3] * dv[cl][0].w + loc[3];
                    S[4] = S[4] * dv[cl][1].x + loc[4]; S[5] = S[5] * dv[cl][1].y + loc[5]; S[6] = S[6] * dv[cl][1].z + loc[6]; S[7] = S[7] * dv[cl][1].w + loc[7]; }
                else { const float dec = (MODE == 0) ? g128 : dsc[cl];
#pragma unroll
                    for (int e = 0; e < 8; ++e) S[e] = S[e] * dec + loc[e]; } }
        }
        __syncthreads();
        {
            const int c = pass * PC + w;
            const size_t rowc = (size_t)b * SEQ + (size_t)c * CL;
            const GAS bf16* qb = WSB(WS_QI) + rowc * QIW + qcol; GAS bf16* yb = WSB(WS_Y) + rowc * 2048 + ycol;
            LTile T0, T1;
            lp_fetch<MODE>(T0, qb, yb, rsb, rowc, lane);
#pragma unroll
            for (int rb = 0; rb < RB; ++rb) {
                if (rb + 1 < RB) { if (rb & 1) lp_fetch<MODE>(T0, qb + (size_t)(rb + 1) * 32 * QIW, yb + (size_t)(rb + 1) * 32 * 2048, rsb, rowc + (rb + 1) * 32, lane);
                                   else lp_fetch<MODE>(T1, qb + (size_t)(rb + 1) * 32 * QIW, yb + (size_t)(rb + 1) * 32 * 2048, rsb, rowc + (rb + 1) * 32, lane); }
                asm volatile("" ::: "memory");
#pragma unroll
                for (int k = 0; k < 8; ++k) *(LAS v4u*)(Qst + (4 * k + (lane >> 4)) * TS + 16 * (lane & 15)) = (rb & 1) ? T1.q[k] : T0.q[k];
#pragma unroll
                for (int k = 0; k < 2; ++k) *(LAS v4u*)(Yst + (16 * k + (lane >> 2)) * YP + 16 * (lane & 3)) = (rb & 1) ? T1.y[k] : T0.y[k];
                LDS_WAIT(); asm volatile("" ::: "memory");
                f32x16 acc = zero16();
#pragma unroll
                for (int kk = 0; kk < 8; ++kk) acc = MFMA32(frag_row(SP + w * 8704, TS, 0, 16 * kk, lane), frag_row(Qst, TS, 0, 16 * kk, lane), acc);
                float sc = 1.f;
                if (MODE == 0) sc = exp2f((float)(rb * 32 + li + 1) * l2g);
                if (MODE == 2) sc = (rb & 1) ? T1.rs : T0.rs;
                LAS unsigned char* yl = Yst + li * YP + 8 * hi;
#pragma unroll
                for (int g = 0; g < 4; ++g) { const v2u yy = *(const LAS v2u*)(yl + 16 * g); v2u o;
                    o.x = pkf(bflo(yy.x) + sc * acc[4 * g], bfhi(yy.x) + sc * acc[4 * g + 1]); o.y = pkf(bflo(yy.y) + sc * acc[4 * g + 2], bfhi(yy.y) + sc * acc[4 * g + 3]);
                    *(LAS v2u*)(yl + 16 * g) = o; }
                LDS_WAIT(); asm volatile("" ::: "memory");
#pragma unroll
                for (int k = 0; k < 2; ++k) *(GAS v4u*)(yb + (size_t)(rb * 32 + 16 * k + (lane >> 2)) * 2048 + 8 * (lane & 3)) = *(const LAS v4u*)(Yst + (16 * k + (lane >> 2)) * YP + 16 * (lane & 3));
                asm volatile("" ::: "memory");
            }
        }
        __syncthreads();
    }
}
__device__ __forceinline__ void mixer_loop(Frame& F) {
    for (int u = blockIdx.x; u < 256; u += F.G) {
        if (u < 64) loop_unit<0>(F, u);
        else if (u < 128) loop_unit<1>(F, u - 64);
        else loop_unit<2>(F, u - 128);
    }
}
__device__ __forceinline__ float softplusf_(float x) { return fmaxf(x, 0.f) + log1pf(__expf(-fabsf(x))); }
__device__ __forceinline__ void npre_rows(Frame& F, int l) {
    const int gw = F.vcu * NWAVES + F.wave, NGW = F.G * NWAVES, lane = F.lane;
    for (int row = gw; row < M; row += NGW) {
        const int t = row & (SEQ - 1);
        const GAS bf16* pr = WSB(WS_PROJ) + (size_t)row * NPROJ;
        GAS float* nq = WSF(WS_NQ) + (size_t)row * 1280; GAS float* nk = WSF(WS_NK) + (size_t)row * 1280; GAS float* nv = WSF(WS_NV) + (size_t)row * 2048;
        const float cs = WSF(WS_COS)[(size_t)row * 64 + lane], sn = WSF(WS_SIN)[(size_t)row * 64 + lane];
#pragma unroll
        for (int h = 0; h < 4; ++h) {
            const float q1 = bf2f(pr[C_RQ + h * 128 + lane]), q2 = bf2f(pr[C_RQ + h * 128 + 64 + lane]);
            const float k1 = bf2f(pr[C_RK + h * 128 + lane]) * 0.08838834764831845f, k2 = bf2f(pr[C_RK + h * 128 + 64 + lane]) * 0.08838834764831845f;
            nq[h * 128 + lane] = q1 * cs - q2 * sn; nq[h * 128 + 64 + lane] = q1 * sn + q2 * cs;
            nk[h * 128 + lane] = k1 * cs - k2 * sn; nk[h * 128 + 64 + lane] = k1 * sn + k2 * cs;
        }
#pragma unroll
        for (int j = 0; j < 8; ++j) { const int c = lane + 64 * j; nv[c] = bf2f(pr[C_RV + c]);
            const float lb = WSF(WS_LBS)[l * 512 + c], sg = sigmoidf_(bf2f(pr[C_HF + c])), f = lb + (1.f - lb) * sg;
            WSF(WS_NF)[(size_t)row * 512 + c] = f; nk[512 + c] = (1.f - lb) * (1.f - sg); nq[512 + c] = bf2f(pr[C_HQ + c]); nv[512 + c] = bf2f(pr[C_HI + c]); }
        for (int j = 0; j < 24; ++j) { const int ch = lane + 64 * j; float acc = INF(I_CONVB)[l * MCONV + ch];
#pragma unroll
            for (int k = 0; k < 4; ++k) { const int tt = t - 3 + k; if (tt >= 0) acc += INF(I_CONVW)[(l * 4 + k) * MCONV + ch] * bf2f(WSB(WS_PROJ)[(size_t)(row - 3 + k) * NPROJ + C_MX + ch]); }
            const float a = siluf_(acc);
            if (ch < 1024) nv[1024 + ch] = a; else if (ch < 1280) nk[1024 + ch - 1024] = a; else nq[1024 + ch - 1280] = a; }
        if (lane < 16) { const float dt = softplusf_(WSF(WS_DTRAW)[(size_t)row * 16 + lane] + INF(I_DTB)[l * 16 + lane]);
            WSF(WS_NDT)[(size_t)row * 16 + lane] = dt; WSF(WS_NDA)[(size_t)row * 16 + lane] = __expf(-__expf(INF(I_ALOG)[l * 16 + lane]) * dt); }
    }
}
template <int MODE> __device__ __forceinline__ void nscan(Frame& F, int l, int b, int hd, int half) {
    const int lane = F.lane;
    LAS float* kS = (LAS float*)(F.lds + RING_OFF + F.wave * 12288); LAS float* qS = kS + 1024; LAS float* fS = kS + 2048;
    const int kb = (MODE == 0) ? hd * 128 : (MODE == 1) ? 512 + hd * 128 : 1024 + (hd >> 3) * 128;
    const int vc = (MODE == 0) ? hd * 128 + half * 64 + lane : (MODE == 1) ? 512 + hd * 128 + half * 64 + lane : 1024 + hd * 64 + lane;
    const float gamma = 1.0f - exp2f(-5.0f - (float)hd);
    const float dsk = (MODE == 2) ? INF(I_MD)[l * 16 + hd] : 0.f;
    float S[128];
#pragma unroll
    for (int n = 0; n < 128; ++n) S[n] = 0.f;
    for (int t0 = 0; t0 < SEQ; t0 += 8) {
        const size_t row0 = (size_t)b * SEQ + t0;
#pragma unroll
        for (int tt = 0; tt < 8; ++tt) {
            *(LAS f32x2*)(kS + tt * 128 + 2 * lane) = *(const GAS f32x2*)(WSF(WS_NK) + (row0 + tt) * 1280 + kb + 2 * lane);
            *(LAS f32x2*)(qS + tt * 128 + 2 * lane) = *(const GAS f32x2*)(WSF(WS_NQ) + (row0 + tt) * 1280 + kb + 2 * lane);
            if (MODE == 1) *(LAS f32x2*)(fS + tt * 128 + 2 * lane) = *(const GAS f32x2*)(WSF(WS_NF) + (row0 + tt) * 512 + hd * 128 + 2 * lane);
        }
        LDS_WAIT(); asm volatile("" ::: "memory");
        for (int tt = 0; tt < 8; ++tt) {
            const size_t row = row0 + tt;
            const float v = WSF(WS_NV)[row * 2048 + vc];
            float dec = gamma, vv = v;
            if (MODE == 2) { dec = WSF(WS_NDA)[row * 16 + hd]; vv = v * WSF(WS_NDT)[row * 16 + hd]; }
            float o = 0.f;
#pragma unroll
            for (int n4 = 0; n4 < 32; ++n4) {
                const f32x4 k4 = *(const LAS f32x4*)(kS + tt * 128 + 4 * n4), q4 = *(const LAS f32x4*)(qS + tt * 128 + 4 * n4);
                f32x4 f4 = (f32x4){dec, dec, dec, dec};
                if (MODE == 1) f4 = *(const LAS f32x4*)(fS + tt * 128 + 4 * n4);
#pragma unroll
                for (int i = 0; i < 4; ++i) { S[4 * n4 + i] = S[4 * n4 + i] * f4[i] + k4[i] * vv; o += S[4 * n4 + i] * q4[i]; }
            }
            if (MODE == 2) o += dsk * v;
            WSB(WS_Y)[row * 2048 + vc] = (bf16)f2bf(o);
        }
        LDS_WAIT(); asm volatile("" ::: "memory");
    }
}
__device__ __forceinline__ void nloop(Frame& F, int l) {
    const int gw = blockIdx.x * NWAVES + F.wave, NGW = F.G * NWAVES;
    const int stride = NGW >= 128 ? NGW / 128 : 1;
    for (int u = 0; u < 128; ++u) {
        if ((u * stride) % NGW != gw) continue;
        if (u < 32) nscan<0>(F, l, u >> 3, (u >> 1) & 3, u & 1);
        else if (u < 64) { const int v = u - 32; nscan<1>(F, l, v >> 3, (v >> 1) & 3, v & 1); }
        else { const int v = u - 64; nscan<2>(F, l, v >> 4, v & 15, 0); }
    }
}
__device__ __forceinline__ void post_rows(Frame& F, int l) {
    const int gw = F.vcu * NWAVES + F.wave, NGW = F.G * NWAVES, lane = F.lane;
    const GAS float* hgw = INF(I_HGNW) + l * 512 + 8 * lane; const GAS float* mnw = INF(I_MNW) + l * 1024 + 8 * lane;
    const GAS bf16* Yb = WSB(WS_Y); const GAS bf16* Pb = WSB(WS_PROJ); GAS bf16* Ob = WSB(WS_O);
    float wv[3][8];
    { const f32x4 a = *(const GAS f32x4*)hgw, b4 = *(const GAS f32x4*)(hgw + 4), c4 = *(const GAS f32x4*)mnw, d4 = *(const GAS f32x4*)(mnw + 4), e4 = *(const GAS f32x4*)(mnw + 512), f4 = *(const GAS f32x4*)(mnw + 516);
      wv[0][0] = a.x; wv[0][1] = a.y; wv[0][2] = a.z; wv[0][3] = a.w; wv[0][4] = b4.x; wv[0][5] = b4.y; wv[0][6] = b4.z; wv[0][7] = b4.w;
      wv[1][0] = c4.x; wv[1][1] = c4.y; wv[1][2] = c4.z; wv[1][3] = c4.w; wv[1][4] = d4.x; wv[1][5] = d4.y; wv[1][6] = d4.z; wv[1][7] = d4.w;
      wv[2][0] = e4.x; wv[2][1] = e4.y; wv[2][2] = e4.z; wv[2][3] = e4.w; wv[2][4] = f4.x; wv[2][5] = f4.y; wv[2][6] = f4.z; wv[2][7] = f4.w; }
    for (int row = gw; row < M; row += NGW) {
        const GAS bf16* yr = Yb + (size_t)row * 2048 + 8 * lane; const GAS bf16* pr = Pb + (size_t)row * NPROJ + 8 * lane; GAS bf16* orow = Ob + (size_t)row * 2048 + 8 * lane;
        v4u yw[4], gq[4];
#pragma unroll
        for (int j = 0; j < 4; ++j) yw[j] = *(const GAS v4u*)(yr + 512 * j);
        gq[0] = *(const GAS v4u*)(pr + C_RG); gq[1] = *(const GAS v4u*)(pr + C_HG); gq[2] = *(const GAS v4u*)(pr + C_MZ); gq[3] = *(const GAS v4u*)(pr + C_MZ + 512);
#pragma unroll
        for (int j = 0; j < 4; ++j) {
            float y[8], g[8], o[8]; unpack8(yw[j], y); unpack8(gq[j], g);
            if (j < 2) {
                float ss = 0.f;
#pragma unroll
                for (int e = 0; e < 8; ++e) ss += y[e] * y[e];
                ss = grp16_sum(ss);
                const float r = 1.f / sqrtf(ss * (1.f / 128.f) + RMS_EPS);
#pragma unroll
                for (int e = 0; e < 8; ++e) o[e] = y[e] * r * (j == 1 ? wv[0][e] : 1.f) * siluf_(g[e]);
            } else {
                float ss = 0.f;
#pragma unroll
                for (int e = 0; e < 8; ++e) { y[e] = y[e] * siluf_(g[e]); ss += y[e] * y[e]; }
                ss = wave_sum(ss);
                const float r = 1.f / sqrtf(ss * (1.f / 512.f) + RMS_EPS);
#pragma unroll
                for (int e = 0; e < 8; ++e) o[e] = y[e] * r * wv[j - 1][e];
            }
            *(GAS v4u*)(orow + 512 * j) = pack8(o);
        }
    }
}

struct Args { const void* in[19]; float* out; unsigned char* ws; int ph_lo, ph_hi, flags, pad; };
__global__ void __launch_bounds__(NWAVES * 64, 2) hymba_fwd(Args args) {
    extern __shared__ __attribute__((aligned(16))) unsigned char lds[];
    Frame F;
    F.lds = (LAS unsigned char*)lds;
    F.MISC = (volatile LAS unsigned*)(F.lds + MISC_OFF);
    F.tid = threadIdx.x; F.lane = F.tid & 63; F.wave = __builtin_amdgcn_readfirstlane(F.tid >> 6);
    F.G = gridDim.x; { const int bx = blockIdx.x; F.vcu = (F.G % 8 == 0) ? (bx % 8) * (F.G / 8) + bx / 8 : bx; }
    F.ws = (GAS unsigned char*)args.ws;
    F.ctl = (gu32*)(args.ws + WS_CTL);
    for (int u = F.tid; u < LDSCTL_BYTES / 4; u += NWAVES * 64) ((LAS unsigned*)(F.lds + LDSCTL_OFF))[u] = 0u;
    __syncthreads();
    if (F.tid == 0) {
#pragma unroll
        for (int i = 0; i < 19; ++i) ((LAS unsigned long long*)(F.lds + PTAB_OFF))[i] = (unsigned long long)args.in[i];
        ((LAS unsigned long long*)(F.lds + PTAB_OFF))[19] = (unsigned long long)args.out;
        ((LAS unsigned long long*)(F.lds + PTAB_OFF))[20] = (unsigned long long)args.ws;
    }
    __syncthreads();
    const int lo = args.ph_lo, hi = args.ph_hi;
    XcdBarrier bar; bar.bar = (unsigned*)(F.ctl + CW_BAR); bar.x = 0; bar.st = nullptr;
    if (hi - lo > 1) bar = xcd_barrier_post((unsigned*)(F.ctl + CW_BAR), F.MISC + 8);
    int ph = 0;
#define PHASE_BEGIN if (ph >= lo && ph < hi) { { int t_; asm volatile("v_mov_b32 %0, %1" : "=v"(t_) : "v"((int)threadIdx.x)); F.tid = t_; F.lane = t_ & 63; F.wave = __builtin_amdgcn_readfirstlane(t_ >> 6); }
#define PHASE_END   if (ph + 1 < hi) xcd_barrier(bar); } ++ph;

    PHASE_BEGIN
#ifndef X_NO_PRO
 p0_prologue(F);
#endif
 PHASE_END
    PHASE_BEGIN
#ifndef X_NO_LN
 mod_rows(F, INF(I_X), WSF(WS_ADA), 1, 0);
#endif
 PHASE_END
    for (int l = 0; l < DEPTH; ++l) {
        const GAS float* ada_l = WSF(WS_ADA) + (size_t)l * BATCH * NADA;
        PHASE_BEGIN
#ifndef X_NO_GIN
{
            pg8::Gemm g{(const pg8::bf16_t*)WSB(WS_H), (const pg8::bf16_t*)(WSB(WS_WIN) + (size_t)l * NPROJ * D), M, NPROJ, D}; pg8::StaticOrder S; S.init(M, NPROJ, F.G, (int)blockIdx.x);
            pg8::EpiProj E{F.lds + PTAB_OFF, WS_PROJ, WS_DTRAW, NPROJ, C_DT / 256};
            pg8::gemm_phase<pg8::EpiProj, pg8::StaticOrder, PG8_ALIGN, PG8_SP2>(F.lds + RING_OFF, g, S, E);
            constexpr int NU = (M / 256) * (NPROJ / 256); const int full = NU / F.G, rem = NU % F.G;
            if (l + 1 < DEPTH) { if (rem != 0 && (int)blockIdx.x >= rem) convert_next_in_out(F, l + 1, (int)blockIdx.x - rem, F.G - rem); else if (rem == 0) convert_next_in_out(F, l + 1, (int)blockIdx.x, F.G); }
            (void)full;
        }
#endif
 PHASE_END
        PHASE_BEGIN
#if MIXER_NAIVE
 npre_rows(F, l);
#else
 mixer_pre(F, l, args.flags);
#endif
 PHASE_END
        PHASE_BEGIN
#if MIXER_NAIVE
 nloop(F, l);
#elif MIXER_V2
 mixer_scan(F);
#else
 mixer_loop(F);
#endif
 PHASE_END
        PHASE_BEGIN
#if MIXER_V2 && !MIXER_NAIVE
 mixer_interpost(F, l);
#else
 post_rows(F, l);
#endif
 PHASE_END
        PHASE_BEGIN
#ifndef X_NO_GOUT
{
            pg8::Gemm g{(const pg8::bf16_t*)WSB(WS_O), (const pg8::bf16_t*)(WSB(WS_WOUT) + (size_t)l * D * D), M, D, D}; pg8::StaticOrder S; S.init(M, D, F.G, (int)blockIdx.x);
            pg8::EpiRes E{F.lds + PTAB_OFF, WS_T, WS_ADA + ((size_t)l * BATCH * NADA + 2 * D) * 4, WS_STAT, D, NADA, l == 0 ? -1 : l * 2 - 1, ALPHA, (size_t)0};
            pg8::gemm_phase<pg8::EpiRes, pg8::StaticOrder, PG8_ALIGN, PG8_SP2>(F.lds + RING_OFF, g, S, E);
        }
#endif
 PHASE_END
        PHASE_BEGIN
#ifndef X_NO_LN
 ln_rows(F, WSB(WS_T), (const GAS float*)nullptr, INF(I_LNG) + (size_t)(l * 2 + 0) * D, INF(I_LNB) + (size_t)(l * 2 + 0) * D, WSF(WS_X), WSF(WS_STAT), ada_l, 4, 3, true);
#endif
 PHASE_END
        PHASE_BEGIN
#ifndef X_NO_G1
{
            pg8::Gemm g{(const pg8::bf16_t*)WSB(WS_H), (const pg8::bf16_t*)(WSB(WS_W1) + (size_t)l * DFF * D), M, DFF, D}; pg8::StaticOrder S; S.init(M, DFF, F.G, (int)blockIdx.x);
            pg8::EpiRelu2 E{F.lds + PTAB_OFF, WS_U, DFF};
            pg8::gemm_phase<pg8::EpiRelu2, pg8::StaticOrder, PG8_ALIGN, PG8_SP2>(F.lds + RING_OFF, g, S, E);
        }
#endif
 PHASE_END
        PHASE_BEGIN
#ifndef X_NO_G2
{
            pg8::Gemm g{(const pg8::bf16_t*)WSB(WS_U), (const pg8::bf16_t*)(WSB(WS_W2) + (size_t)l * D * DFF), M, D, DFF}; pg8::StaticOrder S; S.init(M, D, F.G, (int)blockIdx.x);
            pg8::EpiRes E{F.lds + PTAB_OFF, WS_T, WS_ADA + ((size_t)l * BATCH * NADA + 5 * D) * 4, WS_STAT, D, NADA, l * 2, ALPHA, (l == DEPTH - 1) ? (size_t)WS_X : (size_t)0};
            pg8::gemm_phase<pg8::EpiRes, pg8::StaticOrder, PG8_ALIGN, PG8_SP2>(F.lds + RING_OFF, g, S, E);
        }
#endif
 PHASE_END
        PHASE_BEGIN
#ifndef X_NO_LN
 ln_rows(F, WSB(WS_T), (l == DEPTH - 1) ? (const GAS float*)WSF(WS_X) : (const GAS float*)nullptr, INF(I_LNG) + (size_t)(l * 2 + 1) * D, INF(I_LNB) + (size_t)(l * 2 + 1) * D, (GAS float*)ptab_get(F, I_OUT), WSF(WS_STAT), ada_l + (size_t)BATCH * NADA, 1, 0, l < DEPTH - 1);
#endif
 PHASE_END
    }
#undef PHASE_BEGIN
#undef PHASE_END
}

extern "C" void kernel_launch(void* const* d_in, const int* in_sizes, int n_in, void* d_out, int out_size, void* d_ws, size_t ws_size, hipStream_t stream) {
    static int grid = 0;
    if (grid == 0) {
        if (n_in != 19 || in_sizes[0] != M * D || out_size != M * D || ws_size < WS_END) { fprintf(stderr, "kernel_launch: unexpected shapes (n_in %d, in0 %d, out %d, ws %zu)\n", n_in, n_in > 0 ? in_sizes[0] : -1, out_size, ws_size); grid = -1; return; }
        int dev = 0, cus = 0, per_cu = 0;
        if (hipGetDevice(&dev) != hipSuccess || hipDeviceGetAttribute(&cus, hipDeviceAttributeMultiprocessorCount, dev) != hipSuccess) { grid = -1; return; }
        if (hipFuncSetAttribute((const void*)hymba_fwd, hipFuncAttributeMaxDynamicSharedMemorySize, LDS_BYTES) != hipSuccess) { fprintf(stderr, "kernel_launch: hipFuncSetAttribute failed\n"); grid = -1; return; }
        if (hipOccupancyMaxActiveBlocksPerMultiprocessor(&per_cu, (const void*)hymba_fwd, NWAVES * 64, LDS_BYTES) != hipSuccess || per_cu < 1)
            fprintf(stderr, "kernel_launch: note: occupancy query reports %d workgroups per CU\n", per_cu);
        (void)hipGetLastError();
        grid = cus;
    }
    if (grid < 0) return;
    if (hipMemsetAsync((char*)d_ws + WS_CTL, 0, CTL_ZERO_BYTES, stream) != hipSuccess) return;
    Args a{};
    for (int i = 0; i < 19; ++i) a.in[i] = d_in[i];
    a.out = (float*)d_out; a.ws = (unsigned char*)d_ws;
#if MK_PER_PHASE
    for (int p = 0; p < N_PHASES; ++p) { a.ph_lo = p; a.ph_hi = p + 1; hipLaunchKernelGGL(hymba_fwd, dim3(grid), dim3(NWAVES * 64), LDS_BYTES, stream, a); }
#else
    a.ph_lo = 0; a.ph_hi = N_PHASES;
    hipLaunchKernelGGL(hymba_fwd, dim3(grid), dim3(NWAVES * 64), LDS_BYTES, stream, a);
#if defined(PROBE_SET)
#ifndef PROBE_FLAGS
#define PROBE_FLAGS 0
#endif
    {
        const int L3 = 2 + 3 * PH_PER_LAYER;
        const int sets[10][4] = { {0, -1, -1, -1}, {L3 + 0, L3 + 4, L3 + 6, L3 + 7}, {L3 + 1, L3 + 2, L3 + 3, -1}, {L3 + 5, L3 - 1, -1, -1}, {L3 + 1, -1, -1, -1}, {L3 + 2, -1, -1, -1}, {L3 + 0, -1, -1, -1}, {L3 + 7, -1, -1, -1}, {L3 + 4, -1, -1, -1}, {L3 + 6, -1, -1, -1} };
        for (int rep = 0; rep < PROBE_REPS; ++rep) for (int k = 0; k < 4; ++k) { const int p = sets[PROBE_SET][k]; if (p < 0) continue;
            a.ph_lo = p; a.ph_hi = p + 1; a.flags = PROBE_FLAGS; hipLaunchKernelGGL(hymba_fwd, dim3(grid), dim3(NWAVES * 64), LDS_BYTES, stream, a); }
    }
#endif
#endif
    const hipError_t le = hipPeekAtLastError();
    if (le != hipSuccess) fprintf(stderr, "kernel_launch: launch failed: %s\n", hipGetErrorName(le));
}
```
